# Optimizing an MI355X kernel written in HIP

```python
import jax, jax.numpy as jnp
from jax import lax
import numpy as np

D_MODEL = 2048
BATCH = 8
SEQ = 4096
DEPTH = 1

N_META = 16
BLK = 128
PAD_FRONT = BLK - N_META
MLA_HEADS = 8
MLA_NOPE = 128
MLA_ROPE = 64
MLA_V = 128
MLA_Q_RANK = 512
MLA_KV_RANK = 256
MLA_WIDTH = MLA_HEADS * MLA_V
RET_HEADS = 8
RET_DK = 128
RET_DV = 128
RET_WIDTH = RET_HEADS * RET_DV
ROPE_BASE = 10000.0
NORM_EPS = 1e-6
GN_EPS = 1e-5
N_BRANCH = 2
NEG_INF = -1e30
IN_SPLITS = (MLA_Q_RANK, MLA_KV_RANK, MLA_ROPE, MLA_WIDTH,
             RET_HEADS * RET_DK, RET_HEADS * RET_DK, RET_WIDTH, RET_WIDTH,
             N_BRANCH * D_MODEL)
IN_WIDTH = sum(IN_SPLITS)

kernel_name = "mla_retention_gated_hybrid"


def rmsnorm(x, w):
    xf = x.astype(jnp.float32)
    y = xf * lax.rsqrt(jnp.mean(xf * xf, axis=-1, keepdims=True) + NORM_EPS)
    return (y * w.astype(jnp.float32)).astype(x.dtype)


def rope(t, pos):
    d = t.shape[-1]
    inv = ROPE_BASE ** (-jnp.arange(0, d, 2, dtype=jnp.float32) / d)
    ang = pos.astype(jnp.float32)[:, None] * inv[None, :]
    ang = ang.reshape(ang.shape[:1] + (1,) * (t.ndim - 3) + ang.shape[1:])
    cos = jnp.cos(ang).astype(t.dtype)
    sin = jnp.sin(ang).astype(t.dtype)
    t1, t2 = t[..., : d // 2], t[..., d // 2:]
    return jnp.concatenate([t1 * cos - t2 * sin, t1 * sin + t2 * cos], axis=-1)


def pad_front(t):
    return jnp.pad(t, ((0, 0), (PAD_FRONT, 0)) + ((0, 0),) * (t.ndim - 2))


def mla_branch(c_q, c_kv, k_pe, pos, q_norm_w, w_uq, kv_norm_w, w_ukv):
    B, L, _ = c_q.shape
    q = (rmsnorm(c_q, q_norm_w) @ w_uq).reshape(B, L, MLA_HEADS, MLA_NOPE + MLA_ROPE)
    q_nope, q_pe = q[..., :MLA_NOPE], rope(q[..., MLA_NOPE:], pos)
    kv = (rmsnorm(c_kv, kv_norm_w) @ w_ukv).reshape(B, L, MLA_HEADS, MLA_NOPE + MLA_V)
    k_nope, v = kv[..., :MLA_NOPE], kv[..., MLA_NOPE:]
    k_pe = rope(k_pe, pos)
    q_nope, q_pe, k_nope, v, k_pe = (pad_front(t) for t in (q_nope, q_pe, k_nope, v, k_pe))
    Lp = L + PAD_FRONT
    scale = (MLA_NOPE + MLA_ROPE) ** -0.5
    kidx = jnp.arange(Lp)

    def block(i):
        start = i * BLK
        qn = lax.dynamic_slice_in_dim(q_nope, start, BLK, axis=1)
        qp = lax.dynamic_slice_in_dim(q_pe, start, BLK, axis=1)
        s = (jnp.einsum('bqhd,bkhd->bhqk', qn, k_nope)
             + jnp.einsum('bqhd,bkd->bhqk', qp, k_pe)).astype(jnp.float32) * scale
        qidx = start + jnp.arange(BLK)
        mask = (kidx[None, :] <= qidx[:, None]) & (kidx[None, :] >= PAD_FRONT)
        s = jnp.where(mask[None, None], s, NEG_INF)
        p = jax.nn.softmax(s, axis=-1).astype(v.dtype)
        return jnp.einsum('bhqk,bkhd->bqhd', p, v)

    o = lax.map(block, jnp.arange(Lp // BLK))
    o = o.transpose(1, 0, 2, 3, 4).reshape(B, Lp, MLA_WIDTH)
    return o[:, PAD_FRONT:]


def retention_branch(r_q, r_k, r_v, pos, gn_w, gn_b):
    B, L, _ = r_q.shape
    dt = r_q.dtype
    q = rope(r_q.reshape(B, L, RET_HEADS, RET_DK), pos)
    k = rope(r_k.reshape(B, L, RET_HEADS, RET_DK), pos) * (RET_DK ** -0.5)
    v = r_v.reshape(B, L, RET_HEADS, RET_DV)
    q, k, v = (pad_front(t).astype(jnp.float32) for t in (q, k, v))
    Lp = L + PAD_FRONT
    nc = Lp // BLK

    def chunk(t):
        return t.reshape(B, nc, BLK, RET_HEADS, -1).transpose(0, 3, 1, 2, 4)

    qc, kc, vc = chunk(q), chunk(k), chunk(v)
    log_g = jnp.log1p(-(2.0 ** (-5.0 - jnp.arange(RET_HEADS, dtype=jnp.float32))))
    n = jnp.arange(BLK, dtype=jnp.float32)
    diff = n[:, None] - n[None, :]
    decay_in = jnp.where(diff >= 0, jnp.exp(log_g[:, None, None] * jnp.maximum(diff, 0.0)), 0.0)
    zeta = jnp.exp(log_g[:, None] * (BLK - 1.0 - n))
    xi = jnp.exp(log_g[:, None] * (n + 1.0))
    g_chunk = jnp.exp(log_g * BLK)
    s = jnp.einsum('bhcnd,bhcmd->bhcnm', qc, kc) * decay_in[None, :, None]
    inner = jnp.einsum('bhcnm,bhcme->bhcne', s, vc)
    kv_chunk = jnp.einsum('bhcmd,bhcme->cbhde', kc * zeta[None, :, None, :, None], vc)

    def step(R, kv):
        return R * g_chunk[None, :, None, None] + kv, R

    _, R_prev = lax.scan(step, jnp.zeros((B, RET_HEADS, RET_DK, RET_DV), jnp.float32), kv_chunk)
    cross = jnp.einsum('bhcnd,cbhde->bhcne', qc, R_prev) * xi[None, :, None, :, None]
    o = (inner + cross).transpose(0, 2, 3, 1, 4).reshape(B, Lp, RET_HEADS, RET_DV)[:, PAD_FRONT:]
    mu = jnp.mean(o, axis=-1, keepdims=True)
    var = jnp.mean(jnp.square(o - mu), axis=-1, keepdims=True)
    o = ((o - mu) * lax.rsqrt(var + GN_EPS)).reshape(B, L, RET_WIDTH)
    o = o * gn_w.astype(jnp.float32) + gn_b.astype(jnp.float32)
    return o.astype(dt)


def hybrid_layer(h, pos, norm_w, w_in, mla_q_norm_w, mla_w_uq, mla_kv_norm_w, mla_w_ukv,
                 ret_gn_w, ret_gn_b, w_branch_mla, w_branch_ret, w_out):
    B, L, D = h.shape
    xn = rmsnorm(h, norm_w)
    proj = xn @ w_in
    offs, acc = [], 0
    for w in IN_SPLITS[:-1]:
        acc += w
        offs.append(acc)
    c_q, c_kv, k_pe, z_mla, r_q, r_k, r_v, z_ret, gate_logits = jnp.split(proj, offs, axis=-1)
    y_mla = mla_branch(c_q, c_kv, k_pe, pos, mla_q_norm_w, mla_w_uq, mla_kv_norm_w, mla_w_ukv) * jax.nn.silu(z_mla)
    y_ret = retention_branch(r_q, r_k, r_v, pos, ret_gn_w, ret_gn_b) * jax.nn.silu(z_ret)
    gates = jax.nn.sigmoid(gate_logits.astype(jnp.float32)).astype(h.dtype).reshape(B, L, N_BRANCH, D)
    merged = gates[:, :, 0] * (y_mla @ w_branch_mla) + gates[:, :, 1] * (y_ret @ w_branch_ret)
    return h + merged @ w_out


def setup_inputs(seed: int = 0) -> dict:
    key = jax.random.key(seed)
    ks = jax.random.split(key, 16)
    f32 = jnp.float32

    def w(k, shape, fan_in):
        return jax.random.normal(k, shape, f32) * (fan_in ** -0.5)

    def gain(k, shape):
        return 1.0 + 0.02 * jax.random.normal(k, shape, f32)

    return {
        "x": jax.random.normal(ks[0], (BATCH, SEQ, D_MODEL), f32),
        "meta": jax.random.normal(ks[1], (N_META, D_MODEL), f32),
        "norm_w": gain(ks[2], (DEPTH, D_MODEL)),
        "w_in": w(ks[3], (DEPTH, D_MODEL, IN_WIDTH), D_MODEL),
        "mla_q_norm_w": gain(ks[4], (DEPTH, MLA_Q_RANK)),
        "mla_w_uq": w(ks[5], (DEPTH, MLA_Q_RANK, MLA_HEADS * (MLA_NOPE + MLA_ROPE)), MLA_Q_RANK),
        "mla_kv_norm_w": gain(ks[6], (DEPTH, MLA_KV_RANK)),
        "mla_w_ukv": w(ks[7], (DEPTH, MLA_KV_RANK, MLA_HEADS * (MLA_NOPE + MLA_V)), MLA_KV_RANK),
        "ret_gn_w": gain(ks[8], (DEPTH, RET_WIDTH)),
        "ret_gn_b": 0.02 * jax.random.normal(ks[9], (DEPTH, RET_WIDTH), f32),
        "w_branch_mla": w(ks[10], (DEPTH, MLA_WIDTH, D_MODEL), MLA_WIDTH),
        "w_branch_ret": w(ks[11], (DEPTH, RET_WIDTH, D_MODEL), RET_WIDTH),
        "w_out": w(ks[12], (DEPTH, D_MODEL, D_MODEL), D_MODEL),
        "final_norm_w": gain(ks[13], (D_MODEL,)),
    }


def reference(x, meta, norm_w, w_in, mla_q_norm_w, mla_w_uq, mla_kv_norm_w, mla_w_ukv,
              ret_gn_w, ret_gn_b, w_branch_mla, w_branch_ret, w_out, final_norm_w):
    B = x.shape[0]
    h = jnp.concatenate([jnp.broadcast_to(meta.astype(x.dtype)[None], (B, N_META, D_MODEL)), x], axis=1)
    pos = jnp.arange(h.shape[1])
    for l in range(DEPTH):
        h = hybrid_layer(h, pos, norm_w[l], w_in[l], mla_q_norm_w[l], mla_w_uq[l],
                         mla_kv_norm_w[l], mla_w_ukv[l], ret_gn_w[l], ret_gn_b[l],
                         w_branch_mla[l], w_branch_ret[l], w_out[l])
    h = rmsnorm(h, final_norm_w)
    return h[:, N_META:]
```

```cpp
#include <hip/hip_runtime.h>
#include <hip/hip_cooperative_groups.h>
#include <cstdio>
#include <cstdint>
constexpr size_t MiB = 1u << 20;
constexpr size_t WS_CTL = 0, WS_WIN = 1 * MiB, WS_WUQ = 41 * MiB, WS_WUK = 43 * MiB, WS_WUV = 43 * MiB + 512 * 1024, WS_WBM = 44 * MiB, WS_WBR = 48 * MiB, WS_WOUT = 52 * MiB;
constexpr size_t WS_C128 = 60 * MiB, WS_S128 = 61 * MiB + 256 * 1024, WS_C64 = 62 * MiB + 512 * 1024, WS_S64 = 63 * MiB + 256 * 1024;
constexpr size_t WS_MP = 64 * MiB, WS_R0 = 64 * MiB + 256 * 1024, WS_SSQQ = 65 * MiB, WS_SSQKV = 66 * MiB, WS_SSQO = 67 * MiB, WS_KR = 71 * MiB;
constexpr size_t WS_XN = 76 * MiB, WS_QN = 76 * MiB, WS_QR = 140 * MiB, WS_CQ = 204 * MiB, WS_CKV = 236 * MiB, WS_ZMLA = 252 * MiB, WS_RQ = 316 * MiB, WS_RK = 380 * MiB, WS_MG = 316 * MiB;
constexpr size_t WS_RV = 444 * MiB, WS_ZRET = 508 * MiB, WS_GATES = 572 * MiB, WS_KN = 828 * MiB, WS_VT = 894 * MiB, WS_END = 960 * MiB;
namespace pg8 {
#define PG8_LAS __attribute__((address_space(3)))
typedef unsigned short bf16_t;
typedef short bf16x8 __attribute__((ext_vector_type(8)));
typedef float f32x4 __attribute__((ext_vector_type(4)));
typedef unsigned u32x4 __attribute__((ext_vector_type(4)));
constexpr int BM = 256, BK = 64, HALF = 128, HTB = HALF * BK * 2  , STAGE_BYTES = 8 * HTB, NXCD = 8, WGM = 8;

__host__ __device__ __forceinline__ int lds_byte(int r, int c) { const int st = (r >> 4) * 2 + (c >> 5), rr = r & 15, cc = c & 31, ob = rr * 64 + cc * 2; return st * 1024 + (ob ^ (((ob >> 9) & 1) << 5)); }
__host__ __device__ __forceinline__ void stage_rc(int b, int& R, int& C) { const int st = b / 1024, sb = b % 1024, swz = sb ^ (((sb >> 9) & 1) << 5); R = (st >> 1) * 16 + swz / 64; C = (st & 1) * 32 + (swz % 64) / 2; }
__host__ __device__ __forceinline__ int perm32(int rho) { const int n = rho >> 4, i = rho & 15; return 8 * (i >> 2) + 4 * n + (i & 3); }

struct Unit { int pm, pn; };
struct Gemm { const bf16_t* A; const bf16_t* Bt; int M, N, K; };

struct StaticOrder {
    int nM, nN, nwg, G, c;
    __host__ __device__ void init(int M, int N, int G_, int c_) { nM = M / BM; nN = N / BM; nwg = nM * nN; G = G_; c = c_; }
    __host__ __device__ bool next(int i, Unit& u) const {
        const long L = (long)i * G + c; if (L >= nwg) return false;
        int wgid = (int)L; { const int q = nwg / NXCD, r = nwg % NXCD, xcd = wgid % NXCD, off = wgid / NXCD; wgid = (xcd < r ? xcd * (q + 1) : r * (q + 1) + (xcd - r) * q) + off; }
        const int nig = WGM * nN, gid = wgid / nig, fm = gid * WGM, gsz = (nM - fm) < WGM ? (nM - fm) : WGM;
        u.pm = fm + ((wgid % nig) % gsz); u.pn = (wgid % nig) / gsz; return true;
    }
    __device__ __forceinline__ void a_ready(const Unit&) const {}
    __device__ __forceinline__ void done(const Unit&) const {}
};

__device__ __forceinline__ unsigned cvt_pk_bf16(float lo, float hi) { unsigned r; asm volatile("v_cvt_pk_bf16_f32 %0, %1, %2" : "=v"(r) : "v"(lo), "v"(hi)); return r; }
typedef float f32x2 __attribute__((ext_vector_type(2)));
typedef unsigned u32x2 __attribute__((ext_vector_type(2)));
constexpr int TOK = 4096, KSEQ = 4160, KOFF = 64;
__device__ __forceinline__ float head_lg2(int h) { const float x = __uint_as_float((unsigned)(127 - 5 - h) << 23); const float p = x * (1.f + x * (0.5f + x * (0.33333333f + x * (0.25f + x * (0.2f + x * (0.16666667f + x * 0.14285714f)))))); return -p * 1.4426950408889634f; }
__device__ __forceinline__ float sigmoid_f(float x) { return __builtin_amdgcn_rcpf(1.f + __expf(-x)); }
__device__ __forceinline__ float bf2f(unsigned short b) { return __uint_as_float((unsigned)b << 16); }
__device__ __forceinline__ u32x4 pack8(f32x4 v0, f32x4 v1) { u32x4 w; w.x = cvt_pk_bf16(v0[0], v0[1]); w.y = cvt_pk_bf16(v0[2], v0[3]); w.z = cvt_pk_bf16(v1[0], v1[1]); w.w = cvt_pk_bf16(v1[2], v1[3]); return w; }
__device__ __forceinline__ u32x2 pack4(f32x4 v) { u32x2 w; w.x = cvt_pk_bf16(v[0], v[1]); w.y = cvt_pk_bf16(v[2], v[3]); return w; }
__device__ __forceinline__ void unpack8(u32x4 w, f32x4& a, f32x4& b) {
    a[0] = __uint_as_float(w.x << 16); a[1] = __uint_as_float(w.x & 0xffff0000u); a[2] = __uint_as_float(w.y << 16); a[3] = __uint_as_float(w.y & 0xffff0000u);
    b[0] = __uint_as_float(w.z << 16); b[1] = __uint_as_float(w.z & 0xffff0000u); b[2] = __uint_as_float(w.w << 16); b[3] = __uint_as_float(w.w & 0xffff0000u); }

struct EpiIn {
    static constexpr bool PERM = true, AFTER_DRAIN = false;
    unsigned char* ws; float *ssq_q, *ssq_kv; const float *C128, *S128, *C64, *S64;
    __device__ __forceinline__ void operator()(const f32x4 (&acc)[2][2][4][2], const Unit& u, int wr, int wc, int fr, int fq) const {
        const int pn = u.pn, row0 = u.pm * BM + wr * 64 + fr;
        if (pn < 3) {
            bf16_t* base = (bf16_t*)(ws + (pn < 2 ? WS_CQ : WS_CKV)); const int ldc = pn < 2 ? 512 : 256, colt = pn < 2 ? pn * 256 : 0;
            float* sq = pn < 2 ? ssq_q : ssq_kv; const int sld = pn < 2 ? 8 : 4, soff = (pn < 2 ? pn * 4 : 0) + wc;
#pragma unroll
            for (int ai = 0; ai < 2; ++ai)
#pragma unroll
                for (int m = 0; m < 4; ++m) { const int row = row0 + ai * HALF + m * 16; float s = 0.f;
#pragma unroll
                    for (int bj = 0; bj < 2; ++bj) { const f32x4 v0 = acc[ai][bj][m][0], v1 = acc[ai][bj][m][1];
                        s += (v0[0] * v0[0] + v0[1] * v0[1]) + (v0[2] * v0[2] + v0[3] * v0[3]) + (v1[0] * v1[0] + v1[1] * v1[1]) + (v1[2] * v1[2] + v1[3] * v1[3]);
                        *(u32x4*)(base + (size_t)row * ldc + colt + bj * HALF + wc * 32 + 8 * fq) = pack8(v0, v1); }
                    s += __shfl_xor(s, 16); s += __shfl_xor(s, 32);
                    if (fq == 0) sq[(size_t)row * sld + soff] = s; }
        } else if (pn == 3) {
            if (wc < 2) {
                const int j0 = 16 * wc + 4 * fq;
#pragma unroll
                for (int ai = 0; ai < 2; ++ai)
#pragma unroll
                    for (int m = 0; m < 4; ++m) { const int row = row0 + ai * HALF + m * 16, b = row >> 12, t = row & (TOK - 1), pos = 16 + t;
                        const f32x4 c = *(const f32x4*)(C64 + pos * 32 + j0), s = *(const f32x4*)(S64 + pos * 32 + j0);
                        const f32x4 t1 = acc[ai][0][m][0], t2 = acc[ai][0][m][1];
                        bf16_t* o = (bf16_t*)(ws + WS_KR) + (size_t)(b * KSEQ + KOFF + t) * 64 + j0;
                        *(u32x2*)o = pack4(t1 * c - t2 * s); *(u32x2*)(o + 32) = pack4(t1 * s + t2 * c); }
            }
        } else if ((pn >= 8) && (pn < 16)) {
            const bool isk = pn >= 12; bf16_t* base = (bf16_t*)(ws + (isk ? WS_RK : WS_RQ)); const int colt = (pn - (isk ? 12 : 8)) * 256; const int j0 = 16 * wc + 4 * fq;
#pragma unroll
            for (int ai = 0; ai < 2; ++ai)
#pragma unroll
                for (int m = 0; m < 4; ++m) { const int row = row0 + ai * HALF + m * 16, t = row & (TOK - 1), pos = 16 + t;
                    const f32x4 c = *(const f32x4*)(C128 + pos * 64 + j0), s = *(const f32x4*)(S128 + pos * 64 + j0);
#pragma unroll
                    for (int bj = 0; bj < 2; ++bj) { float f = 1.f;
                        if (isk) { const int h = (colt >> 7) + bj; f = 0.08838834764831845f * __builtin_amdgcn_exp2f(head_lg2(h) * (float)(127 - (t & 127))); }
                        const f32x4 t1 = acc[ai][bj][m][0] * f, t2 = acc[ai][bj][m][1] * f;
                        bf16_t* o = base + (size_t)row * 1024 + colt + bj * HALF + j0;
                        *(u32x2*)o = pack4(t1 * c - t2 * s); *(u32x2*)(o + 64) = pack4(t1 * s + t2 * c); } }
        } else {
            size_t boff; int ldc, colt, act;
            if (pn < 8) { boff = WS_ZMLA; ldc = 1024; colt = (pn - 4) * 256; act = 1; }
            else if (pn < 20) { boff = WS_RV; ldc = 1024; colt = (pn - 16) * 256; act = 0; }
            else if (pn < 24) { boff = WS_ZRET; ldc = 1024; colt = (pn - 20) * 256; act = 1; }
            else { boff = WS_GATES; ldc = 4096; colt = (pn - 24) * 256; act = 2; }
            bf16_t* base = (bf16_t*)(ws + boff);
#pragma unroll
            for (int ai = 0; ai < 2; ++ai)
#pragma unroll
                for (int m = 0; m < 4; ++m) { const int row = row0 + ai * HALF + m * 16;
#pragma unroll
                    for (int bj = 0; bj < 2; ++bj) { f32x4 v0 = acc[ai][bj][m][0], v1 = acc[ai][bj][m][1];
                        if (act != 0) {
#pragma unroll
                            for (int i = 0; i < 4; ++i) { const float s0 = sigmoid_f(v0[i]), s1 = sigmoid_f(v1[i]); v0[i] = act == 1 ? v0[i] * s0 : s0; v1[i] = act == 1 ? v1[i] * s1 : s1; } }
                        *(u32x4*)(base + (size_t)row * ldc + colt + bj * HALF + wc * 32 + 8 * fq) = pack8(v0, v1); } }
        }
    }
};

__device__ __forceinline__ float rs_from(const float* p, int n, float inv_d, float eps) { float s = 0.f; for (int i = 0; i < n; ++i) s += p[i]; return 1.0f / sqrtf(s * inv_d + eps); }

struct EpiQ {
    static constexpr bool PERM = true, AFTER_DRAIN = false;
    bf16_t *QN, *QR; const float *ssq_q, *C64, *S64; float qscale;
    __device__ __forceinline__ void operator()(const f32x4 (&acc)[2][2][4][2], const Unit& u, int wr, int wc, int fr, int fq) const {
        const int pn = u.pn, row0 = u.pm * BM + wr * 64 + fr;
#pragma unroll
        for (int ai = 0; ai < 2; ++ai)
#pragma unroll
            for (int m = 0; m < 4; ++m) { const int row = row0 + ai * HALF + m * 16;
                const f32x4 q0 = *(const f32x4*)(ssq_q + (size_t)row * 8), q1 = *(const f32x4*)(ssq_q + (size_t)row * 8 + 4);
                const float ss = ((q0[0] + q0[1]) + (q0[2] + q0[3])) + ((q1[0] + q1[1]) + (q1[2] + q1[3]));
                const float f = qscale / sqrtf(ss * (1.f / 512.f) + 1e-6f);
                if (pn < 4) {
#pragma unroll
                    for (int bj = 0; bj < 2; ++bj) *(u32x4*)(QN + (size_t)row * 1024 + pn * 256 + bj * HALF + wc * 32 + 8 * fq) = pack8(acc[ai][bj][m][0] * f, acc[ai][bj][m][1] * f);
                } else {
                    const int pos = 16 + (row & (TOK - 1)), j0 = 16 * (wc & 1) + 4 * fq;
                    const f32x4 c = *(const f32x4*)(C64 + pos * 32 + j0), s = *(const f32x4*)(S64 + pos * 32 + j0);
#pragma unroll
                    for (int bj = 0; bj < 2; ++bj) { const int head = (pn - 4) * 4 + bj * 2 + (wc >> 1);
                        const f32x4 t1 = acc[ai][bj][m][0] * f, t2 = acc[ai][bj][m][1] * f;
                        bf16_t* o = QR + (size_t)row * 512 + head * 64 + j0;
                        *(u32x2*)o = pack4(t1 * c - t2 * s); *(u32x2*)(o + 32) = pack4(t1 * s + t2 * c); }
                }
            }
    }
};
struct EpiK {
    static constexpr bool PERM = true, AFTER_DRAIN = false;
    bf16_t* KN; const float* ssq_kv;
    __device__ __forceinline__ void operator()(const f32x4 (&acc)[2][2][4][2], const Unit& u, int wr, int wc, int fr, int fq) const {
        const int pn = u.pn, row0 = u.pm * BM + wr * 64 + fr;
#pragma unroll
        for (int ai = 0; ai < 2; ++ai)
#pragma unroll
            for (int m = 0; m < 4; ++m) { const int row = row0 + ai * HALF + m * 16, b = row >> 12, t = row & (TOK - 1);
                const f32x4 q0 = *(const f32x4*)(ssq_kv + (size_t)row * 4);
                const float f = 1.0f / sqrtf(((q0[0] + q0[1]) + (q0[2] + q0[3])) * (1.f / 256.f) + 1e-6f);
#pragma unroll
                for (int bj = 0; bj < 2; ++bj) *(u32x4*)(KN + (size_t)(b * KSEQ + KOFF + t) * 1024 + pn * 256 + bj * HALF + wc * 32 + 8 * fq) = pack8(acc[ai][bj][m][0] * f, acc[ai][bj][m][1] * f);
                asm volatile("" ::: "memory"); }
    }
};
struct EpiVT {
    static constexpr bool PERM = true, AFTER_DRAIN = false;
    bf16_t* VT; const float* ssq_kv;
    __device__ __forceinline__ void operator()(const f32x4 (&acc)[2][2][4][2], const Unit& u, int wr, int wc, int fr, int fq) const {
        const int pn = u.pn, row0 = u.pm * BM + wr * 64 + fr;
#pragma unroll
        for (int bj = 0; bj < 2; ++bj) { const int col = pn * 256 + bj * HALF + wc * 32 + 8 * fq, b = col >> 12, t = col & (TOK - 1);
            f32x4 f0, f1;
#pragma unroll
            for (int i = 0; i < 4; ++i) { const f32x4 a = *(const f32x4*)(ssq_kv + (size_t)(col + i) * 4);
                f0[i] = 1.0f / sqrtf(((a[0] + a[1]) + (a[2] + a[3])) * (1.f / 256.f) + 1e-6f); asm volatile("" : "+v"(f0[i]) :: "memory"); }
#pragma unroll
            for (int i = 0; i < 4; ++i) { const f32x4 c = *(const f32x4*)(ssq_kv + (size_t)(col + 4 + i) * 4);
                f1[i] = 1.0f / sqrtf(((c[0] + c[1]) + (c[2] + c[3])) * (1.f / 256.f) + 1e-6f); asm volatile("" : "+v"(f1[i]) :: "memory"); }
#pragma unroll
            for (int ai = 0; ai < 2; ++ai)
#pragma unroll
                for (int m = 0; m < 4; ++m) { const int row = row0 + ai * HALF + m * 16;
                    *(u32x4*)(VT + (size_t)row * (8 * KSEQ) + b * KSEQ + KOFF + t) = pack8(acc[ai][bj][m][0] * f0, acc[ai][bj][m][1] * f1); } }
    }
};
template <int PASS> struct EpiMerge {
    static constexpr bool PERM = true, AFTER_DRAIN = false;
    bf16_t* MG; const bf16_t* GATES;
    __device__ __forceinline__ void operator()(const f32x4 (&acc)[2][2][4][2], const Unit& u, int wr, int wc, int fr, int fq) const {
        const int pn = u.pn, row0 = u.pm * BM + wr * 64 + fr;
#pragma unroll
        for (int ai = 0; ai < 2; ++ai)
#pragma unroll
            for (int m = 0; m < 4; ++m) { const int row = row0 + ai * HALF + m * 16;
#pragma unroll
                for (int bj = 0; bj < 2; ++bj) { const int col = pn * 256 + bj * HALF + wc * 32 + 8 * fq;
                    f32x4 g0, g1; unpack8(*(const u32x4*)(GATES + (size_t)row * 4096 + PASS * 2048 + col), g0, g1);
                    f32x4 v0 = acc[ai][bj][m][0] * g0, v1 = acc[ai][bj][m][1] * g1;
                    if (PASS == 1) { f32x4 p0, p1; unpack8(*(const u32x4*)(MG + (size_t)row * 2048 + col), p0, p1); v0 += p0; v1 += p1; }
                    *(u32x4*)(MG + (size_t)row * 2048 + col) = pack8(v0, v1); } }
    }
};
struct EpiOut {
    static constexpr bool PERM = true, AFTER_DRAIN = false;
    const float* X; float* OUT; float* ssq_o;
    __device__ __forceinline__ void operator()(const f32x4 (&acc)[2][2][4][2], const Unit& u, int wr, int wc, int fr, int fq) const {
        const int pn = u.pn, row0 = u.pm * BM + wr * 64 + fr;
#pragma unroll
        for (int ai = 0; ai < 2; ++ai)
#pragma unroll
            for (int m = 0; m < 4; ++m) { const int row = row0 + ai * HALF + m * 16; float s = 0.f;
#pragma unroll
                for (int bj = 0; bj < 2; ++bj) { const size_t off = (size_t)row * 2048 + pn * 256 + bj * HALF + wc * 32 + 8 * fq;
                    const f32x4 v0 = acc[ai][bj][m][0] + *(const f32x4*)(X + off), v1 = acc[ai][bj][m][1] + *(const f32x4*)(X + off + 4);
                    s += (v0[0] * v0[0] + v0[1] * v0[1]) + (v0[2] * v0[2] + v0[3] * v0[3]) + (v1[0] * v1[0] + v1[1] * v1[1]) + (v1[2] * v1[2] + v1[3] * v1[3]);
                    *(f32x4*)(OUT + off) = v0; *(f32x4*)(OUT + off + 4) = v1; }
                s += __shfl_xor(s, 16); s += __shfl_xor(s, 32);
                if (fq == 0) ssq_o[(size_t)row * 32 + pn * 4 + wc] = s; }
    }
};
template <class Epi, class Sched, bool ALIGN_EPI = false, bool SP2 = false>
__device__ __forceinline__ void gemm_phase(PG8_LAS unsigned char* lds, const Gemm g, const Sched& S, const Epi& E) {
    int tid = threadIdx.x; asm volatile("" : "+v"(tid));
    const int wid = __builtin_amdgcn_readfirstlane(tid >> 6), lane = tid & 63, wr = wid >> 2, wc = wid & 3, fr = lane & 15, fq = lane >> 4;
    const int K = g.K, nt = K / BK;
    unsigned voffA[2], voffB[2];
#pragma unroll
    for (int i = 0; i < 2; ++i) { int R, C; stage_rc(tid * 16 + i * 8192, R, C); const int Rb = Epi::PERM ? ((R & ~31) + perm32(R & 31)) : R;
        voffA[i] = (unsigned)(R * K + C) * 2u; voffB[i] = (unsigned)(Rb * K + C) * 2u; }
    const size_t kstep = (size_t)(BK * 2);
    const size_t hstep = (size_t)HALF * K * 2;
    const size_t tstep = 2 * hstep;
    const unsigned ldsw = (unsigned)wid * 1024u;
    const int aoff = lds_byte(wr * 64 + fr, fq * 8), boff = lds_byte(wc * 32 + fr, fq * 8);
#define PG8_SA(b, h) (((b) * 2 + (h)) * HTB)
#define PG8_SB(b, h) ((4 + (b) * 2 + (h)) * HTB)
#define PG8_STAGE(bufoff, gbase, voff) do { _Pragma("unroll") for (int _i = 0; _i < 2; ++_i) \
        __builtin_amdgcn_global_load_lds((const unsigned*)((const char*)(gbase) + (voff)[_i]), (PG8_LAS unsigned*)(lds + (bufoff) + ldsw + _i * 8192), 16, 0, 0); } while (0)
#define PG8_LDA(dst, b, h) do { _Pragma("unroll") for (int m = 0; m < 4; ++m) _Pragma("unroll") for (int k = 0; k < 2; ++k) dst[m][k] = *(const PG8_LAS bf16x8*)(lds + PG8_SA(b, h) + aoff + m * 2048 + k * 1024); } while (0)
#define PG8_LDB(dst, b, h) do { _Pragma("unroll") for (int n = 0; n < 2; ++n) _Pragma("unroll") for (int k = 0; k < 2; ++k) dst[n][k] = *(const PG8_LAS bf16x8*)(lds + PG8_SB(b, h) + boff + n * 2048 + k * 1024); } while (0)
#define PG8_MMA(ai, bj, At, Bt) do { __builtin_amdgcn_s_setprio(1); _Pragma("unroll") for (int m = 0; m < 4; ++m) _Pragma("unroll") for (int n = 0; n < 2; ++n) _Pragma("unroll") for (int k = 0; k < 2; ++k) \
        acc[ai][bj][m][n] = __builtin_amdgcn_mfma_f32_16x16x32_bf16(Bt[n][k], At[m][k], acc[ai][bj][m][n], 0, 0, 0); __builtin_amdgcn_s_setprio(0); } while (0)
#define PG8_WAIT_V(n) asm volatile("s_waitcnt vmcnt(" #n ")" ::: "memory")
#define PG8_WAIT_L(n) asm volatile("s_waitcnt lgkmcnt(" #n ")" ::: "memory")
#define PG8_BAR __builtin_amdgcn_s_barrier()
#define PG8_SCHED __builtin_amdgcn_sched_barrier(0)
    Unit cur, nxt; int ui = 0;
    if (!S.next(0, cur)) return;
    f32x4 acc[2][2][4][2];
#pragma unroll
    for (int a = 0; a < 2; ++a)
#pragma unroll
        for (int b = 0; b < 2; ++b)
#pragma unroll
            for (int m = 0; m < 4; ++m)
#pragma unroll
                for (int n = 0; n < 2; ++n) acc[a][b][m][n] = (f32x4){0.f, 0.f, 0.f, 0.f};
    bf16x8 At[4][2], B0[2][2], B1[2][2];
    const char* cA = (const char*)g.A + (size_t)cur.pm * tstep; const char* cB = (const char*)g.Bt + (size_t)cur.pn * tstep;
    S.a_ready(cur);
    if constexpr (SP2) {
        PG8_STAGE(PG8_SB(0, 0), cB, voffB); PG8_STAGE(PG8_SB(0, 1), cB + hstep, voffB); PG8_STAGE(PG8_SA(0, 0), cA, voffA); PG8_STAGE(PG8_SA(0, 1), cA + hstep, voffA);
        if (wr == 1) PG8_BAR;
        PG8_WAIT_V(2); PG8_BAR;
        PG8_STAGE(PG8_SB(1, 0), cB + kstep, voffB); PG8_STAGE(PG8_SA(1, 0), cA + kstep, voffA); PG8_STAGE(PG8_SB(1, 1), cB + hstep + kstep, voffB);
        PG8_WAIT_V(6); PG8_BAR;
    } else {
        PG8_STAGE(PG8_SB(0, 0), cB, voffB); PG8_STAGE(PG8_SA(0, 0), cA, voffA); PG8_STAGE(PG8_SB(0, 1), cB + hstep, voffB); PG8_STAGE(PG8_SA(0, 1), cA + hstep, voffA);
        if (wr == 1) PG8_BAR;
        PG8_WAIT_V(4); PG8_BAR;
        PG8_STAGE(PG8_SB(1, 0), cB + kstep, voffB); PG8_STAGE(PG8_SA(1, 0), cA + kstep, voffA); PG8_STAGE(PG8_SB(1, 1), cB + hstep + kstep, voffB);
        PG8_WAIT_V(6); PG8_BAR;
    }
    for (;;) {
        const bool has_next = S.next(ui + 1, nxt);
        const char* nA = has_next ? (const char*)g.A + (size_t)nxt.pm * tstep : cA; const char* nB = has_next ? (const char*)g.Bt + (size_t)nxt.pn * tstep : cB;
#pragma nounroll
        for (int t = 0; t < nt; t += 2) {
            const bool last = (t == nt - 2);
            const char* a1 = cA + (size_t)(t + 1) * kstep;
            const char* a2 = last ? nA : cA + (size_t)(t + 2) * kstep; const char* b2 = last ? nB : cB + (size_t)(t + 2) * kstep;
            const char* a3 = a2 + kstep; const char* b3 = b2 + kstep;
            if (last && has_next) S.a_ready(nxt);
            if constexpr (SP2) {
            PG8_LDB(B0, 0, 0); PG8_LDB(B1, 0, 1); PG8_SCHED; PG8_LDA(At, 0, 0); PG8_STAGE(PG8_SA(1, 1), a1 + hstep, voffA);
            PG8_WAIT_V(8); PG8_WAIT_L(0); PG8_BAR; PG8_MMA(0, 0, At, B0); PG8_MMA(0, 1, At, B1); PG8_BAR; PG8_SCHED;
            PG8_LDA(At, 0, 1); PG8_STAGE(PG8_SB(0, 0), b2, voffB); PG8_STAGE(PG8_SB(0, 1), b2 + hstep, voffB); PG8_STAGE(PG8_SA(0, 0), a2, voffA);
            PG8_WAIT_V(8); PG8_WAIT_L(0); PG8_BAR; PG8_MMA(1, 0, At, B0); PG8_MMA(1, 1, At, B1); PG8_BAR; PG8_SCHED;
            PG8_LDB(B0, 1, 0); PG8_LDB(B1, 1, 1); PG8_SCHED; PG8_LDA(At, 1, 0); PG8_STAGE(PG8_SA(0, 1), a2 + hstep, voffA);
            PG8_WAIT_V(8); PG8_WAIT_L(0); PG8_BAR; PG8_MMA(0, 0, At, B0); PG8_MMA(0, 1, At, B1); PG8_BAR; PG8_SCHED;
            PG8_LDA(At, 1, 1); PG8_STAGE(PG8_SB(1, 0), b3, voffB); PG8_STAGE(PG8_SB(1, 1), b3 + hstep, voffB); PG8_STAGE(PG8_SA(1, 0), a3, voffA);
            PG8_WAIT_V(8); PG8_WAIT_L(0); PG8_BAR; PG8_MMA(1, 0, At, B0); PG8_MMA(1, 1, At, B1); PG8_BAR; PG8_SCHED;
            } else {
            PG8_LDB(B0, 0, 0); PG8_SCHED; PG8_LDA(At, 0, 0); PG8_STAGE(PG8_SA(1, 1), a1 + hstep, voffA);
            PG8_WAIT_L(8); PG8_BAR; PG8_WAIT_L(0); PG8_MMA(0, 0, At, B0); PG8_BAR; PG8_SCHED;
            PG8_LDB(B1, 0, 1); PG8_STAGE(PG8_SB(0, 0), b2, voffB);
            PG8_BAR; PG8_WAIT_L(0); PG8_MMA(0, 1, At, B1); PG8_BAR;
            PG8_LDA(At, 0, 1); PG8_STAGE(PG8_SA(0, 0), a2, voffA);
            PG8_BAR; PG8_WAIT_L(0); PG8_MMA(1, 0, At, B0); PG8_BAR; PG8_SCHED;
            PG8_STAGE(PG8_SB(0, 1), b2 + hstep, voffB);
            PG8_WAIT_V(6); PG8_BAR; PG8_MMA(1, 1, At, B1); PG8_BAR;
            PG8_LDB(B0, 1, 0); PG8_SCHED; PG8_LDA(At, 1, 0); PG8_STAGE(PG8_SA(0, 1), a2 + hstep, voffA);
            PG8_WAIT_L(8); PG8_BAR; PG8_WAIT_L(0); PG8_MMA(0, 0, At, B0); PG8_BAR; PG8_SCHED;
            PG8_LDB(B1, 1, 1); PG8_STAGE(PG8_SB(1, 0), b3, voffB);
            PG8_BAR; PG8_WAIT_L(0); PG8_MMA(0, 1, At, B1); PG8_BAR;
            PG8_LDA(At, 1, 1); PG8_STAGE(PG8_SA(1, 0), a3, voffA);
            PG8_BAR; PG8_WAIT_L(0); PG8_MMA(1, 0, At, B0); PG8_BAR; PG8_SCHED;
            PG8_STAGE(PG8_SB(1, 1), b3 + hstep, voffB);
            PG8_WAIT_V(6); PG8_BAR; PG8_MMA(1, 1, At, B1); PG8_BAR;
            }
        }
        if constexpr (ALIGN_EPI) { if (wr == 0) PG8_BAR; }
        if constexpr (!Epi::AFTER_DRAIN) { E(acc, cur, wr, wc, fr, fq); S.done(cur); }
        if (!has_next) break;
#pragma unroll
        for (int a = 0; a < 2; ++a)
#pragma unroll
            for (int b = 0; b < 2; ++b)
#pragma unroll
                for (int m = 0; m < 4; ++m)
#pragma unroll
                    for (int n = 0; n < 2; ++n) acc[a][b][m][n] = (f32x4){0.f, 0.f, 0.f, 0.f};
        cur = nxt; cA = nA; cB = nB; ++ui;
        if constexpr (ALIGN_EPI) { if (wr == 1) PG8_BAR; }
    }
    PG8_WAIT_V(0);
    if constexpr (!ALIGN_EPI) { if (wr == 0) PG8_BAR; }
    PG8_BAR;
    if constexpr (Epi::AFTER_DRAIN) { E.fused(acc, cur, wr, wc, fr, fq, lds, wid, lane); S.done(cur); }
#undef PG8_SA
#undef PG8_SB
#undef PG8_STAGE
#undef PG8_LDA
#undef PG8_LDB
#undef PG8_MMA
#undef PG8_WAIT_V
#undef PG8_WAIT_L
#undef PG8_BAR
#undef PG8_SCHED
}
}
namespace cg = cooperative_groups;
#define LAS __attribute__((address_space(3)))
typedef unsigned short bf16;
using pg8::f32x4; using pg8::bf16x8; using pg8::u32x4; using pg8::u32x2; using pg8::cvt_pk_bf16; using pg8::bf2f;
typedef float f32x16 __attribute__((ext_vector_type(16)));
typedef short s16x4 __attribute__((ext_vector_type(4)));
using pg8::TOK; using pg8::KSEQ; using pg8::KOFF;
constexpr int NB = 8, M = NB * TOK, D = 2048, NIN = 10048, NINP = 10240, NPOS = 4112;
constexpr int NWAVES = 8, NTHR = 512, LDS_BYTES = 147456, QWORD_OFF = 147200;
constexpr int NMP = 2368;
constexpr float NORM_EPS = 1e-6f, GN_EPS = 1e-5f;

struct Args { const float* in[14]; float* out; unsigned char* ws; };

__device__ __forceinline__ unsigned f2bf(float f) { unsigned u = __float_as_uint(f); return (u + 0x7fffu + ((u >> 16) & 1u)) >> 16; }
__device__ __forceinline__ unsigned pk2(float lo, float hi) { return f2bf(lo) | (f2bf(hi) << 16); }
__device__ __forceinline__ float wave_sum(float v) {
#pragma unroll
    for (int o = 1; o < 64; o <<= 1) v += __shfl_xor(v, o);
    return v;
}
__device__ __forceinline__ float head_lg2(int h) { return pg8::head_lg2(h); }

__device__ __forceinline__ int src_in(int n) {
    if (n < 768) return n;
    if (n < 1024) { const int p = n - 768; if (p >= 64) return -1; const int wc = p >> 5, fq = (p >> 3) & 3, nn = (p >> 2) & 1, i = p & 3; return 768 + 32 * nn + 16 * wc + 4 * fq + i; }
    if (n < 2048) return 832 + (n - 1024);
    if (n < 4096) { const int q = n - 2048, hb = q >> 7, p = q & 127, wc = p >> 5, fq = (p >> 3) & 3, nn = (p >> 2) & 1, i = p & 3; return 1856 + hb * 128 + 64 * nn + 16 * wc + 4 * fq + i; }
    if (n < 6144) return 3904 + (n - 4096);
    return 5952 + (n - 6144);
}
__device__ __forceinline__ int src_uq(int n) {
    if (n < 1024) return (n >> 7) * 192 + (n & 127);
    const int q = n - 1024, blk = q >> 7, p = q & 127, wc = p >> 5, fq = (p >> 3) & 3, nn = (p >> 2) & 1, i = p & 3;
    return (2 * blk + (wc >> 1)) * 192 + 128 + 32 * nn + 16 * (wc & 1) + 4 * fq + i;
}
template <int KIND> __device__ __forceinline__ void p0_item(const float* W, int ldw, int K, bf16* WT, const float* ksc, int item, int nblk, LAS float* scr, int lane) {
    const int kb = item / nblk, nb = item % nblk, k0 = 64 * kb, n0 = 32 * nb, nl = lane & 31;
    int sc;
    if (KIND == 0) sc = n0 + nl; else if (KIND == 1) sc = src_in(n0 + nl); else if (KIND == 2) sc = src_uq(n0 + nl);
    else if (KIND == 3) sc = ((n0 + nl) >> 7) * 256 + ((n0 + nl) & 127); else sc = ((n0 + nl) >> 7) * 256 + 128 + ((n0 + nl) & 127);
#pragma unroll 8
    for (int i = 0; i < 32; ++i) { const int kk = 2 * i + (lane >> 5); float v = sc >= 0 ? W[(size_t)(k0 + kk) * ldw + sc] : 0.f; if (ksc) v *= ksc[k0 + kk]; scr[kk * 33 + nl] = v; }
    asm volatile("s_waitcnt lgkmcnt(0)" ::: "memory");
    const int c = lane & 7;
#pragma unroll
    for (int j = 0; j < 4; ++j) { const int n = (lane >> 3) + 8 * j; const LAS float* s = scr + (8 * c) * 33 + n;
        u32x4 o; o.x = pk2(s[0 * 33], s[1 * 33]); o.y = pk2(s[2 * 33], s[3 * 33]); o.z = pk2(s[4 * 33], s[5 * 33]); o.w = pk2(s[6 * 33], s[7 * 33]);
        *(u32x4*)(WT + (size_t)(n0 + n) * K + k0 + 8 * c) = o; }
    asm volatile("s_waitcnt lgkmcnt(0)" ::: "memory");
}

struct Ptrs {
    const Args* a; unsigned char* ws;
    __device__ __forceinline__ const float* x() const { return a->in[0]; }
    __device__ __forceinline__ const float* meta() const { return a->in[1]; }
    __device__ __forceinline__ const float* norm_w() const { return a->in[2]; }
    __device__ __forceinline__ const float* w_in() const { return a->in[3]; }
    __device__ __forceinline__ const float* qnw() const { return a->in[4]; }
    __device__ __forceinline__ const float* w_uq() const { return a->in[5]; }
    __device__ __forceinline__ const float* kvnw() const { return a->in[6]; }
    __device__ __forceinline__ const float* w_ukv() const { return a->in[7]; }
    __device__ __forceinline__ const float* gnw() const { return a->in[8]; }
    __device__ __forceinline__ const float* gnb() const { return a->in[9]; }
    __device__ __forceinline__ const float* w_bm() const { return a->in[10]; }
    __device__ __forceinline__ const float* w_br() const { return a->in[11]; }
    __device__ __forceinline__ const float* w_out() const { return a->in[12]; }
    __device__ __forceinline__ const float* fnw() const { return a->in[13]; }
    __device__ __forceinline__ float* out() const { return a->out; }
    __device__ __forceinline__ bf16* WIN() const { return (bf16*)(ws + WS_WIN); }
    __device__ __forceinline__ bf16* WUQ() const { return (bf16*)(ws + WS_WUQ); }
    __device__ __forceinline__ bf16* WUK() const { return (bf16*)(ws + WS_WUK); }
    __device__ __forceinline__ bf16* WUV() const { return (bf16*)(ws + WS_WUV); }
    __device__ __forceinline__ bf16* WBM() const { return (bf16*)(ws + WS_WBM); }
    __device__ __forceinline__ bf16* WBR() const { return (bf16*)(ws + WS_WBR); }
    __device__ __forceinline__ bf16* WOUT() const { return (bf16*)(ws + WS_WOUT); }
    __device__ __forceinline__ bf16* KR() const { return (bf16*)(ws + WS_KR); }
    __device__ __forceinline__ bf16* XN() const { return (bf16*)(ws + WS_XN); }
    __device__ __forceinline__ bf16* QN() const { return (bf16*)(ws + WS_QN); }
    __device__ __forceinline__ bf16* QR() const { return (bf16*)(ws + WS_QR); }
    __device__ __forceinline__ bf16* CQ() const { return (bf16*)(ws + WS_CQ); }
    __device__ __forceinline__ bf16* CKV() const { return (bf16*)(ws + WS_CKV); }
    __device__ __forceinline__ bf16* ZMLA() const { return (bf16*)(ws + WS_ZMLA); }
    __device__ __forceinline__ bf16* RQ() const { return (bf16*)(ws + WS_RQ); }
    __device__ __forceinline__ bf16* RK() const { return (bf16*)(ws + WS_RK); }
    __device__ __forceinline__ bf16* MG() const { return (bf16*)(ws + WS_MG); }
    __device__ __forceinline__ bf16* RV() const { return (bf16*)(ws + WS_RV); }
    __device__ __forceinline__ bf16* ZRET() const { return (bf16*)(ws + WS_ZRET); }
    __device__ __forceinline__ bf16* GATES() const { return (bf16*)(ws + WS_GATES); }
    __device__ __forceinline__ bf16* KN() const { return (bf16*)(ws + WS_KN); }
    __device__ __forceinline__ bf16* VT() const { return (bf16*)(ws + WS_VT); }
    __device__ __forceinline__ float* C128() const { return (float*)(ws + WS_C128); }
    __device__ __forceinline__ float* S128() const { return (float*)(ws + WS_S128); }
    __device__ __forceinline__ float* C64() const { return (float*)(ws + WS_C64); }
    __device__ __forceinline__ float* S64() const { return (float*)(ws + WS_S64); }
    __device__ __forceinline__ float* MP() const { return (float*)(ws + WS_MP); }
    __device__ __forceinline__ float* R0() const { return (float*)(ws + WS_R0); }
    __device__ __forceinline__ float* SSQQ() const { return (float*)(ws + WS_SSQQ); }
    __device__ __forceinline__ float* SSQKV() const { return (float*)(ws + WS_SSQKV); }
    __device__ __forceinline__ float* SSQO() const { return (float*)(ws + WS_SSQO); }
    __device__ __forceinline__ unsigned* ctl() const { return (unsigned*)(ws + WS_CTL); }
};

__device__ __forceinline__ void p0_prologue(const Ptrs& P, LAS unsigned char* lds, int tid, int lane, int wave) {
    const int G = gridDim.x, bx = blockIdx.x;
    const int gtid = bx * NTHR + tid, NT = G * NTHR;
    if (gtid == 0) { P.ctl()[0] = 0u; P.ctl()[64] = 0u; }
    for (int i = gtid; i < NB * 48 * 512; i += NT) { const int b = i / (48 * 512), r = i % (48 * 512); ((unsigned*)(P.KN() + (size_t)b * KSEQ * 1024))[r] = 0u; }
    for (int i = gtid; i < NB * 48 * 32; i += NT) { const int b = i / (48 * 32), r = i % (48 * 32); ((unsigned*)(P.KR() + (size_t)b * KSEQ * 64))[r] = 0u; }
    for (int i = gtid; i < 1024 * NB * 24; i += NT) { const int row = i / (NB * 24), r = i % (NB * 24), b = r / 24, c = r % 24; ((unsigned*)(P.VT() + (size_t)row * (NB * KSEQ) + b * KSEQ))[c] = 0u; }
    for (int i = gtid; i < NPOS * 96; i += NT) { const int pos = i / 96, j = i % 96;
        const double e = j < 64 ? (double)j / 64.0 : (double)(j - 64) / 32.0;
        const float inv = (float)exp2(-e * 13.287712379549449); const float ang = (float)pos * inv;
        const double rev = (double)ang * 0.15915494309189535; const float a = (float)((rev - rint(rev)) * 6.283185307179586);
        const float c = cosf(a), s = sinf(a);
        if (j < 64) { P.C128()[pos * 64 + j] = c; P.S128()[pos * 64 + j] = s; } else { P.C64()[pos * 32 + j - 64] = c; P.S64()[pos * 32 + j - 64] = s; } }
    if (bx < NMP / 64) {
        LAS float* mx = (LAS float*)lds;
        for (int rr = 0; rr < 2; ++rr) { const int row = 2 * wave + rr; f32x4 v[8]; float ss = 0.f;
#pragma unroll
            for (int j = 0; j < 8; ++j) { v[j] = *(const f32x4*)(P.meta() + (size_t)row * D + 4 * lane + 256 * j); ss += (v[j][0] * v[j][0] + v[j][1] * v[j][1]) + (v[j][2] * v[j][2] + v[j][3] * v[j][3]); }
            const float rs = 1.0f / sqrtf(wave_sum(ss) * (1.f / D) + NORM_EPS);
#pragma unroll
            for (int j = 0; j < 8; ++j) { const f32x4 w = *(const f32x4*)(P.norm_w() + 4 * lane + 256 * j); *(LAS f32x4*)(mx + row * D + 4 * lane + 256 * j) = v[j] * rs * w; } }
        __syncthreads();
        const int q = 64 * bx + lane, orig = q < 320 ? 512 + q : 2880 + (q - 320);
        float acc[16];
#pragma unroll
        for (int i = 0; i < 16; ++i) acc[i] = 0.f;
        for (int k = 256 * wave; k < 256 * wave + 256; k += 4) {
            float wv[4];
#pragma unroll
            for (int kk = 0; kk < 4; ++kk) wv[kk] = P.w_in()[(size_t)(k + kk) * NIN + orig];
#pragma unroll
            for (int i = 0; i < 16; ++i) { const f32x4 m4 = *(const LAS f32x4*)(mx + i * D + k); acc[i] += (m4[0] * wv[0] + m4[1] * wv[1]) + (m4[2] * wv[2] + m4[3] * wv[3]); } }
        __syncthreads();
        LAS float* red = (LAS float*)lds;
#pragma unroll
        for (int i = 0; i < 16; ++i) red[(wave * 16 + i) * 64 + lane] = acc[i];
        __syncthreads();
        for (int o = tid; o < 1024; o += NTHR) { float s = 0.f;
#pragma unroll
            for (int w = 0; w < 8; ++w) s += red[w * 1024 + o];
            P.MP()[(o >> 6) * NMP + 64 * bx + (o & 63)] = s; }
        __syncthreads();
    }
    LAS float* scr = (LAS float*)(lds + wave * 16384);
    const int gw = bx * NWAVES + wave, NGW = G * NWAVES;
    constexpr int I_IN = 32 * 320, I_UQ = 8 * 48, I_UK = 4 * 32, I_B = 16 * 64, I_O = 32 * 64;
    constexpr int NITEMS = I_IN + I_UQ + 2 * I_UK + 2 * I_B + I_O;
    for (int it = gw; it < NITEMS; it += NGW) { int r = it;
        if (r < I_IN) { p0_item<1>(P.w_in(), NIN, D, P.WIN(), nullptr, r, 320, scr, lane); continue; } r -= I_IN;
        if (r < I_UQ) { p0_item<2>(P.w_uq(), 1536, 512, P.WUQ(), P.qnw(), r, 48, scr, lane); continue; } r -= I_UQ;
        if (r < I_UK) { p0_item<3>(P.w_ukv(), 2048, 256, P.WUK(), P.kvnw(), r, 32, scr, lane); continue; } r -= I_UK;
        if (r < I_UK) { p0_item<4>(P.w_ukv(), 2048, 256, P.WUV(), P.kvnw(), r, 32, scr, lane); continue; } r -= I_UK;
        if (r < I_B) { p0_item<0>(P.w_bm(), D, 1024, P.WBM(), nullptr, r, 64, scr, lane); continue; } r -= I_B;
        if (r < I_B) { p0_item<0>(P.w_br(), D, 1024, P.WBR(), nullptr, r, 64, scr, lane); continue; } r -= I_B;
        p0_item<0>(P.w_out(), D, D, P.WOUT(), nullptr, r, 64, scr, lane); }
    for (int m = gw; m < M; m += NGW) { const float* xr = P.x() + (size_t)m * D; f32x4 v[8]; float ss = 0.f;
#pragma unroll
        for (int j = 0; j < 8; ++j) { v[j] = *(const f32x4*)(xr + 4 * lane + 256 * j); ss += (v[j][0] * v[j][0] + v[j][1] * v[j][1]) + (v[j][2] * v[j][2] + v[j][3] * v[j][3]); }
        const float rs = 1.0f / sqrtf(wave_sum(ss) * (1.f / D) + NORM_EPS);
#pragma unroll
        for (int j = 0; j < 8; ++j) { const f32x4 w = *(const f32x4*)(P.norm_w() + 4 * lane + 256 * j); const f32x4 o = v[j] * rs * w;
            u32x2 pk; pk.x = pk2(o[0], o[1]); pk.y = pk2(o[2], o[3]); *(u32x2*)(P.XN() + (size_t)m * D + 4 * lane + 256 * j) = pk; } }
}

__device__ __forceinline__ void meta_stage2(const Ptrs& P, int tid) {
    const int gtid = blockIdx.x * NTHR + tid, NT = gridDim.x * NTHR;
    for (int idx = gtid; idx < 8 * 128 * 128; idx += NT) { const int h = idx >> 14, d = (idx >> 7) & 127, e = idx & 127, j = d & 63; const float lg2 = head_lg2(h); float s = 0.f;
        for (int i = 0; i < 16; ++i) { const float k1 = P.MP()[i * NMP + 320 + h * 128 + j], k2 = P.MP()[i * NMP + 320 + h * 128 + j + 64], c = P.C128()[i * 64 + j], sn = P.S128()[i * 64 + j];
            const float kd = d < 64 ? k1 * c - k2 * sn : k1 * sn + k2 * c;
            s += kd * 0.08838834764831845f * exp2f(lg2 * (float)(15 - i)) * P.MP()[i * NMP + 1344 + h * 128 + e]; }
        P.R0()[idx] = s; }
    if (gtid < 2048) { const int n = gtid, head = n >> 8, wi = n & 255; float dot[16], ss[16];
#pragma unroll
        for (int i = 0; i < 16; ++i) { dot[i] = 0.f; ss[i] = 0.f; }
        for (int k = 0; k < 256; ++k) { const float wv = P.w_ukv()[(size_t)k * 2048 + n] * P.kvnw()[k];
#pragma unroll
            for (int i = 0; i < 16; ++i) { const float c = P.MP()[i * NMP + k]; dot[i] += c * wv; ss[i] += c * c; } }
#pragma unroll
        for (int i = 0; i < 16; ++i) { const float v = dot[i] / sqrtf(ss[i] * (1.f / 256.f) + NORM_EPS); const bf16 bv = (bf16)f2bf(v);
            for (int b = 0; b < NB; ++b) { if (wi < 128) P.KN()[(size_t)(b * KSEQ + 48 + i) * 1024 + head * 128 + wi] = bv; else P.VT()[(size_t)(head * 128 + wi - 128) * (NB * KSEQ) + b * KSEQ + 48 + i] = bv; } }
    } else if (gtid < 2048 + 512) { const int idx = gtid - 2048, i = idx >> 5, j = idx & 31;
        const float t1 = P.MP()[i * NMP + 256 + j], t2 = P.MP()[i * NMP + 256 + 32 + j], c = P.C64()[i * 32 + j], s = P.S64()[i * 32 + j];
        const bf16 o1 = (bf16)f2bf(t1 * c - t2 * s), o2 = (bf16)f2bf(t1 * s + t2 * c);
        for (int b = 0; b < NB; ++b) { P.KR()[(size_t)(b * KSEQ + 48 + i) * 64 + j] = o1; P.KR()[(size_t)(b * KSEQ + 48 + i) * 64 + 32 + j] = o2; } }
}

constexpr int AT_KS = 400, AT_VS = 144, AT_KB = 64 * AT_KS, AT_VB = 128 * AT_VS, AT_BUF = AT_KB + AT_VB;
__device__ __forceinline__ void attn_unit(const Ptrs& P, LAS unsigned char* lds, int b, int h, int qb, int tid, int lane, int wave) {
    asm volatile("" : "+v"(tid), "+v"(lane));
    const int r = lane & 31, hh = lane >> 5;
    const int trow = 256 * qb + 32 * wave + r;
    const size_t row = (size_t)b * TOK + trow;
    bf16x8 qf[12];
#pragma unroll
    for (int s = 0; s < 8; ++s) qf[s] = *(const bf16x8*)(P.QN() + row * 1024 + h * 128 + 16 * s + 8 * hh);
#pragma unroll
    for (int s = 0; s < 4; ++s) qf[8 + s] = *(const bf16x8*)(P.QR() + row * 512 + h * 64 + 16 * s + 8 * hh);
    const int ntiles = 4 * qb + 5, kt_last = 4 * qb + 1 + (wave >> 1);
    f32x16 o[4];
#pragma unroll
    for (int e = 0; e < 4; ++e)
#pragma unroll
        for (int i = 0; i < 16; ++i) o[e][i] = 0.f;
    float mrun = -1e30f, lsum = 0.f;
    const bf16* kbase = P.KN() + (size_t)b * KSEQ * 1024 + h * 128; const bf16* rbase = P.KR() + (size_t)b * KSEQ * 64; const bf16* vbase = P.VT() + (size_t)(h * 128) * (NB * KSEQ) + (size_t)b * KSEQ;
    u32x4 kreg[3], vreg[2];
#define AT_LOAD(kt) do { _Pragma("unroll") for (int i = 0; i < 3; ++i) { const int c = tid + 512 * i, key = c / 24, cc = c % 24; \
            kreg[i] = cc < 16 ? *(const u32x4*)(kbase + (size_t)(64 * (kt) + key) * 1024 + cc * 8) : *(const u32x4*)(rbase + (size_t)(64 * (kt) + key) * 64 + (cc - 16) * 8); } \
        _Pragma("unroll") for (int i = 0; i < 2; ++i) { const int c = tid + 512 * i, e = c >> 3, cc = c & 7; vreg[i] = *(const u32x4*)(vbase + (size_t)e * (NB * KSEQ) + 64 * (kt) + cc * 8); } } while (0)
#define AT_STORE(buf) do { LAS unsigned char* kb_ = lds + (buf) * AT_BUF; LAS unsigned char* vb_ = kb_ + AT_KB; \
        _Pragma("unroll") for (int i = 0; i < 3; ++i) { const int c = tid + 512 * i, key = c / 24, cc = c % 24; *(LAS u32x4*)(kb_ + key * AT_KS + cc * 16) = kreg[i]; } \
        _Pragma("unroll") for (int i = 0; i < 2; ++i) { const int c = tid + 512 * i, e = c >> 3, cc = c & 7; *(LAS u32x4*)(vb_ + e * AT_VS + cc * 16) = vreg[i]; } } while (0)
    __syncthreads();
    AT_LOAD(0); AT_STORE(0);
    __syncthreads();
    for (int kt = 0; kt < ntiles; ++kt) {
        const bool more = kt + 1 < ntiles;
        if (more) AT_LOAD(kt + 1);
        if (kt <= kt_last) {
            const LAS unsigned char* kb = lds + (kt & 1) * AT_BUF; const LAS unsigned char* vb = kb + AT_KB;
            f32x16 p0, p1;
#pragma unroll
            for (int i = 0; i < 16; ++i) { p0[i] = 0.f; p1[i] = 0.f; }
#pragma unroll
            for (int s = 0; s < 12; ++s) { const bf16x8 a0 = *(const LAS bf16x8*)(kb + r * AT_KS + s * 32 + hh * 16), a1 = *(const LAS bf16x8*)(kb + (32 + r) * AT_KS + s * 32 + hh * 16);
                p0 = __builtin_amdgcn_mfma_f32_32x32x16_bf16(a0, qf[s], p0, 0, 0, 0); p1 = __builtin_amdgcn_mfma_f32_32x32x16_bf16(a1, qf[s], p1, 0, 0, 0);
                if ((s & 3) == 3) __builtin_amdgcn_sched_barrier(0); }
            if (kt == 0 || kt >= 4 * qb + 1) {
                const int kmax = KOFF + trow, k0 = 64 * kt + 4 * hh;
#pragma unroll
                for (int i = 0; i < 16; ++i) { const int kk = k0 + (i & 3) + 8 * (i >> 2); if (kk < 48 || kk > kmax) p0[i] = -1e30f; if (kk + 32 < 48 || kk + 32 > kmax) p1[i] = -1e30f; }
            }
            float mx = fmaxf(p0[0], p1[0]);
#pragma unroll
            for (int i = 1; i < 16; ++i) mx = fmaxf(mx, fmaxf(p0[i], p1[i]));
            mx = fmaxf(mx, __shfl_xor(mx, 32));
            const float mnew = fmaxf(mrun, mx), alpha = __builtin_amdgcn_exp2f(mrun - mnew); mrun = mnew;
            float ps = 0.f;
#pragma unroll
            for (int i = 0; i < 16; ++i) { p0[i] = __builtin_amdgcn_exp2f(p0[i] - mnew); p1[i] = __builtin_amdgcn_exp2f(p1[i] - mnew); ps += p0[i] + p1[i]; }
            lsum = lsum * alpha + ps;
#pragma unroll
            for (int e = 0; e < 4; ++e)
#pragma unroll
                for (int i = 0; i < 16; ++i) o[e][i] *= alpha;
#pragma unroll
            for (int s2 = 0; s2 < 4; ++s2) { u32x4 pw;
                if (s2 == 0) { pw.x = cvt_pk_bf16(p0[0], p0[1]); pw.y = cvt_pk_bf16(p0[2], p0[3]); pw.z = cvt_pk_bf16(p0[4], p0[5]); pw.w = cvt_pk_bf16(p0[6], p0[7]); }
                else if (s2 == 1) { pw.x = cvt_pk_bf16(p0[8], p0[9]); pw.y = cvt_pk_bf16(p0[10], p0[11]); pw.z = cvt_pk_bf16(p0[12], p0[13]); pw.w = cvt_pk_bf16(p0[14], p0[15]); }
                else if (s2 == 2) { pw.x = cvt_pk_bf16(p1[0], p1[1]); pw.y = cvt_pk_bf16(p1[2], p1[3]); pw.z = cvt_pk_bf16(p1[4], p1[5]); pw.w = cvt_pk_bf16(p1[6], p1[7]); }
                else { pw.x = cvt_pk_bf16(p1[8], p1[9]); pw.y = cvt_pk_bf16(p1[10], p1[11]); pw.z = cvt_pk_bf16(p1[12], p1[13]); pw.w = cvt_pk_bf16(p1[14], p1[15]); }
                const bf16x8 pb = __builtin_bit_cast(bf16x8, pw);
#pragma unroll
                for (int e = 0; e < 4; ++e) { const LAS unsigned char* vp = vb + (32 * e + r) * AT_VS + (16 * s2 + 4 * hh) * 2;
                    const s16x4 lo = *(const LAS s16x4*)vp, hi = *(const LAS s16x4*)(vp + 16);
                    const bf16x8 va = __builtin_shufflevector(lo, hi, 0, 1, 2, 3, 4, 5, 6, 7);
                    o[e] = __builtin_amdgcn_mfma_f32_32x32x16_bf16(va, pb, o[e], 0, 0, 0); }
                __builtin_amdgcn_sched_barrier(0); }
        }
        if (more) AT_STORE((kt + 1) & 1);
        __syncthreads();
    }
#undef AT_LOAD
#undef AT_STORE
    const float inv = 1.0f / (lsum + __shfl_xor(lsum, 32));
    bf16* yrow = P.ZMLA() + row * 1024 + h * 128;
#pragma unroll
    for (int e = 0; e < 4; ++e)
#pragma unroll
        for (int g = 0; g < 4; ++g) { bf16* p = yrow + 32 * e + 8 * g + 4 * hh; const u32x2 z = *(const u32x2*)p;
            const float z0 = __uint_as_float(z.x << 16), z1 = __uint_as_float(z.x & 0xffff0000u), z2 = __uint_as_float(z.y << 16), z3 = __uint_as_float(z.y & 0xffff0000u);
            u32x2 w; w.x = cvt_pk_bf16(o[e][4 * g] * inv * z0, o[e][4 * g + 1] * inv * z1); w.y = cvt_pk_bf16(o[e][4 * g + 2] * inv * z2, o[e][4 * g + 3] * inv * z3); *(u32x2*)p = w; }
}

constexpr int RT_S = 272, RT_T = 128 * RT_S;
typedef short v4i16_t __attribute__((ext_vector_type(4)));
__device__ __forceinline__ s16x4 tr_read(const LAS unsigned char* p) { return __builtin_bit_cast(s16x4, __builtin_amdgcn_ds_read_tr16_b64_v4i16((LAS v4i16_t*)p)); }
__device__ __forceinline__ void ret_unit(const Ptrs& P, LAS unsigned char* lds, int b, int h, int tid, int lane, int wave) {
    asm volatile("" : "+v"(tid), "+v"(lane));
    const int c16 = lane & 15, q4 = lane >> 4, tq = c16 >> 2, tp = c16 & 3;
    LAS unsigned char* Ks = lds; LAS unsigned char* Vs = lds + RT_T; LAS unsigned char* Ps = lds + 2 * RT_T; LAS unsigned char* RTs = lds + 3 * RT_T;
    const float lg2 = head_lg2(h), G = exp2f(lg2 * 128.f);
    f32x4 R[8];
#pragma unroll
    for (int eb = 0; eb < 8; ++eb)
#pragma unroll
        for (int i = 0; i < 4; ++i) R[eb][i] = P.R0()[(h * 128 + 16 * wave + 4 * q4 + i) * 128 + 16 * eb + c16];
    __syncthreads();
#pragma unroll
    for (int eb = 0; eb < 8; ++eb) { u32x2 w; w.x = cvt_pk_bf16(R[eb][0], R[eb][1]); w.y = cvt_pk_bf16(R[eb][2], R[eb][3]); *(LAS u32x2*)(RTs + (16 * eb + c16) * RT_S + (16 * wave + 4 * q4) * 2) = w; }
    float rowfac[4], xi[4];
#pragma unroll
    for (int i = 0; i < 4; ++i) { const int n = 16 * wave + 4 * q4 + i; rowfac[i] = exp2f(lg2 * (float)(n - 127)); xi[i] = exp2f(lg2 * (float)(n + 1)); }
    float gw[8], gb[8];
#pragma unroll
    for (int eb = 0; eb < 8; ++eb) { gw[eb] = P.gnw()[h * 128 + 16 * eb + c16]; gb[eb] = P.gnb()[h * 128 + 16 * eb + c16]; }
    for (int ch = 0; ch < 32; ++ch) {
        const size_t row0 = (size_t)b * TOK + 128 * ch;
#pragma unroll
        for (int i = 0; i < 4; ++i) { const int id = tid + 512 * i, m = id >> 4, cc = id & 15;
            *(LAS u32x4*)(Ks + m * RT_S + cc * 16) = *(const u32x4*)(P.RK() + (row0 + m) * 1024 + h * 128 + cc * 8);
            *(LAS u32x4*)(Vs + m * RT_S + cc * 16) = *(const u32x4*)(P.RV() + (row0 + m) * 1024 + h * 128 + cc * 8); }
        bf16x8 qf[4];
#pragma unroll
        for (int s = 0; s < 4; ++s) qf[s] = *(const bf16x8*)(P.RQ() + (row0 + 16 * wave + c16) * 1024 + h * 128 + 32 * s + 8 * q4);
        __syncthreads();
        f32x4 sacc[8], oacc[8];
#pragma unroll
        for (int mb = 0; mb < 8; ++mb) { f32x4 a = {0.f, 0.f, 0.f, 0.f}, c = {0.f, 0.f, 0.f, 0.f};
#pragma unroll
            for (int s = 0; s < 4; ++s) { const bf16x8 kf = *(const LAS bf16x8*)(Ks + (16 * mb + c16) * RT_S + (32 * s + 8 * q4) * 2), rf = *(const LAS bf16x8*)(RTs + (16 * mb + c16) * RT_S + (32 * s + 8 * q4) * 2);
                a = __builtin_amdgcn_mfma_f32_16x16x32_bf16(qf[s], kf, a, 0, 0, 0); c = __builtin_amdgcn_mfma_f32_16x16x32_bf16(qf[s], rf, c, 0, 0, 0); }
            sacc[mb] = a; oacc[mb] = c; }
#pragma unroll
        for (int mb = 0; mb < 8; ++mb)
#pragma unroll
            for (int i = 0; i < 4; ++i) { const int n = 16 * wave + 4 * q4 + i, m = 16 * mb + c16; const float pv = m <= n ? sacc[mb][i] * rowfac[i] : 0.f;
                *(LAS bf16*)(Ps + n * RT_S + m * 2) = (bf16)f2bf(pv); oacc[mb][i] *= xi[i]; }
        __syncthreads();
        bf16x8 pf[4], ktf[4];
#pragma unroll
        for (int s = 0; s < 4; ++s) { pf[s] = *(const LAS bf16x8*)(Ps + (16 * wave + c16) * RT_S + (32 * s + 8 * q4) * 2);
            const s16x4 lo = tr_read(Ks + (32 * s + 8 * q4 + tq) * RT_S + (16 * wave + 4 * tp) * 2), hi = tr_read(Ks + (32 * s + 8 * q4 + 4 + tq) * RT_S + (16 * wave + 4 * tp) * 2);
            ktf[s] = __builtin_shufflevector(lo, hi, 0, 1, 2, 3, 4, 5, 6, 7); }
#pragma unroll
        for (int eb = 0; eb < 8; ++eb) { f32x4 kv = {0.f, 0.f, 0.f, 0.f};
#pragma unroll
            for (int s = 0; s < 4; ++s) { const s16x4 lo = tr_read(Vs + (32 * s + 8 * q4 + tq) * RT_S + (16 * eb + 4 * tp) * 2), hi = tr_read(Vs + (32 * s + 8 * q4 + 4 + tq) * RT_S + (16 * eb + 4 * tp) * 2);
                const bf16x8 vf = __builtin_shufflevector(lo, hi, 0, 1, 2, 3, 4, 5, 6, 7);
                oacc[eb] = __builtin_amdgcn_mfma_f32_16x16x32_bf16(pf[s], vf, oacc[eb], 0, 0, 0); kv = __builtin_amdgcn_mfma_f32_16x16x32_bf16(ktf[s], vf, kv, 0, 0, 0); }
            R[eb] = R[eb] * G + kv;
            u32x2 w; w.x = cvt_pk_bf16(R[eb][0], R[eb][1]); w.y = cvt_pk_bf16(R[eb][2], R[eb][3]); *(LAS u32x2*)(RTs + (16 * eb + c16) * RT_S + (16 * wave + 4 * q4) * 2) = w; }
#pragma unroll
        for (int i = 0; i < 4; ++i) { float s = 0.f;
#pragma unroll
            for (int eb = 0; eb < 8; ++eb) s += oacc[eb][i];
            s += __shfl_xor(s, 1); s += __shfl_xor(s, 2); s += __shfl_xor(s, 4); s += __shfl_xor(s, 8);
            const float mu = s * (1.f / 128.f); float v = 0.f;
#pragma unroll
            for (int eb = 0; eb < 8; ++eb) { const float d = oacc[eb][i] - mu; v += d * d; }
            v += __shfl_xor(v, 1); v += __shfl_xor(v, 2); v += __shfl_xor(v, 4); v += __shfl_xor(v, 8);
            const float rstd = 1.0f / sqrtf(v * (1.f / 128.f) + GN_EPS);
            bf16* yr = P.ZRET() + (row0 + 16 * wave + 4 * q4 + i) * 1024 + h * 128 + c16;
#pragma unroll
            for (int eb = 0; eb < 8; ++eb) { const float z = bf2f(yr[16 * eb]); yr[16 * eb] = (bf16)f2bf(((oacc[eb][i] - mu) * rstd * gw[eb] + gb[eb]) * z); } }
        __syncthreads();
    }
}

template <int PH> __device__ __forceinline__ void run_phase(const Ptrs& P, LAS unsigned char* lds, int tid, int lane, int wave);

template <int ph_lo, int ph_hi> __global__ void __launch_bounds__(NTHR, 2) hybrid_fwd(Args args) {
    extern __shared__ __attribute__((aligned(16))) unsigned char lds_raw[];
    LAS unsigned char* lds = (LAS unsigned char*)lds_raw;
    const int tid = threadIdx.x, lane = tid & 63, wave = __builtin_amdgcn_readfirstlane(tid >> 6);
    const int G = gridDim.x, bx = blockIdx.x;
    constexpr bool multi = (ph_hi - ph_lo) > 1;
#ifndef PHMASK
#define PHMASK 0x7f
#endif
#define IN(k) (((PHMASK >> (k)) & 1) && ph_lo <= (k) && (k) < ph_hi)
#define PHASE_PTRS() Ptrs P; { unsigned char* ws_ = args.ws; asm volatile("" : "+s"(ws_)); P.a = &args; P.ws = ws_; } unsigned char* ws = P.ws; (void)ws
#define SEAM(k) do { if (multi && IN((k) + 1)) cg::this_grid().sync(); } while (0)

    if (IN(0)) { PHASE_PTRS(); p0_prologue(P, lds, tid, lane, wave); SEAM(0); }
    if (IN(1)) { PHASE_PTRS();
        pg8::Gemm g{P.XN(), P.WIN(), M, NINP, D}; pg8::StaticOrder S; S.init(M, NINP, G, bx);
        pg8::EpiIn E{ws, P.SSQQ(), P.SSQKV(), P.C128(), P.S128(), P.C64(), P.S64()};
        pg8::gemm_phase<pg8::EpiIn, pg8::StaticOrder, true, true>(lds, g, S, E);
        SEAM(1);
    }
    if (IN(2)) { PHASE_PTRS();
        meta_stage2(P, tid);
        { pg8::Gemm g{P.CQ(), P.WUQ(), M, 1536, 512}; pg8::StaticOrder S; S.init(M, 1536, G, bx);
          pg8::EpiQ E{P.QN(), P.QR(), P.SSQQ(), P.C64(), P.S64(), 0.07216878364870322f * 1.4426950408889634f};
          pg8::gemm_phase<pg8::EpiQ, pg8::StaticOrder, true, true>(lds, g, S, E); }
        { pg8::Gemm g{P.CKV(), P.WUK(), M, 1024, 256}; pg8::StaticOrder S; S.init(M, 1024, G, bx);
          pg8::EpiK E{P.KN(), P.SSQKV()};
          pg8::gemm_phase<pg8::EpiK, pg8::StaticOrder, true, true>(lds, g, S, E); }
        { pg8::Gemm g{P.WUV(), P.CKV(), 1024, M, 256}; pg8::StaticOrder S; S.init(1024, M, G, bx);
          pg8::EpiVT E{P.VT(), P.SSQKV()};
          pg8::gemm_phase<pg8::EpiVT, pg8::StaticOrder, true, true>(lds, g, S, E); }
        SEAM(2);
    }
    if (IN(3)) { PHASE_PTRS();
        volatile LAS unsigned* qw = (volatile LAS unsigned*)(lds + QWORD_OFF);
#ifndef NO_RET
        for (;;) {
            __syncthreads();
            if (tid == 0) *qw = __hip_atomic_fetch_add(P.ctl(), 1u, __ATOMIC_RELAXED, __HIP_MEMORY_SCOPE_AGENT);
            __syncthreads();
            const int idx = (int)__builtin_amdgcn_readfirstlane(*qw);
            if (idx >= 64) break;
            ret_unit(P, lds, idx >> 3, idx & 7, tid, lane, wave);
        }
#endif
#ifndef NO_ATT
        for (;;) {
            __syncthreads();
            if (tid == 0) *qw = __hip_atomic_fetch_add(P.ctl() + 64, 1u, __ATOMIC_RELAXED, __HIP_MEMORY_SCOPE_AGENT);
            __syncthreads();
            const int a = (int)__builtin_amdgcn_readfirstlane(*qw);
            if (a >= 1024) break;
            attn_unit(P, lds, (a & 63) >> 3, a & 7, 15 - (a >> 6), tid, lane, wave);
        }
#endif
        SEAM(3);
    }
    if (IN(4)) { PHASE_PTRS();
        { pg8::Gemm g{P.ZMLA(), P.WBM(), M, D, 1024}; pg8::StaticOrder S; S.init(M, D, G, bx);
          pg8::EpiMerge<0> E{P.MG(), P.GATES()};
          pg8::gemm_phase<pg8::EpiMerge<0>, pg8::StaticOrder, true, true>(lds, g, S, E); }
        { pg8::Gemm g{P.ZRET(), P.WBR(), M, D, 1024}; pg8::StaticOrder S; S.init(M, D, G, bx);
          pg8::EpiMerge<1> E{P.MG(), P.GATES()};
          pg8::gemm_phase<pg8::EpiMerge<1>, pg8::StaticOrder, true, true>(lds, g, S, E); }
        SEAM(4);
    }
    if (IN(5)) { PHASE_PTRS();
        pg8::Gemm g{P.MG(), P.WOUT(), M, D, D}; pg8::StaticOrder S; S.init(M, D, G, bx);
        pg8::EpiOut E{P.x(), P.out(), P.SSQO()};
        pg8::gemm_phase<pg8::EpiOut, pg8::StaticOrder, true, true>(lds, g, S, E);
        SEAM(5);
    }
    if (IN(6)) { PHASE_PTRS();
        const int gw = bx * NWAVES + wave, NGW = G * NWAVES;
        for (int m = gw; m < M; m += NGW) { float* orow = P.out() + (size_t)m * D;
            float ss = lane < 32 ? P.SSQO()[(size_t)m * 32 + lane] : 0.f; ss = wave_sum(ss);
            const float rs = 1.0f / sqrtf(ss * (1.f / D) + NORM_EPS);
#pragma unroll
            for (int j = 0; j < 8; ++j) { const f32x4 v = *(const f32x4*)(orow + 4 * lane + 256 * j), w = *(const f32x4*)(P.fnw() + 4 * lane + 256 * j); *(f32x4*)(orow + 4 * lane + 256 * j) = v * rs * w; } }
    }
#undef IN
#undef SEAM
}

#ifndef N_LAUNCHES
#define N_LAUNCHES 1
#endif
template <int LO, int HI> static bool setup_one(int& per_cu) {
    if (hipFuncSetAttribute((const void*)hybrid_fwd<LO, HI>, hipFuncAttributeMaxDynamicSharedMemorySize, LDS_BYTES) != hipSuccess) { fprintf(stderr, "kernel_launch: hipFuncSetAttribute failed\n"); return false; }
    if (hipOccupancyMaxActiveBlocksPerMultiprocessor(&per_cu, (const void*)hybrid_fwd<LO, HI>, NTHR, LDS_BYTES) != hipSuccess || per_cu < 1) { fprintf(stderr, "kernel_launch: occupancy query says %d blocks per CU\n", per_cu); per_cu = 1; }
    (void)hipGetLastError();
    return true;
}
extern "C" void kernel_launch(void* const* d_in, const int* in_sizes, int n_in, void* d_out, int out_size, void* d_ws, size_t ws_size, hipStream_t stream) {
    static int grid = 0;
    if (grid == 0) {
        if (n_in != 14 || out_size != M * D || ws_size < WS_END) { fprintf(stderr, "kernel_launch: unexpected shapes (n_in %d, out %d, ws %zu)\n", n_in, out_size, ws_size); grid = -1; return; }
        int dev = 0, cus = 0, per_cu = 1; bool ok = true;
        (void)hipGetDevice(&dev); (void)hipDeviceGetAttribute(&cus, hipDeviceAttributeMultiprocessorCount, dev);
#if N_LAUNCHES == 1
        ok = setup_one<0, 7>(per_cu);
#else
        ok = setup_one<0, 1>(per_cu) && setup_one<1, 2>(per_cu) && setup_one<2, 3>(per_cu) && setup_one<3, 4>(per_cu) && setup_one<4, 5>(per_cu) && setup_one<5, 6>(per_cu) && setup_one<6, 7>(per_cu);
#endif
        if (!ok) { grid = -1; return; }
        grid = cus * per_cu;
        if (grid != 256) fprintf(stderr, "kernel_launch: note: grid = %d workgroups\n", grid);
    }
    if (grid < 0) return;
    Args a{};
    for (int i = 0; i < 14; ++i) a.in[i] = (const float*)d_in[i];
    a.out = (float*)d_out; a.ws = (unsigned char*)d_ws;
#if N_LAUNCHES == 1
    void* kargs[] = {&a};
    hipError_t e = hipLaunchCooperativeKernel((const void*)hybrid_fwd<0, 7>, dim3(grid), dim3(NTHR), kargs, LDS_BYTES, stream);
    if (e != hipSuccess) fprintf(stderr, "kernel_launch: cooperative launch failed: %s (grid %d)\n", hipGetErrorString(e), grid);
#else
    hipLaunchKernelGGL((hybrid_fwd<0, 1>), dim3(grid), dim3(NTHR), LDS_BYTES, stream, a);
    hipLaunchKernelGGL((hybrid_fwd<1, 2>), dim3(grid), dim3(NTHR), LDS_BYTES, stream, a);
    hipLaunchKernelGGL((hybrid_fwd<2, 3>), dim3(grid), dim3(NTHR), LDS_BYTES, stream, a);
    hipLaunchKernelGGL((hybrid_fwd<3, 4>), dim3(grid), dim3(NTHR), LDS_BYTES, stream, a);
    hipLaunchKernelGGL((hybrid_fwd<4, 5>), dim3(grid), dim3(NTHR), LDS_BYTES, stream, a);
    hipLaunchKernelGGL((hybrid_fwd<5, 6>), dim3(grid), dim3(NTHR), LDS_BYTES, stream, a);
    hipLaunchKernelGGL((hybrid_fwd<6, 7>), dim3(grid), dim3(NTHR), LDS_BYTES, stream, a);
#endif
}
```

```cpp
#include <hip/hip_runtime.h>
#include <hip/hip_cooperative_groups.h>
#include <cstdio>
#include <cstdint>
constexpr size_t MiB = 1u << 20;
constexpr size_t WS_CTL = 0, WS_WIN = 1 * MiB, WS_WUQ = 41 * MiB, WS_WUK = 43 * MiB, WS_WUV = 43 * MiB + 512 * 1024, WS_WBM = 44 * MiB, WS_WBR = 48 * MiB, WS_WOUT = 52 * MiB;
constexpr size_t WS_C128 = 60 * MiB, WS_S128 = 61 * MiB + 256 * 1024, WS_C64 = 62 * MiB + 512 * 1024, WS_S64 = 63 * MiB + 256 * 1024;
constexpr size_t WS_MP = 64 * MiB, WS_R0 = 64 * MiB + 256 * 1024, WS_SSQQ = 65 * MiB, WS_SSQKV = 66 * MiB, WS_SSQO = 67 * MiB, WS_KR = 71 * MiB;
constexpr size_t WS_XN = 76 * MiB, WS_QN = 76 * MiB, WS_QR = 140 * MiB, WS_CQ = 204 * MiB, WS_CKV = 236 * MiB, WS_ZMLA = 252 * MiB, WS_RQ = 316 * MiB, WS_RK = 380 * MiB, WS_MG = 316 * MiB;
constexpr size_t WS_RV = 444 * MiB, WS_ZRET = 508 * MiB, WS_GATES = 572 * MiB, WS_KN = 828 * MiB, WS_VT = 894 * MiB, WS_END = 960 * MiB;
namespace pg8 {
#define PG8_LAS __attribute__((address_space(3)))
typedef unsigned short bf16_t;
typedef short bf16x8 __attribute__((ext_vector_type(8)));
typedef float f32x4 __attribute__((ext_vector_type(4)));
typedef unsigned u32x4 __attribute__((ext_vector_type(4)));
constexpr int BM = 256, BK = 64, HALF = 128, HTB = HALF * BK * 2  , STAGE_BYTES = 8 * HTB, NXCD = 8, WGM = 8;

__host__ __device__ __forceinline__ int lds_byte(int r, int c) { const int st = (r >> 4) * 2 + (c >> 5), rr = r & 15, cc = c & 31, ob = rr * 64 + cc * 2; return st * 1024 + (ob ^ (((ob >> 9) & 1) << 5)); }
__host__ __device__ __forceinline__ void stage_rc(int b, int& R, int& C) { const int st = b / 1024, sb = b % 1024, swz = sb ^ (((sb >> 9) & 1) << 5); R = (st >> 1) * 16 + swz / 64; C = (st & 1) * 32 + (swz % 64) / 2; }
__host__ __device__ __forceinline__ int perm32(int rho) { const int n = rho >> 4, i = rho & 15; return 8 * (i >> 2) + 4 * n + (i & 3); }

struct Unit { int pm, pn; };
struct Gemm { const bf16_t* A; const bf16_t* Bt; int M, N, K; };

struct StaticOrder {
    int nM, nN, nwg, G, c;
    __host__ __device__ void init(int M, int N, int G_, int c_) { nM = M / BM; nN = N / BM; nwg = nM * nN; G = G_; c = c_; }
    __host__ __device__ bool next(int i, Unit& u) const {
        const long L = (long)i * G + c; if (L >= nwg) return false;
        int wgid = (int)L; { const int q = nwg / NXCD, r = nwg % NXCD, xcd = wgid % NXCD, off = wgid / NXCD; wgid = (xcd < r ? xcd * (q + 1) : r * (q + 1) + (xcd - r) * q) + off; }
        const int nig = WGM * nN, gid = wgid / nig, fm = gid * WGM, gsz = (nM - fm) < WGM ? (nM - fm) : WGM;
        u.pm = fm + ((wgid % nig) % gsz); u.pn = (wgid % nig) / gsz; return true;
    }
    __device__ __forceinline__ void a_ready(const Unit&) const {}
    __device__ __forceinline__ void done(const Unit&) const {}
};

__device__ __forceinline__ unsigned cvt_pk_bf16(float lo, float hi) { unsigned r; asm volatile("v_cvt_pk_bf16_f32 %0, %1, %2" : "=v"(r) : "v"(lo), "v"(hi)); return r; }
typedef float f32x2 __attribute__((ext_vector_type(2)));
typedef unsigned u32x2 __attribute__((ext_vector_type(2)));
constexpr int TOK = 4096, KSEQ = 4160, KOFF = 64;
__device__ __forceinline__ float head_lg2(int h) { const float x = __uint_as_float((unsigned)(127 - 5 - h) << 23); const float p = x * (1.f + x * (0.5f + x * (0.33333333f + x * (0.25f + x * (0.2f + x * (0.16666667f + x * 0.14285714f)))))); return -p * 1.4426950408889634f; }
__device__ __forceinline__ float sigmoid_f(float x) { return __builtin_amdgcn_rcpf(1.f + __expf(-x)); }
__device__ __forceinline__ float bf2f(unsigned short b) { return __uint_as_float((unsigned)b << 16); }
__device__ __forceinline__ u32x4 pack8(f32x4 v0, f32x4 v1) { u32x4 w; w.x = cvt_pk_bf16(v0[0], v0[1]); w.y = cvt_pk_bf16(v0[2], v0[3]); w.z = cvt_pk_bf16(v1[0], v1[1]); w.w = cvt_pk_bf16(v1[2], v1[3]); return w; }
__device__ __forceinline__ u32x2 pack4(f32x4 v) { u32x2 w; w.x = cvt_pk_bf16(v[0], v[1]); w.y = cvt_pk_bf16(v[2], v[3]); return w; }
__device__ __forceinline__ void unpack8(u32x4 w, f32x4& a, f32x4& b) {
    a[0] = __uint_as_float(w.x << 16); a[1] = __uint_as_float(w.x & 0xffff0000u); a[2] = __uint_as_float(w.y << 16); a[3] = __uint_as_float(w.y & 0xffff0000u);
    b[0] = __uint_as_float(w.z << 16); b[1] = __uint_as_float(w.z & 0xffff0000u); b[2] = __uint_as_float(w.w << 16); b[3] = __uint_as_float(w.w & 0xffff0000u); }

struct EpiIn {
    static constexpr bool PERM = true, AFTER_DRAIN = false;
    unsigned char* ws; float *ssq_q, *ssq_kv; const float *C128, *S128, *C64, *S64;
    __device__ __forceinline__ void operator()(const f32x4 (&acc)[2][2][4][2], const Unit& u, int wr, int wc, int fr, int fq) const {
        const int pn = u.pn, row0 = u.pm * BM + wr * 64 + fr;
        if (pn < 3) {
            bf16_t* base = (bf16_t*)(ws + (pn < 2 ? WS_CQ : WS_CKV)); const int ldc = pn < 2 ? 512 : 256, colt = pn < 2 ? pn * 256 : 0;
            float* sq = pn < 2 ? ssq_q : ssq_kv; const int sld = pn < 2 ? 8 : 4, soff = (pn < 2 ? pn * 4 : 0) + wc;
#pragma unroll
            for (int ai = 0; ai < 2; ++ai)
#pragma unroll
                for (int m = 0; m < 4; ++m) { const int row = row0 + ai * HALF + m * 16; float s = 0.f;
#pragma unroll
                    for (int bj = 0; bj < 2; ++bj) { const f32x4 v0 = acc[ai][bj][m][0], v1 = acc[ai][bj][m][1];
                        s += (v0[0] * v0[0] + v0[1] * v0[1]) + (v0[2] * v0[2] + v0[3] * v0[3]) + (v1[0] * v1[0] + v1[1] * v1[1]) + (v1[2] * v1[2] + v1[3] * v1[3]);
                        *(u32x4*)(base + (size_t)row * ldc + colt + bj * HALF + wc * 32 + 8 * fq) = pack8(v0, v1); }
                    s += __shfl_xor(s, 16); s += __shfl_xor(s, 32);
                    if (fq == 0) sq[(size_t)row * sld + soff] = s; }
        } else if (pn == 3) {
            if (wc < 2) {
                const int j0 = 16 * wc + 4 * fq;
#pragma unroll
                for (int ai = 0; ai < 2; ++ai)
#pragma unroll
                    for (int m = 0; m < 4; ++m) { const int row = row0 + ai * HALF + m * 16, b = row >> 12, t = row & (TOK - 1), pos = 16 + t;
                        const f32x4 c = *(const f32x4*)(C64 + pos * 32 + j0), s = *(const f32x4*)(S64 + pos * 32 + j0);
                        const f32x4 t1 = acc[ai][0][m][0], t2 = acc[ai][0][m][1];
                        bf16_t* o = (bf16_t*)(ws + WS_KR) + (size_t)(b * KSEQ + KOFF + t) * 64 + j0;
                        *(u32x2*)o = pack4(t1 * c - t2 * s); *(u32x2*)(o + 32) = pack4(t1 * s + t2 * c); }
            }
        } else if ((pn >= 8) && (pn < 16)) {
            const bool isk = pn >= 12; bf16_t* base = (bf16_t*)(ws + (isk ? WS_RK : WS_RQ)); const int colt = (pn - (isk ? 12 : 8)) * 256; const int j0 = 16 * wc + 4 * fq;
#pragma unroll
            for (int ai = 0; ai < 2; ++ai)
#pragma unroll
                for (int m = 0; m < 4; ++m) { const int row = row0 + ai * HALF + m * 16, t = row & (TOK - 1), pos = 16 + t;
                    const f32x4 c = *(const f32x4*)(C128 + pos * 64 + j0), s = *(const f32x4*)(S128 + pos * 64 + j0);
#pragma unroll
                    for (int bj = 0; bj < 2; ++bj) { float f = 1.f;
                        if (isk) { const int h = (colt >> 7) + bj; f = 0.08838834764831845f * __builtin_amdgcn_exp2f(head_lg2(h) * (float)(127 - (t & 127))); }
                        const f32x4 t1 = acc[ai][bj][m][0] * f, t2 = acc[ai][bj][m][1] * f;
                        bf16_t* o = base + (size_t)row * 1024 + colt + bj * HALF + j0;
                        *(u32x2*)o = pack4(t1 * c - t2 * s); *(u32x2*)(o + 64) = pack4(t1 * s + t2 * c); } }
        } else {
            size_t boff; int ldc, colt, act;
            if (pn < 8) { boff = WS_ZMLA; ldc = 1024; colt = (pn - 4) * 256; act = 1; }
            else if (pn < 20) { boff = WS_RV; ldc = 1024; colt = (pn - 16) * 256; act = 0; }
            else if (pn < 24) { boff = WS_ZRET; ldc = 1024; colt = (pn - 20) * 256; act = 1; }
            else { boff = WS_GATES; ldc = 4096; colt = (pn - 24) * 256; act = 2; }
            bf16_t* base = (bf16_t*)(ws + boff);
#pragma unroll
            for (int ai = 0; ai < 2; ++ai)
#pragma unroll
                for (int m = 0; m < 4; ++m) { const int row = row0 + ai * HALF + m * 16;
#pragma unroll
                    for (int bj = 0; bj < 2; ++bj) { f32x4 v0 = acc[ai][bj][m][0], v1 = acc[ai][bj][m][1];
                        if (act != 0) {
#pragma unroll
                            for (int i = 0; i < 4; ++i) { const float s0 = sigmoid_f(v0[i]), s1 = sigmoid_f(v1[i]); v0[i] = act == 1 ? v0[i] * s0 : s0; v1[i] = act == 1 ? v1[i] * s1 : s1; } }
                        *(u32x4*)(base + (size_t)row * ldc + colt + bj * HALF + wc * 32 + 8 * fq) = pack8(v0, v1); } }
        }
    }
};

__device__ __forceinline__ float rs_from(const float* p, int n, float inv_d, float eps) { float s = 0.f; for (int i = 0; i < n; ++i) s += p[i]; return 1.0f / sqrtf(s * inv_d + eps); }

struct EpiQ {
    static constexpr bool PERM = true, AFTER_DRAIN = false;
    bf16_t *QN, *QR; const float *ssq_q, *C64, *S64; float qscale;
    __device__ __forceinline__ void operator()(const f32x4 (&acc)[2][2][4][2], const Unit& u, int wr, int wc, int fr, int fq) const {
        const int pn = u.pn, row0 = u.pm * BM + wr * 64 + fr;
#pragma unroll
        for (int ai = 0; ai < 2; ++ai)
#pragma unroll
            for (int m = 0; m < 4; ++m) { const int row = row0 + ai * HALF + m * 16;
                const f32x4 q0 = *(const f32x4*)(ssq_q + (size_t)row * 8), q1 = *(const f32x4*)(ssq_q + (size_t)row * 8 + 4);
                const float ss = ((q0[0] + q0[1]) + (q0[2] + q0[3])) + ((q1[0] + q1[1]) + (q1[2] + q1[3]));
                const float f = qscale / sqrtf(ss * (1.f / 512.f) + 1e-6f);
                if (pn < 4) {
#pragma unroll
                    for (int bj = 0; bj < 2; ++bj) *(u32x4*)(QN + (size_t)row * 1024 + pn * 256 + bj * HALF + wc * 32 + 8 * fq) = pack8(acc[ai][bj][m][0] * f, acc[ai][bj][m][1] * f);
                } else {
                    const int pos = 16 + (row & (TOK - 1)), j0 = 16 * (wc & 1) + 4 * fq;
                    const f32x4 c = *(const f32x4*)(C64 + pos * 32 + j0), s = *(const f32x4*)(S64 + pos * 32 + j0);
#pragma unroll
                    for (int bj = 0; bj < 2; ++bj) { const int head = (pn - 4) * 4 + bj * 2 + (wc >> 1);
                        const f32x4 t1 = acc[ai][bj][m][0] * f, t2 = acc[ai][bj][m][1] * f;
                        bf16_t* o = QR + (size_t)row * 512 + head * 64 + j0;
                        *(u32x2*)o = pack4(t1 * c - t2 * s); *(u32x2*)(o + 32) = pack4(t1 * s + t2 * c); }
                }
            }
    }
};
struct EpiK {
    static constexpr bool PERM = true, AFTER_DRAIN = false;
    bf16_t* KN; const float* ssq_kv;
    __device__ __forceinline__ void operator()(const f32x4 (&acc)[2][2][4][2], const Unit& u, int wr, int wc, int fr, int fq) const {
        const int pn = u.pn, row0 = u.pm * BM + wr * 64 + fr;
#pragma unroll
        for (int ai = 0; ai < 2; ++ai)
#pragma unroll
            for (int m = 0; m < 4; ++m) { const int row = row0 + ai * HALF + m * 16, b = row >> 12, t = row & (TOK - 1);
                const f32x4 q0 = *(const f32x4*)(ssq_kv + (size_t)row * 4);
                const float f = 1.0f / sqrtf(((q0[0] + q0[1]) + (q0[2] + q0[3])) * (1.f / 256.f) + 1e-6f);
#pragma unroll
                for (int bj = 0; bj < 2; ++bj) *(u32x4*)(KN + (size_t)(b * KSEQ + KOFF + t) * 1024 + pn * 256 + bj * HALF + wc * 32 + 8 * fq) = pack8(acc[ai][bj][m][0] * f, acc[ai][bj][m][1] * f);
                asm volatile("" ::: "memory"); }
    }
};
struct EpiVT {
    static constexpr bool PERM = true, AFTER_DRAIN = false;
    bf16_t* VT; const float* ssq_kv;
    __device__ __forceinline__ void operator()(const f32x4 (&acc)[2][2][4][2], const Unit& u, int wr, int wc, int fr, int fq) const {
        const int pn = u.pn, row0 = u.pm * BM + wr * 64 + fr;
#pragma unroll
        for (int bj = 0; bj < 2; ++bj) { const int col = pn * 256 + bj * HALF + wc * 32 + 8 * fq, b = col >> 12, t = col & (TOK - 1);
            f32x4 f0, f1;
#pragma unroll
            for (int i = 0; i < 4; ++i) { const f32x4 a = *(const f32x4*)(ssq_kv + (size_t)(col + i) * 4);
                f0[i] = 1.0f / sqrtf(((a[0] + a[1]) + (a[2] + a[3])) * (1.f / 256.f) + 1e-6f); asm volatile("" : "+v"(f0[i]) :: "memory"); }
#pragma unroll
            for (int i = 0; i < 4; ++i) { const f32x4 c = *(const f32x4*)(ssq_kv + (size_t)(col + 4 + i) * 4);
                f1[i] = 1.0f / sqrtf(((c[0] + c[1]) + (c[2] + c[3])) * (1.f / 256.f) + 1e-6f); asm volatile("" : "+v"(f1[i]) :: "memory"); }
#pragma unroll
            for (int ai = 0; ai < 2; ++ai)
#pragma unroll
                for (int m = 0; m < 4; ++m) { const int row = row0 + ai * HALF + m * 16;
                    *(u32x4*)(VT + (size_t)row * (8 * KSEQ) + b * KSEQ + KOFF + t) = pack8(acc[ai][bj][m][0] * f0, acc[ai][bj][m][1] * f1); } }
    }
};
template <int PASS> struct EpiMerge {
    static constexpr bool PERM = true, AFTER_DRAIN = false;
    bf16_t* MG; const bf16_t* GATES;
    __device__ __forceinline__ void operator()(const f32x4 (&acc)[2][2][4][2], const Unit& u, int wr, int wc, int fr, int fq) const {
        const int pn = u.pn, row0 = u.pm * BM + wr * 64 + fr;
#pragma unroll
        for (int ai = 0; ai < 2; ++ai)
#pragma unroll
            for (int m = 0; m < 4; ++m) { const int row = row0 + ai * HALF + m * 16;
#pragma unroll
                for (int bj = 0; bj < 2; ++bj) { const int col = pn * 256 + bj * HALF + wc * 32 + 8 * fq;
                    f32x4 g0, g1; unpack8(*(const u32x4*)(GATES + (size_t)row * 4096 + PASS * 2048 + col), g0, g1);
                    f32x4 v0 = acc[ai][bj][m][0] * g0, v1 = acc[ai][bj][m][1] * g1;
                    if (PASS == 1) { f32x4 p0, p1; unpack8(*(const u32x4*)(MG + (size_t)row * 2048 + col), p0, p1); v0 += p0; v1 += p1; }
                    *(u32x4*)(MG + (size_t)row * 2048 + col) = pack8(v0, v1); } }
    }
};
struct EpiOut {
    static constexpr bool PERM = true, AFTER_DRAIN = false;
    const float* X; bf16_t* PRE; float* ssq_o;
    __device__ __forceinline__ void operator()(const f32x4 (&acc)[2][2][4][2], const Unit& u, int wr, int wc, int fr, int fq) const {
        const int pn = u.pn, row0 = u.pm * BM + wr * 64 + fr;
#pragma unroll
        for (int ai = 0; ai < 2; ++ai)
#pragma unroll
            for (int m = 0; m < 4; ++m) { const int row = row0 + ai * HALF + m * 16; float s = 0.f;
#pragma unroll
                for (int bj = 0; bj < 2; ++bj) { const size_t off = (size_t)row * 2048 + pn * 256 + bj * HALF + wc * 32 + 8 * fq;
                    const f32x4 v0 = acc[ai][bj][m][0] + *(const f32x4*)(X + off), v1 = acc[ai][bj][m][1] + *(const f32x4*)(X + off + 4);
                    s += (v0[0] * v0[0] + v0[1] * v0[1]) + (v0[2] * v0[2] + v0[3] * v0[3]) + (v1[0] * v1[0] + v1[1] * v1[1]) + (v1[2] * v1[2] + v1[3] * v1[3]);
                    *(u32x4*)(PRE + off) = pack8(v0, v1); }
                s += __shfl_xor(s, 16); s += __shfl_xor(s, 32);
                if (fq == 0) ssq_o[(size_t)row * 32 + pn * 4 + wc] = s; }
    }
};
template <class Epi, class Sched, bool ALIGN_EPI = false, bool SP2 = false>
__device__ __forceinline__ void gemm_phase(PG8_LAS unsigned char* lds, const Gemm g, const Sched& S, const Epi& E) {
    int tid = threadIdx.x; asm volatile("" : "+v"(tid));
    const int wid = __builtin_amdgcn_readfirstlane(tid >> 6), lane = tid & 63, wr = wid >> 2, wc = wid & 3, fr = lane & 15, fq = lane >> 4;
    const int K = g.K, nt = K / BK;
    unsigned voffA[2], voffB[2];
#pragma unroll
    for (int i = 0; i < 2; ++i) { int R, C; stage_rc(tid * 16 + i * 8192, R, C); const int Rb = Epi::PERM ? ((R & ~31) + perm32(R & 31)) : R;
        voffA[i] = (unsigned)(R * K + C) * 2u; voffB[i] = (unsigned)(Rb * K + C) * 2u; }
    const size_t kstep = (size_t)(BK * 2);
    const size_t hstep = (size_t)HALF * K * 2;
    const size_t tstep = 2 * hstep;
    const unsigned ldsw = (unsigned)wid * 1024u;
    const int aoff = lds_byte(wr * 64 + fr, fq * 8), boff = lds_byte(wc * 32 + fr, fq * 8);
#define PG8_SA(b, h) (((b) * 2 + (h)) * HTB)
#define PG8_SB(b, h) ((4 + (b) * 2 + (h)) * HTB)
#define PG8_STAGE(bufoff, gbase, voff) do { _Pragma("unroll") for (int _i = 0; _i < 2; ++_i) \
        __builtin_amdgcn_global_load_lds((const unsigned*)((const char*)(gbase) + (voff)[_i]), (PG8_LAS unsigned*)(lds + (bufoff) + ldsw + _i * 8192), 16, 0, 0); } while (0)
#define PG8_LDA(dst, b, h) do { _Pragma("unroll") for (int m = 0; m < 4; ++m) _Pragma("unroll") for (int k = 0; k < 2; ++k) dst[m][k] = *(const PG8_LAS bf16x8*)(lds + PG8_SA(b, h) + aoff + m * 2048 + k * 1024); } while (0)
#define PG8_LDB(dst, b, h) do { _Pragma("unroll") for (int n = 0; n < 2; ++n) _Pragma("unroll") for (int k = 0; k < 2; ++k) dst[n][k] = *(const PG8_LAS bf16x8*)(lds + PG8_SB(b, h) + boff + n * 2048 + k * 1024); } while (0)
#define PG8_MMA(ai, bj, At, Bt) do { __builtin_amdgcn_s_setprio(1); _Pragma("unroll") for (int m = 0; m < 4; ++m) _Pragma("unroll") for (int n = 0; n < 2; ++n) _Pragma("unroll") for (int k = 0; k < 2; ++k) \
        acc[ai][bj][m][n] = __builtin_amdgcn_mfma_f32_16x16x32_bf16(Bt[n][k], At[m][k], acc[ai][bj][m][n], 0, 0, 0); __builtin_amdgcn_s_setprio(0); } while (0)
#define PG8_WAIT_V(n) asm volatile("s_waitcnt vmcnt(" #n ")" ::: "memory")
#define PG8_WAIT_L(n) asm volatile("s_waitcnt lgkmcnt(" #n ")" ::: "memory")
#define PG8_BAR __builtin_amdgcn_s_barrier()
#define PG8_SCHED __builtin_amdgcn_sched_barrier(0)
    Unit cur, nxt; int ui = 0;
    if (!S.next(0, cur)) return;
    f32x4 acc[2][2][4][2];
#pragma unroll
    for (int a = 0; a < 2; ++a)
#pragma unroll
        for (int b = 0; b < 2; ++b)
#pragma unroll
            for (int m = 0; m < 4; ++m)
#pragma unroll
                for (int n = 0; n < 2; ++n) acc[a][b][m][n] = (f32x4){0.f, 0.f, 0.f, 0.f};
    bf16x8 At[4][2], B0[2][2], B1[2][2];
    const char* cA = (const char*)g.A + (size_t)cur.pm * tstep; const char* cB = (const char*)g.Bt + (size_t)cur.pn * tstep;
    S.a_ready(cur);
    if constexpr (SP2) {
        PG8_STAGE(PG8_SB(0, 0), cB, voffB); PG8_STAGE(PG8_SB(0, 1), cB + hstep, voffB); PG8_STAGE(PG8_SA(0, 0), cA, voffA); PG8_STAGE(PG8_SA(0, 1), cA + hstep, voffA);
        if (wr == 1) PG8_BAR;
        PG8_WAIT_V(2); PG8_BAR;
        PG8_STAGE(PG8_SB(1, 0), cB + kstep, voffB); PG8_STAGE(PG8_SA(1, 0), cA + kstep, voffA); PG8_STAGE(PG8_SB(1, 1), cB + hstep + kstep, voffB);
        PG8_WAIT_V(6); PG8_BAR;
    } else {
        PG8_STAGE(PG8_SB(0, 0), cB, voffB); PG8_STAGE(PG8_SA(0, 0), cA, voffA); PG8_STAGE(PG8_SB(0, 1), cB + hstep, voffB); PG8_STAGE(PG8_SA(0, 1), cA + hstep, voffA);
        if (wr == 1) PG8_BAR;
        PG8_WAIT_V(4); PG8_BAR;
        PG8_STAGE(PG8_SB(1, 0), cB + kstep, voffB); PG8_STAGE(PG8_SA(1, 0), cA + kstep, voffA); PG8_STAGE(PG8_SB(1, 1), cB + hstep + kstep, voffB);
        PG8_WAIT_V(6); PG8_BAR;
    }
    for (;;) {
        const bool has_next = S.next(ui + 1, nxt);
        const char* nA = has_next ? (const char*)g.A + (size_t)nxt.pm * tstep : cA; const char* nB = has_next ? (const char*)g.Bt + (size_t)nxt.pn * tstep : cB;
#pragma nounroll
        for (int t = 0; t < nt; t += 2) {
            const bool last = (t == nt - 2);
            const char* a1 = cA + (size_t)(t + 1) * kstep;
            const char* a2 = last ? nA : cA + (size_t)(t + 2) * kstep; const char* b2 = last ? nB : cB + (size_t)(t + 2) * kstep;
            const char* a3 = a2 + kstep; const char* b3 = b2 + kstep;
            if (last && has_next) S.a_ready(nxt);
            if constexpr (SP2) {
            PG8_LDB(B0, 0, 0); PG8_LDB(B1, 0, 1); PG8_SCHED; PG8_LDA(At, 0, 0); PG8_STAGE(PG8_SA(1, 1), a1 + hstep, voffA);
            PG8_WAIT_V(8); PG8_WAIT_L(0); PG8_BAR; PG8_MMA(0, 0, At, B0); PG8_MMA(0, 1, At, B1); PG8_BAR; PG8_SCHED;
            PG8_LDA(At, 0, 1); PG8_STAGE(PG8_SB(0, 0), b2, voffB); PG8_STAGE(PG8_SB(0, 1), b2 + hstep, voffB); PG8_STAGE(PG8_SA(0, 0), a2, voffA);
            PG8_WAIT_V(8); PG8_WAIT_L(0); PG8_BAR; PG8_MMA(1, 0, At, B0); PG8_MMA(1, 1, At, B1); PG8_BAR; PG8_SCHED;
            PG8_LDB(B0, 1, 0); PG8_LDB(B1, 1, 1); PG8_SCHED; PG8_LDA(At, 1, 0); PG8_STAGE(PG8_SA(0, 1), a2 + hstep, voffA);
            PG8_WAIT_V(8); PG8_WAIT_L(0); PG8_BAR; PG8_MMA(0, 0, At, B0); PG8_MMA(0, 1, At, B1); PG8_BAR; PG8_SCHED;
            PG8_LDA(At, 1, 1); PG8_STAGE(PG8_SB(1, 0), b3, voffB); PG8_STAGE(PG8_SB(1, 1), b3 + hstep, voffB); PG8_STAGE(PG8_SA(1, 0), a3, voffA);
            PG8_WAIT_V(8); PG8_WAIT_L(0); PG8_BAR; PG8_MMA(1, 0, At, B0); PG8_MMA(1, 1, At, B1); PG8_BAR; PG8_SCHED;
            } else {
            PG8_LDB(B0, 0, 0); PG8_SCHED; PG8_LDA(At, 0, 0); PG8_STAGE(PG8_SA(1, 1), a1 + hstep, voffA);
            PG8_WAIT_L(8); PG8_BAR; PG8_WAIT_L(0); PG8_MMA(0, 0, At, B0); PG8_BAR; PG8_SCHED;
            PG8_LDB(B1, 0, 1); PG8_STAGE(PG8_SB(0, 0), b2, voffB);
            PG8_BAR; PG8_WAIT_L(0); PG8_MMA(0, 1, At, B1); PG8_BAR;
            PG8_LDA(At, 0, 1); PG8_STAGE(PG8_SA(0, 0), a2, voffA);
            PG8_BAR; PG8_WAIT_L(0); PG8_MMA(1, 0, At, B0); PG8_BAR; PG8_SCHED;
            PG8_STAGE(PG8_SB(0, 1), b2 + hstep, voffB);
            PG8_WAIT_V(6); PG8_BAR; PG8_MMA(1, 1, At, B1); PG8_BAR;
            PG8_LDB(B0, 1, 0); PG8_SCHED; PG8_LDA(At, 1, 0); PG8_STAGE(PG8_SA(0, 1), a2 + hstep, voffA);
            PG8_WAIT_L(8); PG8_BAR; PG8_WAIT_L(0); PG8_MMA(0, 0, At, B0); PG8_BAR; PG8_SCHED;
            PG8_LDB(B1, 1, 1); PG8_STAGE(PG8_SB(1, 0), b3, voffB);
            PG8_BAR; PG8_WAIT_L(0); PG8_MMA(0, 1, At, B1); PG8_BAR;
            PG8_LDA(At, 1, 1); PG8_STAGE(PG8_SA(1, 0), a3, voffA);
            PG8_BAR; PG8_WAIT_L(0); PG8_MMA(1, 0, At, B0); PG8_BAR; PG8_SCHED;
            PG8_STAGE(PG8_SB(1, 1), b3 + hstep, voffB);
            PG8_WAIT_V(6); PG8_BAR; PG8_MMA(1, 1, At, B1); PG8_BAR;
            }
        }
        if constexpr (ALIGN_EPI) { if (wr == 0) PG8_BAR; }
        if constexpr (!Epi::AFTER_DRAIN) { E(acc, cur, wr, wc, fr, fq); S.done(cur); }
        if (!has_next) break;
#pragma unroll
        for (int a = 0; a < 2; ++a)
#pragma unroll
            for (int b = 0; b < 2; ++b)
#pragma unroll
                for (int m = 0; m < 4; ++m)
#pragma unroll
                    for (int n = 0; n < 2; ++n) acc[a][b][m][n] = (f32x4){0.f, 0.f, 0.f, 0.f};
        cur = nxt; cA = nA; cB = nB; ++ui;
        if constexpr (ALIGN_EPI) { if (wr == 1) PG8_BAR; }
    }
    PG8_WAIT_V(0);
    if constexpr (!ALIGN_EPI) { if (wr == 0) PG8_BAR; }
    PG8_BAR;
    if constexpr (Epi::AFTER_DRAIN) { E.fused(acc, cur, wr, wc, fr, fq, lds, wid, lane); S.done(cur); }
#undef PG8_SA
#undef PG8_SB
#undef PG8_STAGE
#undef PG8_LDA
#undef PG8_LDB
#undef PG8_MMA
#undef PG8_WAIT_V
#undef PG8_WAIT_L
#undef PG8_BAR
#undef PG8_SCHED
}
}
namespace cg = cooperative_groups;
#define LAS __attribute__((address_space(3)))
typedef unsigned short bf16;
using pg8::f32x4; using pg8::bf16x8; using pg8::u32x4; using pg8::u32x2; using pg8::cvt_pk_bf16; using pg8::bf2f;
typedef float f32x16 __attribute__((ext_vector_type(16)));
typedef short s16x4 __attribute__((ext_vector_type(4)));
using pg8::TOK; using pg8::KSEQ; using pg8::KOFF;
constexpr int NB = 8, M = NB * TOK, D = 2048, NIN = 10048, NINP = 10240, NPOS = 4112;
constexpr int NWAVES = 8, NTHR = 512, LDS_BYTES = 147456, QWORD_OFF = 147200;
constexpr int NMP = 2368;
constexpr float NORM_EPS = 1e-6f, GN_EPS = 1e-5f;

struct Args { const float* in[14]; float* out; unsigned char* ws; };

__device__ __forceinline__ unsigned f2bf(float f) { unsigned u = __float_as_uint(f); return (u + 0x7fffu + ((u >> 16) & 1u)) >> 16; }
__device__ __forceinline__ unsigned pk2(float lo, float hi) { return f2bf(lo) | (f2bf(hi) << 16); }
__device__ __forceinline__ float wave_sum(float v) {
#pragma unroll
    for (int o = 1; o < 64; o <<= 1) v += __shfl_xor(v, o);
    return v;
}
__device__ __forceinline__ float head_lg2(int h) { return pg8::head_lg2(h); }

__device__ __forceinline__ int src_in(int n) {
    if (n < 768) return n;
    if (n < 1024) { const int p = n - 768; if (p >= 64) return -1; const int wc = p >> 5, fq = (p >> 3) & 3, nn = (p >> 2) & 1, i = p & 3; return 768 + 32 * nn + 16 * wc + 4 * fq + i; }
    if (n < 2048) return 832 + (n - 1024);
    if (n < 4096) { const int q = n - 2048, hb = q >> 7, p = q & 127, wc = p >> 5, fq = (p >> 3) & 3, nn = (p >> 2) & 1, i = p & 3; return 1856 + hb * 128 + 64 * nn + 16 * wc + 4 * fq + i; }
    if (n < 6144) return 3904 + (n - 4096);
    return 5952 + (n - 6144);
}
__device__ __forceinline__ int src_uq(int n) {
    if (n < 1024) return (n >> 7) * 192 + (n & 127);
    const int q = n - 1024, blk = q >> 7, p = q & 127, wc = p >> 5, fq = (p >> 3) & 3, nn = (p >> 2) & 1, i = p & 3;
    return (2 * blk + (wc >> 1)) * 192 + 128 + 32 * nn + 16 * (wc & 1) + 4 * fq + i;
}
template <int KIND> __device__ __forceinline__ void p0_item(const float* W, int ldw, int K, bf16* WT, const float* ksc, int item, int nblk, LAS float* scr, int lane) {
    const int kb = item / nblk, nb = item % nblk, k0 = 64 * kb, n0 = 32 * nb, nl = lane & 31;
    int sc;
    if (KIND == 0) sc = n0 + nl; else if (KIND == 1) sc = src_in(n0 + nl); else if (KIND == 2) sc = src_uq(n0 + nl);
    else if (KIND == 3) sc = ((n0 + nl) >> 7) * 256 + ((n0 + nl) & 127); else sc = ((n0 + nl) >> 7) * 256 + 128 + ((n0 + nl) & 127);
#pragma unroll 16
    for (int i = 0; i < 32; ++i) { const int kk = 2 * i + (lane >> 5); float v = sc >= 0 ? W[(size_t)(k0 + kk) * ldw + sc] : 0.f; if (ksc) v *= ksc[k0 + kk]; scr[kk * 33 + nl] = v; }
    asm volatile("s_waitcnt lgkmcnt(0)" ::: "memory");
    const int c = lane & 7;
#pragma unroll
    for (int j = 0; j < 4; ++j) { const int n = (lane >> 3) + 8 * j; const LAS float* s = scr + (8 * c) * 33 + n;
        u32x4 o; o.x = pk2(s[0 * 33], s[1 * 33]); o.y = pk2(s[2 * 33], s[3 * 33]); o.z = pk2(s[4 * 33], s[5 * 33]); o.w = pk2(s[6 * 33], s[7 * 33]);
        *(u32x4*)(WT + (size_t)(n0 + n) * K + k0 + 8 * c) = o; }
    asm volatile("s_waitcnt lgkmcnt(0)" ::: "memory");
}

struct Ptrs {
    const Args* a; unsigned char* ws;
    __device__ __forceinline__ const float* x() const { return a->in[0]; }
    __device__ __forceinline__ const float* meta() const { return a->in[1]; }
    __device__ __forceinline__ const float* norm_w() const { return a->in[2]; }
    __device__ __forceinline__ const float* w_in() const { return a->in[3]; }
    __device__ __forceinline__ const float* qnw() const { return a->in[4]; }
    __device__ __forceinline__ const float* w_uq() const { return a->in[5]; }
    __device__ __forceinline__ const float* kvnw() const { return a->in[6]; }
    __device__ __forceinline__ const float* w_ukv() const { return a->in[7]; }
    __device__ __forceinline__ const float* gnw() const { return a->in[8]; }
    __device__ __forceinline__ const float* gnb() const { return a->in[9]; }
    __device__ __forceinline__ const float* w_bm() const { return a->in[10]; }
    __device__ __forceinline__ const float* w_br() const { return a->in[11]; }
    __device__ __forceinline__ const float* w_out() const { return a->in[12]; }
    __device__ __forceinline__ const float* fnw() const { return a->in[13]; }
    __device__ __forceinline__ float* out() const { return a->out; }
    __device__ __forceinline__ bf16* WIN() const { return (bf16*)(ws + WS_WIN); }
    __device__ __forceinline__ bf16* WUQ() const { return (bf16*)(ws + WS_WUQ); }
    __device__ __forceinline__ bf16* WUK() const { return (bf16*)(ws + WS_WUK); }
    __device__ __forceinline__ bf16* WUV() const { return (bf16*)(ws + WS_WUV); }
    __device__ __forceinline__ bf16* WBM() const { return (bf16*)(ws + WS_WBM); }
    __device__ __forceinline__ bf16* WBR() const { return (bf16*)(ws + WS_WBR); }
    __device__ __forceinline__ bf16* WOUT() const { return (bf16*)(ws + WS_WOUT); }
    __device__ __forceinline__ bf16* KR() const { return (bf16*)(ws + WS_KR); }
    __device__ __forceinline__ bf16* XN() const { return (bf16*)(ws + WS_XN); }
    __device__ __forceinline__ bf16* QN() const { return (bf16*)(ws + WS_QN); }
    __device__ __forceinline__ bf16* QR() const { return (bf16*)(ws + WS_QR); }
    __device__ __forceinline__ bf16* CQ() const { return (bf16*)(ws + WS_CQ); }
    __device__ __forceinline__ bf16* CKV() const { return (bf16*)(ws + WS_CKV); }
    __device__ __forceinline__ bf16* ZMLA() const { return (bf16*)(ws + WS_ZMLA); }
    __device__ __forceinline__ bf16* RQ() const { return (bf16*)(ws + WS_RQ); }
    __device__ __forceinline__ bf16* RK() const { return (bf16*)(ws + WS_RK); }
    __device__ __forceinline__ bf16* MG() const { return (bf16*)(ws + WS_MG); }
    __device__ __forceinline__ bf16* RV() const { return (bf16*)(ws + WS_RV); }
    __device__ __forceinline__ bf16* ZRET() const { return (bf16*)(ws + WS_ZRET); }
    __device__ __forceinline__ bf16* GATES() const { return (bf16*)(ws + WS_GATES); }
    __device__ __forceinline__ bf16* KN() const { return (bf16*)(ws + WS_KN); }
    __device__ __forceinline__ bf16* VT() const { return (bf16*)(ws + WS_VT); }
    __device__ __forceinline__ float* C128() const { return (float*)(ws + WS_C128); }
    __device__ __forceinline__ float* S128() const { return (float*)(ws + WS_S128); }
    __device__ __forceinline__ float* C64() const { return (float*)(ws + WS_C64); }
    __device__ __forceinline__ float* S64() const { return (float*)(ws + WS_S64); }
    __device__ __forceinline__ float* MP() const { return (float*)(ws + WS_MP); }
    __device__ __forceinline__ float* R0() const { return (float*)(ws + WS_R0); }
    __device__ __forceinline__ float* SSQQ() const { return (float*)(ws + WS_SSQQ); }
    __device__ __forceinline__ float* SSQKV() const { return (float*)(ws + WS_SSQKV); }
    __device__ __forceinline__ float* SSQO() const { return (float*)(ws + WS_SSQO); }
    __device__ __forceinline__ unsigned* ctl() const { return (unsigned*)(ws + WS_CTL); }
};

__device__ __forceinline__ void p0_prologue(const Ptrs& P, LAS unsigned char* lds, int tid, int lane, int wave) {
    const int G = gridDim.x, bx = blockIdx.x;
    const int gtid = bx * NTHR + tid, NT = G * NTHR;
    if (gtid == 0) { P.ctl()[0] = 0u; P.ctl()[64] = 0u; P.ctl()[128] = 0u; P.ctl()[192] = 0u; }
    for (int i = gtid; i < NB * 48 * 512; i += NT) { const int b = i / (48 * 512), r = i % (48 * 512); ((unsigned*)(P.KN() + (size_t)b * KSEQ * 1024))[r] = 0u; }
    for (int i = gtid; i < NB * 48 * 32; i += NT) { const int b = i / (48 * 32), r = i % (48 * 32); ((unsigned*)(P.KR() + (size_t)b * KSEQ * 64))[r] = 0u; }
    for (int i = gtid; i < 1024 * NB * 24; i += NT) { const int row = i / (NB * 24), r = i % (NB * 24), b = r / 24, c = r % 24; ((unsigned*)(P.VT() + (size_t)row * (NB * KSEQ) + b * KSEQ))[c] = 0u; }
    for (int i = gtid; i < NPOS * 96; i += NT) { const int pos = i / 96, j = i % 96;
        const double e = j < 64 ? (double)j / 64.0 : (double)(j - 64) / 32.0;
        const float inv = (float)exp2(-e * 13.287712379549449); const float ang = (float)pos * inv;
        const double rev = (double)ang * 0.15915494309189535; const float a = (float)((rev - rint(rev)) * 6.283185307179586);
        const float c = cosf(a), s = sinf(a);
        if (j < 64) { P.C128()[pos * 64 + j] = c; P.S128()[pos * 64 + j] = s; } else { P.C64()[pos * 32 + j - 64] = c; P.S64()[pos * 32 + j - 64] = s; } }
    if (bx < NMP / 16) {
        LAS float* mx = (LAS float*)lds;
        for (int rr = 0; rr < 2; ++rr) { const int row = 2 * wave + rr; f32x4 v[8]; float ss = 0.f;
#pragma unroll
            for (int j = 0; j < 8; ++j) { v[j] = *(const f32x4*)(P.meta() + (size_t)row * D + 4 * lane + 256 * j); ss += (v[j][0] * v[j][0] + v[j][1] * v[j][1]) + (v[j][2] * v[j][2] + v[j][3] * v[j][3]); }
            const float rs = 1.0f / sqrtf(wave_sum(ss) * (1.f / D) + NORM_EPS);
#pragma unroll
            for (int j = 0; j < 8; ++j) { const f32x4 w = *(const f32x4*)(P.norm_w() + 4 * lane + 256 * j); *(LAS f32x4*)(mx + row * D + 4 * lane + 256 * j) = v[j] * rs * w; } }
        __syncthreads();
        const int c16 = lane & 15, ks = lane >> 4, q = 16 * bx + c16, orig = q < 320 ? 512 + q : 2880 + (q - 320);
        float acc[16];
#pragma unroll
        for (int i = 0; i < 16; ++i) acc[i] = 0.f;
        const float* wp = P.w_in() + (size_t)(256 * wave + ks) * NIN + orig;
#pragma unroll 8
        for (int j = 0; j < 64; ++j) { const float wv = wp[(size_t)(4 * j) * NIN]; const int k = 256 * wave + 4 * j + ks;
#pragma unroll
            for (int i = 0; i < 16; ++i) acc[i] += mx[i * D + k] * wv; }
#pragma unroll
        for (int i = 0; i < 16; ++i) { acc[i] += __shfl_xor(acc[i], 16); acc[i] += __shfl_xor(acc[i], 32); }
        __syncthreads();
        LAS float* red = (LAS float*)lds;
        if (ks == 0) {
#pragma unroll
            for (int i = 0; i < 16; ++i) red[(wave * 16 + i) * 16 + c16] = acc[i]; }
        __syncthreads();
        if (tid < 256) { float sum = 0.f;
#pragma unroll
            for (int w = 0; w < 8; ++w) sum += red[w * 256 + tid];
            P.MP()[(tid >> 4) * NMP + 16 * bx + (tid & 15)] = sum; }
        __syncthreads();
    }
    LAS float* scr = (LAS float*)(lds + wave * 16384);
    const int gw = bx * NWAVES + wave, NGW = G * NWAVES;
    constexpr int I_IN = 32 * 320, I_UQ = 8 * 48, I_UK = 4 * 32, I_B = 16 * 64, I_O = 32 * 64;
    constexpr int NITEMS = I_IN + I_UQ + 2 * I_UK + 2 * I_B + I_O;
    for (int it = gw; it < NITEMS; it += NGW) { int r = it;
        if (r < I_IN) { p0_item<1>(P.w_in(), NIN, D, P.WIN(), nullptr, r, 320, scr, lane); continue; } r -= I_IN;
        if (r < I_UQ) { p0_item<2>(P.w_uq(), 1536, 512, P.WUQ(), P.qnw(), r, 48, scr, lane); continue; } r -= I_UQ;
        if (r < I_UK) { p0_item<3>(P.w_ukv(), 2048, 256, P.WUK(), P.kvnw(), r, 32, scr, lane); continue; } r -= I_UK;
        if (r < I_UK) { p0_item<4>(P.w_ukv(), 2048, 256, P.WUV(), P.kvnw(), r, 32, scr, lane); continue; } r -= I_UK;
        if (r < I_B) { p0_item<0>(P.w_bm(), D, 1024, P.WBM(), nullptr, r, 64, scr, lane); continue; } r -= I_B;
        if (r < I_B) { p0_item<0>(P.w_br(), D, 1024, P.WBR(), nullptr, r, 64, scr, lane); continue; } r -= I_B;
        p0_item<0>(P.w_out(), D, D, P.WOUT(), nullptr, r, 64, scr, lane); }
    for (int m = gw; m < M; m += 2 * NGW) {
        const int m2 = m + NGW; const float* xr = P.x() + (size_t)m * D; const float* xr2 = P.x() + (size_t)m2 * D; f32x4 v[8], u[8]; float ss = 0.f, ss2 = 0.f;
#pragma unroll
        for (int j = 0; j < 8; ++j) { v[j] = *(const f32x4*)(xr + 4 * lane + 256 * j); u[j] = *(const f32x4*)(xr2 + 4 * lane + 256 * j); }
#pragma unroll
        for (int j = 0; j < 8; ++j) { ss += (v[j][0] * v[j][0] + v[j][1] * v[j][1]) + (v[j][2] * v[j][2] + v[j][3] * v[j][3]); ss2 += (u[j][0] * u[j][0] + u[j][1] * u[j][1]) + (u[j][2] * u[j][2] + u[j][3] * u[j][3]); }
        const float rs = 1.0f / sqrtf(wave_sum(ss) * (1.f / D) + NORM_EPS), rs2 = 1.0f / sqrtf(wave_sum(ss2) * (1.f / D) + NORM_EPS);
#pragma unroll
        for (int j = 0; j < 8; ++j) { const f32x4 w = *(const f32x4*)(P.norm_w() + 4 * lane + 256 * j); const f32x4 o = v[j] * rs * w, o2 = u[j] * rs2 * w;
            u32x2 pk; pk.x = pk2(o[0], o[1]); pk.y = pk2(o[2], o[3]); *(u32x2*)(P.XN() + (size_t)m * D + 4 * lane + 256 * j) = pk;
            pk.x = pk2(o2[0], o2[1]); pk.y = pk2(o2[2], o2[3]); *(u32x2*)(P.XN() + (size_t)m2 * D + 4 * lane + 256 * j) = pk; } }
}

__device__ __forceinline__ void meta_stage2(const Ptrs& P, int tid) {
    const int gtid = blockIdx.x * NTHR + tid, NT = gridDim.x * NTHR;
    for (int idx = gtid; idx < 8 * 128 * 128; idx += NT) { const int h = idx >> 14, d = (idx >> 7) & 127, e = idx & 127, j = d & 63; const float lg2 = head_lg2(h); float s = 0.f;
        for (int i = 0; i < 16; ++i) { const float k1 = P.MP()[i * NMP + 320 + h * 128 + j], k2 = P.MP()[i * NMP + 320 + h * 128 + j + 64], c = P.C128()[i * 64 + j], sn = P.S128()[i * 64 + j];
            const float kd = d < 64 ? k1 * c - k2 * sn : k1 * sn + k2 * c;
            s += kd * 0.08838834764831845f * exp2f(lg2 * (float)(15 - i)) * P.MP()[i * NMP + 1344 + h * 128 + e]; }
        P.R0()[idx] = s; }
    if (gtid < 2048) { const int n = gtid, head = n >> 8, wi = n & 255; float dot[16], ss[16];
#pragma unroll
        for (int i = 0; i < 16; ++i) { dot[i] = 0.f; ss[i] = 0.f; }
        for (int k = 0; k < 256; ++k) { const float wv = P.w_ukv()[(size_t)k * 2048 + n] * P.kvnw()[k];
#pragma unroll
            for (int i = 0; i < 16; ++i) { const float c = P.MP()[i * NMP + k]; dot[i] += c * wv; ss[i] += c * c; } }
#pragma unroll
        for (int i = 0; i < 16; ++i) { const float v = dot[i] / sqrtf(ss[i] * (1.f / 256.f) + NORM_EPS); const bf16 bv = (bf16)f2bf(v);
            for (int b = 0; b < NB; ++b) { if (wi < 128) P.KN()[(size_t)(b * KSEQ + 48 + i) * 1024 + head * 128 + wi] = bv; else P.VT()[(size_t)(head * 128 + wi - 128) * (NB * KSEQ) + b * KSEQ + 48 + i] = bv; } }
    } else if (gtid < 2048 + 512) { const int idx = gtid - 2048, i = idx >> 5, j = idx & 31;
        const float t1 = P.MP()[i * NMP + 256 + j], t2 = P.MP()[i * NMP + 256 + 32 + j], c = P.C64()[i * 32 + j], s = P.S64()[i * 32 + j];
        const bf16 o1 = (bf16)f2bf(t1 * c - t2 * s), o2 = (bf16)f2bf(t1 * s + t2 * c);
        for (int b = 0; b < NB; ++b) { P.KR()[(size_t)(b * KSEQ + 48 + i) * 64 + j] = o1; P.KR()[(size_t)(b * KSEQ + 48 + i) * 64 + 32 + j] = o2; } }
}

constexpr int AT_KS = 400, AT_VS = 144, AT_KB = 64 * AT_KS, AT_VB = 128 * AT_VS, AT_BUF = AT_KB + AT_VB;
__device__ __forceinline__ void attn_unit(const Ptrs& P, LAS unsigned char* lds, int b, int h, int qb, int tid, int lane, int wave, bool do_store = true) {
    asm volatile("" : "+v"(tid), "+v"(lane));
    const int r = lane & 31, hh = lane >> 5;
    const int trow = 256 * qb + 32 * wave + r;
    const size_t row = (size_t)b * TOK + trow;
    bf16x8 qf[12];
#pragma unroll
    for (int s = 0; s < 8; ++s) qf[s] = *(const bf16x8*)(P.QN() + row * 1024 + h * 128 + 16 * s + 8 * hh);
#pragma unroll
    for (int s = 0; s < 4; ++s) qf[8 + s] = *(const bf16x8*)(P.QR() + row * 512 + h * 64 + 16 * s + 8 * hh);
    const int ntiles = 4 * qb + 5, kt_last = 4 * qb + 1 + (wave >> 1);
    f32x16 o[4];
#pragma unroll
    for (int e = 0; e < 4; ++e)
#pragma unroll
        for (int i = 0; i < 16; ++i) o[e][i] = 0.f;
    float mrun = -1e30f, lsum = 0.f;
    const bf16* kbase = P.KN() + (size_t)b * KSEQ * 1024 + h * 128; const bf16* rbase = P.KR() + (size_t)b * KSEQ * 64; const bf16* vbase = P.VT() + (size_t)(h * 128) * (NB * KSEQ) + (size_t)b * KSEQ;
    u32x4 kreg[3], vreg[2];
#define AT_LOAD(kt) do { _Pragma("unroll") for (int i = 0; i < 3; ++i) { const int c = tid + 512 * i, key = c / 24, cc = c % 24; \
            kreg[i] = cc < 16 ? *(const u32x4*)(kbase + (size_t)(64 * (kt) + key) * 1024 + cc * 8) : *(const u32x4*)(rbase + (size_t)(64 * (kt) + key) * 64 + (cc - 16) * 8); } \
        _Pragma("unroll") for (int i = 0; i < 2; ++i) { const int c = tid + 512 * i, e = c >> 3, cc = c & 7; vreg[i] = *(const u32x4*)(vbase + (size_t)e * (NB * KSEQ) + 64 * (kt) + cc * 8); } } while (0)
#define AT_STORE(buf) do { LAS unsigned char* kb_ = lds + (buf) * AT_BUF; LAS unsigned char* vb_ = kb_ + AT_KB; \
        _Pragma("unroll") for (int i = 0; i < 3; ++i) { const int c = tid + 512 * i, key = c / 24, cc = c % 24; *(LAS u32x4*)(kb_ + key * AT_KS + cc * 16) = kreg[i]; } \
        _Pragma("unroll") for (int i = 0; i < 2; ++i) { const int c = tid + 512 * i, e = c >> 3, cc = c & 7; *(LAS u32x4*)(vb_ + e * AT_VS + cc * 16) = vreg[i]; } } while (0)
    __syncthreads();
    AT_LOAD(0); AT_STORE(0);
    __syncthreads();
    for (int kt = 0; kt < ntiles; ++kt) {
        const bool more = kt + 1 < ntiles;
        if (more) AT_LOAD(kt + 1);
        if (kt <= kt_last) {
            const LAS unsigned char* kb = lds + (kt & 1) * AT_BUF; const LAS unsigned char* vb = kb + AT_KB;
            f32x16 p0, p1;
#pragma unroll
            for (int i = 0; i < 16; ++i) { p0[i] = 0.f; p1[i] = 0.f; }
#pragma unroll
            for (int s = 0; s < 12; ++s) { const bf16x8 a0 = *(const LAS bf16x8*)(kb + r * AT_KS + s * 32 + hh * 16), a1 = *(const LAS bf16x8*)(kb + (32 + r) * AT_KS + s * 32 + hh * 16);
                p0 = __builtin_amdgcn_mfma_f32_32x32x16_bf16(a0, qf[s], p0, 0, 0, 0); p1 = __builtin_amdgcn_mfma_f32_32x32x16_bf16(a1, qf[s], p1, 0, 0, 0);
                if ((s & 3) == 3) __builtin_amdgcn_sched_barrier(0); }
            if (kt == 0 || kt >= 4 * qb + 1) {
                const int kmax = KOFF + trow, k0 = 64 * kt + 4 * hh;
#pragma unroll
                for (int i = 0; i < 16; ++i) { const int kk = k0 + (i & 3) + 8 * (i >> 2); if (kk < 48 || kk > kmax) p0[i] = -1e30f; if (kk + 32 < 48 || kk + 32 > kmax) p1[i] = -1e30f; }
            }
            float mx = fmaxf(p0[0], p1[0]);
#pragma unroll
            for (int i = 1; i < 16; ++i) mx = fmaxf(mx, fmaxf(p0[i], p1[i]));
            mx = fmaxf(mx, __shfl_xor(mx, 32));
            const float mnew = fmaxf(mrun, mx), alpha = __builtin_amdgcn_exp2f(mrun - mnew); mrun = mnew;
            float ps = 0.f;
#pragma unroll
            for (int i = 0; i < 16; ++i) { p0[i] = __builtin_amdgcn_exp2f(p0[i] - mnew); p1[i] = __builtin_amdgcn_exp2f(p1[i] - mnew); ps += p0[i] + p1[i]; }
            lsum = lsum * alpha + ps;
#pragma unroll
            for (int e = 0; e < 4; ++e)
#pragma unroll
                for (int i = 0; i < 16; ++i) o[e][i] *= alpha;
#pragma unroll
            for (int s2 = 0; s2 < 4; ++s2) { u32x4 pw;
                if (s2 == 0) { pw.x = cvt_pk_bf16(p0[0], p0[1]); pw.y = cvt_pk_bf16(p0[2], p0[3]); pw.z = cvt_pk_bf16(p0[4], p0[5]); pw.w = cvt_pk_bf16(p0[6], p0[7]); }
                else if (s2 == 1) { pw.x = cvt_pk_bf16(p0[8], p0[9]); pw.y = cvt_pk_bf16(p0[10], p0[11]); pw.z = cvt_pk_bf16(p0[12], p0[13]); pw.w = cvt_pk_bf16(p0[14], p0[15]); }
                else if (s2 == 2) { pw.x = cvt_pk_bf16(p1[0], p1[1]); pw.y = cvt_pk_bf16(p1[2], p1[3]); pw.z = cvt_pk_bf16(p1[4], p1[5]); pw.w = cvt_pk_bf16(p1[6], p1[7]); }
                else { pw.x = cvt_pk_bf16(p1[8], p1[9]); pw.y = cvt_pk_bf16(p1[10], p1[11]); pw.z = cvt_pk_bf16(p1[12], p1[13]); pw.w = cvt_pk_bf16(p1[14], p1[15]); }
                const bf16x8 pb = __builtin_bit_cast(bf16x8, pw);
#pragma unroll
                for (int e = 0; e < 4; ++e) { const LAS unsigned char* vp = vb + (32 * e + r) * AT_VS + (16 * s2 + 4 * hh) * 2;
                    const s16x4 lo = *(const LAS s16x4*)vp, hi = *(const LAS s16x4*)(vp + 16);
                    const bf16x8 va = __builtin_shufflevector(lo, hi, 0, 1, 2, 3, 4, 5, 6, 7);
                    o[e] = __builtin_amdgcn_mfma_f32_32x32x16_bf16(va, pb, o[e], 0, 0, 0); }
                __builtin_amdgcn_sched_barrier(0); }
        }
        if (more) AT_STORE((kt + 1) & 1);
        __syncthreads();
    }
#undef AT_LOAD
#undef AT_STORE
    const float inv = 1.0f / (lsum + __shfl_xor(lsum, 32));
    bf16* yrow = P.ZMLA() + row * 1024 + h * 128;
#pragma unroll
    for (int e = 0; e < 4; ++e)
#pragma unroll
        for (int g = 0; g < 4; ++g) { bf16* p = yrow + 32 * e + 8 * g + 4 * hh; const u32x2 z = *(const u32x2*)p;
            const float z0 = __uint_as_float(z.x << 16), z1 = __uint_as_float(z.x & 0xffff0000u), z2 = __uint_as_float(z.y << 16), z3 = __uint_as_float(z.y & 0xffff0000u);
            u32x2 w; w.x = cvt_pk_bf16(o[e][4 * g] * inv * z0, o[e][4 * g + 1] * inv * z1); w.y = cvt_pk_bf16(o[e][4 * g + 2] * inv * z2, o[e][4 * g + 3] * inv * z3); if (do_store) *(u32x2*)p = w; }
}

constexpr int RT_S = 272, RT_T = 128 * RT_S;
typedef short v4i16_t __attribute__((ext_vector_type(4)));
__device__ __forceinline__ s16x4 tr_read(const LAS unsigned char* p) { return __builtin_bit_cast(s16x4, __builtin_amdgcn_ds_read_tr16_b64_v4i16((LAS v4i16_t*)p)); }
__device__ __forceinline__ void ret_unit(const Ptrs& P, LAS unsigned char* lds, int b, int h, int tid, int lane, int wave, bool do_store = true) {
    asm volatile("" : "+v"(tid), "+v"(lane));
    const int c16 = lane & 15, q4 = lane >> 4, tq = c16 >> 2, tp = c16 & 3;
    LAS unsigned char* Ks = lds; LAS unsigned char* Vs = lds + RT_T; LAS unsigned char* Ps = lds + 2 * RT_T; LAS unsigned char* RTs = lds + 3 * RT_T;
    const float lg2 = head_lg2(h), G = exp2f(lg2 * 128.f);
    f32x4 R[8];
#pragma unroll
    for (int eb = 0; eb < 8; ++eb)
#pragma unroll
        for (int i = 0; i < 4; ++i) R[eb][i] = P.R0()[(h * 128 + 16 * wave + 4 * q4 + i) * 128 + 16 * eb + c16];
    __syncthreads();
#pragma unroll
    for (int eb = 0; eb < 8; ++eb) { u32x2 w; w.x = cvt_pk_bf16(R[eb][0], R[eb][1]); w.y = cvt_pk_bf16(R[eb][2], R[eb][3]); *(LAS u32x2*)(RTs + (16 * eb + c16) * RT_S + (16 * wave + 4 * q4) * 2) = w; }
    float rowfac[4], xi[4];
#pragma unroll
    for (int i = 0; i < 4; ++i) { const int n = 16 * wave + 4 * q4 + i; rowfac[i] = exp2f(lg2 * (float)(n - 127)); xi[i] = exp2f(lg2 * (float)(n + 1)); }
    float gw[8], gb[8];
#pragma unroll
    for (int eb = 0; eb < 8; ++eb) { gw[eb] = P.gnw()[h * 128 + 16 * eb + c16]; gb[eb] = P.gnb()[h * 128 + 16 * eb + c16]; }
    for (int ch = 0; ch < 32; ++ch) {
        const size_t row0 = (size_t)b * TOK + 128 * ch;
#pragma unroll
        for (int i = 0; i < 4; ++i) { const int id = tid + 512 * i, m = id >> 4, cc = id & 15;
            *(LAS u32x4*)(Ks + m * RT_S + cc * 16) = *(const u32x4*)(P.RK() + (row0 + m) * 1024 + h * 128 + cc * 8);
            *(LAS u32x4*)(Vs + m * RT_S + cc * 16) = *(const u32x4*)(P.RV() + (row0 + m) * 1024 + h * 128 + cc * 8); }
        bf16x8 qf[4];
#pragma unroll
        for (int s = 0; s < 4; ++s) qf[s] = *(const bf16x8*)(P.RQ() + (row0 + 16 * wave + c16) * 1024 + h * 128 + 32 * s + 8 * q4);
        __syncthreads();
        f32x4 sacc[8], oacc[8];
#pragma unroll
        for (int mb = 0; mb < 8; ++mb) { f32x4 a = {0.f, 0.f, 0.f, 0.f}, c = {0.f, 0.f, 0.f, 0.f};
#pragma unroll
            for (int s = 0; s < 4; ++s) { const bf16x8 kf = *(const LAS bf16x8*)(Ks + (16 * mb + c16) * RT_S + (32 * s + 8 * q4) * 2), rf = *(const LAS bf16x8*)(RTs + (16 * mb + c16) * RT_S + (32 * s + 8 * q4) * 2);
                a = __builtin_amdgcn_mfma_f32_16x16x32_bf16(qf[s], kf, a, 0, 0, 0); c = __builtin_amdgcn_mfma_f32_16x16x32_bf16(qf[s], rf, c, 0, 0, 0); }
            sacc[mb] = a; oacc[mb] = c; }
#pragma unroll
        for (int mb = 0; mb < 8; ++mb)
#pragma unroll
            for (int i = 0; i < 4; ++i) { const int n = 16 * wave + 4 * q4 + i, m = 16 * mb + c16; const float pv = m <= n ? sacc[mb][i] * rowfac[i] : 0.f;
                *(LAS bf16*)(Ps + n * RT_S + m * 2) = (bf16)f2bf(pv); oacc[mb][i] *= xi[i]; }
        __syncthreads();
        bf16x8 pf[4], ktf[4];
#pragma unroll
        for (int s = 0; s < 4; ++s) { pf[s] = *(const LAS bf16x8*)(Ps + (16 * wave + c16) * RT_S + (32 * s + 8 * q4) * 2);
            const s16x4 lo = tr_read(Ks + (32 * s + 8 * q4 + tq) * RT_S + (16 * wave + 4 * tp) * 2), hi = tr_read(Ks + (32 * s + 8 * q4 + 4 + tq) * RT_S + (16 * wave + 4 * tp) * 2);
            ktf[s] = __builtin_shufflevector(lo, hi, 0, 1, 2, 3, 4, 5, 6, 7); }
#pragma unroll
        for (int eb = 0; eb < 8; ++eb) { f32x4 kv = {0.f, 0.f, 0.f, 0.f};
#pragma unroll
            for (int s = 0; s < 4; ++s) { const s16x4 lo = tr_read(Vs + (32 * s + 8 * q4 + tq) * RT_S + (16 * eb + 4 * tp) * 2), hi = tr_read(Vs + (32 * s + 8 * q4 + 4 + tq) * RT_S + (16 * eb + 4 * tp) * 2);
                const bf16x8 vf = __builtin_shufflevector(lo, hi, 0, 1, 2, 3, 4, 5, 6, 7);
                oacc[eb] = __builtin_amdgcn_mfma_f32_16x16x32_bf16(pf[s], vf, oacc[eb], 0, 0, 0); kv = __builtin_amdgcn_mfma_f32_16x16x32_bf16(ktf[s], vf, kv, 0, 0, 0); }
            R[eb] = R[eb] * G + kv;
            u32x2 w; w.x = cvt_pk_bf16(R[eb][0], R[eb][1]); w.y = cvt_pk_bf16(R[eb][2], R[eb][3]); *(LAS u32x2*)(RTs + (16 * eb + c16) * RT_S + (16 * wave + 4 * q4) * 2) = w; }
#pragma unroll
        for (int i = 0; i < 4; ++i) { float s = 0.f;
#pragma unroll
            for (int eb = 0; eb < 8; ++eb) s += oacc[eb][i];
            s += __shfl_xor(s, 1); s += __shfl_xor(s, 2); s += __shfl_xor(s, 4); s += __shfl_xor(s, 8);
            const float mu = s * (1.f / 128.f); float v = 0.f;
#pragma unroll
            for (int eb = 0; eb < 8; ++eb) { const float d = oacc[eb][i] - mu; v += d * d; }
            v += __shfl_xor(v, 1); v += __shfl_xor(v, 2); v += __shfl_xor(v, 4); v += __shfl_xor(v, 8);
            const float rstd = 1.0f / sqrtf(v * (1.f / 128.f) + GN_EPS);
            bf16* yr = P.ZRET() + (row0 + 16 * wave + 4 * q4 + i) * 1024 + h * 128 + c16;
#pragma unroll
            for (int eb = 0; eb < 8; ++eb) { const float z = bf2f(yr[16 * eb]); const bf16 yv = (bf16)f2bf(((oacc[eb][i] - mu) * rstd * gw[eb] + gb[eb]) * z); if (do_store) yr[16 * eb] = yv; } }
        __syncthreads();
    }
}

template <int PH> __device__ __forceinline__ void run_phase(const Ptrs& P, LAS unsigned char* lds, int tid, int lane, int wave);

template <int ph_lo, int ph_hi> __global__ void __launch_bounds__(NTHR, 2) hybrid_fwd(Args args) {
    extern __shared__ __attribute__((aligned(16))) unsigned char lds_raw[];
    LAS unsigned char* lds = (LAS unsigned char*)lds_raw;
    const int tid = threadIdx.x, lane = tid & 63, wave = __builtin_amdgcn_readfirstlane(tid >> 6);
    const int G = gridDim.x, bx = blockIdx.x;
    constexpr bool multi = (ph_hi - ph_lo) > 1;
#ifndef PHMASK
#define PHMASK 0x7f
#endif
#ifndef DUPMASK
#define DUPMASK 0
#endif
#define NREP(k) (((DUPMASK >> (k)) & 1) ? 2 : 1)
#define IN(k) (((PHMASK >> (k)) & 1) && ph_lo <= (k) && (k) < ph_hi)
#define PHASE_PTRS() Ptrs P; { unsigned char* ws_ = args.ws; asm volatile("" : "+s"(ws_)); P.a = &args; P.ws = ws_; } unsigned char* ws = P.ws; (void)ws
#define SEAM(k) do { if (multi && IN((k) + 1)) cg::this_grid().sync(); } while (0)

    if (IN(0)) { PHASE_PTRS(); for (int rep_ = 0; rep_ < NREP(0); ++rep_) { p0_prologue(P, lds, tid, lane, wave); __syncthreads(); } SEAM(0); }
    if (IN(1)) { PHASE_PTRS();
      for (int rep_ = 0; rep_ < NREP(1); ++rep_) {
        pg8::Gemm g{P.XN(), P.WIN(), M, NINP, D}; pg8::StaticOrder S; S.init(M, NINP, G, bx);
        pg8::EpiIn E{ws, P.SSQQ(), P.SSQKV(), P.C128(), P.S128(), P.C64(), P.S64()};
        pg8::gemm_phase<pg8::EpiIn, pg8::StaticOrder, true, true>(lds, g, S, E);
      }
        SEAM(1);
    }
    if (IN(2)) { PHASE_PTRS();
        meta_stage2(P, tid);
      for (int rep_ = 0; rep_ < NREP(2); ++rep_) {
        { pg8::Gemm g{P.CQ(), P.WUQ(), M, 1536, 512}; pg8::StaticOrder S; S.init(M, 1536, G, bx);
          pg8::EpiQ E{P.QN(), P.QR(), P.SSQQ(), P.C64(), P.S64(), 0.07216878364870322f * 1.4426950408889634f};
          pg8::gemm_phase<pg8::EpiQ, pg8::StaticOrder, true, true>(lds, g, S, E); }
        { pg8::Gemm g{P.CKV(), P.WUK(), M, 1024, 256}; pg8::StaticOrder S; S.init(M, 1024, G, bx);
          pg8::EpiK E{P.KN(), P.SSQKV()};
          pg8::gemm_phase<pg8::EpiK, pg8::StaticOrder, true, true>(lds, g, S, E); }
        { pg8::Gemm g{P.WUV(), P.CKV(), 1024, M, 256}; pg8::StaticOrder S; S.init(1024, M, G, bx);
          pg8::EpiVT E{P.VT(), P.SSQKV()};
          pg8::gemm_phase<pg8::EpiVT, pg8::StaticOrder, true, true>(lds, g, S, E); }
      }
        SEAM(2);
    }
    if (IN(3)) { PHASE_PTRS();
        volatile LAS unsigned* qw = (volatile LAS unsigned*)(lds + QWORD_OFF);
#if defined(PROBE_RET2)
        for (;;) { __syncthreads(); if (tid == 0) *qw = __hip_atomic_fetch_add(P.ctl() + 128, 1u, __ATOMIC_RELAXED, __HIP_MEMORY_SCOPE_AGENT); __syncthreads();
            const int idx = (int)__builtin_amdgcn_readfirstlane(*qw); if (idx >= 64) break; ret_unit(P, lds, idx >> 3, idx & 7, tid, lane, wave, P.ws == nullptr); }
#endif
#if defined(PROBE_ATT2)
        for (;;) { __syncthreads(); if (tid == 0) *qw = __hip_atomic_fetch_add(P.ctl() + 192, 1u, __ATOMIC_RELAXED, __HIP_MEMORY_SCOPE_AGENT); __syncthreads();
            const int a = (int)__builtin_amdgcn_readfirstlane(*qw); if (a >= 1024) break; attn_unit(P, lds, (a & 63) >> 3, a & 7, 15 - (a >> 6), tid, lane, wave, P.ws == nullptr); }
#endif
#ifndef NO_RET
        for (;;) {
            __syncthreads();
            if (tid == 0) *qw = __hip_atomic_fetch_add(P.ctl(), 1u, __ATOMIC_RELAXED, __HIP_MEMORY_SCOPE_AGENT);
            __syncthreads();
            const int idx = (int)__builtin_amdgcn_readfirstlane(*qw);
            if (idx >= 64) break;
            ret_unit(P, lds, idx >> 3, idx & 7, tid, lane, wave);
        }
#endif
#ifndef NO_ATT
        for (;;) {
            __syncthreads();
            if (tid == 0) *qw = __hip_atomic_fetch_add(P.ctl() + 64, 1u, __ATOMIC_RELAXED, __HIP_MEMORY_SCOPE_AGENT);
            __syncthreads();
            const int a = (int)__builtin_amdgcn_readfirstlane(*qw);
            if (a >= 1024) break;
            attn_unit(P, lds, (a & 63) >> 3, a & 7, 15 - (a >> 6), tid, lane, wave);
        }
#endif
        SEAM(3);
    }
    if (IN(4)) { PHASE_PTRS();
      for (int rep_ = 0; rep_ < NREP(4); ++rep_) {
        { pg8::Gemm g{P.ZMLA(), P.WBM(), M, D, 1024}; pg8::StaticOrder S; S.init(M, D, G, bx);
          pg8::EpiMerge<0> E{P.MG(), P.GATES()};
          pg8::gemm_phase<pg8::EpiMerge<0>, pg8::StaticOrder, true, true>(lds, g, S, E); }
        { pg8::Gemm g{P.ZRET(), P.WBR(), M, D, 1024}; pg8::StaticOrder S; S.init(M, D, G, bx);
          pg8::EpiMerge<1> E{P.MG(), P.GATES()};
          pg8::gemm_phase<pg8::EpiMerge<1>, pg8::StaticOrder, true, true>(lds, g, S, E); }
      }
        SEAM(4);
    }
    if (IN(5)) { PHASE_PTRS();
      for (int rep_ = 0; rep_ < NREP(5); ++rep_) {
        pg8::Gemm g{P.MG(), P.WOUT(), M, D, D}; pg8::StaticOrder S; S.init(M, D, G, bx);
        pg8::EpiOut E{P.x(), P.XN(), P.SSQO()};
        pg8::gemm_phase<pg8::EpiOut, pg8::StaticOrder, true, true>(lds, g, S, E);
      }
        SEAM(5);
    }
    if (IN(6)) { PHASE_PTRS();
        const int gw = bx * NWAVES + wave, NGW = G * NWAVES;
        for (int m = gw; m < M; m += NGW) { float* orow = P.out() + (size_t)m * D; const bf16* prow = P.XN() + (size_t)m * D;
            float ss = lane < 32 ? P.SSQO()[(size_t)m * 32 + lane] : 0.f; ss = wave_sum(ss);
            const float rs = 1.0f / sqrtf(ss * (1.f / D) + NORM_EPS);
#pragma unroll
            for (int j = 0; j < 4; ++j) { const int c0 = 8 * (lane + 64 * j); f32x4 v0, v1; pg8::unpack8(*(const u32x4*)(prow + c0), v0, v1);
                const f32x4 w0 = *(const f32x4*)(P.fnw() + c0), w1 = *(const f32x4*)(P.fnw() + c0 + 4);
                *(f32x4*)(orow + c0) = v0 * rs * w0; *(f32x4*)(orow + c0 + 4) = v1 * rs * w1; } }
    }
#undef IN
#undef SEAM
}

#ifndef N_LAUNCHES
#define N_LAUNCHES 1
#endif
template <int LO, int HI> static bool setup_one(int& per_cu) {
    if (hipFuncSetAttribute((const void*)hybrid_fwd<LO, HI>, hipFuncAttributeMaxDynamicSharedMemorySize, LDS_BYTES) != hipSuccess) { fprintf(stderr, "kernel_launch: hipFuncSetAttribute failed\n"); return false; }
    if (hipOccupancyMaxActiveBlocksPerMultiprocessor(&per_cu, (const void*)hybrid_fwd<LO, HI>, NTHR, LDS_BYTES) != hipSuccess || per_cu < 1) { fprintf(stderr, "kernel_launch: occupancy query says %d blocks per CU\n", per_cu); per_cu = 1; }
    (void)hipGetLastError();
    return true;
}
extern "C" void kernel_launch(void* const* d_in, const int* in_sizes, int n_in, void* d_out, int out_size, void* d_ws, size_t ws_size, hipStream_t stream) {
    static int grid = 0;
    if (grid == 0) {
        if (n_in != 14 || out_size != M * D || ws_size < WS_END) { fprintf(stderr, "kernel_launch: unexpected shapes (n_in %d, out %d, ws %zu)\n", n_in, out_size, ws_size); grid = -1; return; }
        int dev = 0, cus = 0, per_cu = 1; bool ok = true;
        (void)hipGetDevice(&dev); (void)hipDeviceGetAttribute(&cus, hipDeviceAttributeMultiprocessorCount, dev);
#if N_LAUNCHES == 1
        ok = setup_one<0, 7>(per_cu);
#else
        ok = setup_one<0, 1>(per_cu) && setup_one<1, 2>(per_cu) && setup_one<2, 3>(per_cu) && setup_one<3, 4>(per_cu) && setup_one<4, 5>(per_cu) && setup_one<5, 6>(per_cu) && setup_one<6, 7>(per_cu);
#endif
        if (!ok) { grid = -1; return; }
        grid = cus * per_cu;
        if (grid != 256) fprintf(stderr, "kernel_launch: note: grid = %d workgroups\n", grid);
    }
    if (grid < 0) return;
    Args a{};
    for (int i = 0; i < 14; ++i) a.in[i] = (const float*)d_in[i];
    a.out = (float*)d_out; a.ws = (unsigned char*)d_ws;
#if N_LAUNCHES == 1
    void* kargs[] = {&a};
    hipError_t e = hipLaunchCooperativeKernel((const void*)hybrid_fwd<0, 7>, dim3(grid), dim3(NTHR), kargs, LDS_BYTES, stream);
    if (e != hipSuccess) fprintf(stderr, "kernel_launch: cooperative launch failed: %s (grid %d)\n", hipGetErrorString(e), grid);
#else
    hipLaunchKernelGGL((hybrid_fwd<0, 1>), dim3(grid), dim3(NTHR), LDS_BYTES, stream, a);
    hipLaunchKernelGGL((hybrid_fwd<1, 2>), dim3(grid), dim3(NTHR), LDS_BYTES, stream, a);
    hipLaunchKernelGGL((hybrid_fwd<2, 3>), dim3(grid), dim3(NTHR), LDS_BYTES, stream, a);
    hipLaunchKernelGGL((hybrid_fwd<3, 4>), dim3(grid), dim3(NTHR), LDS_BYTES, stream, a);
    hipLaunchKernelGGL((hybrid_fwd<4, 5>), dim3(grid), dim3(NTHR), LDS_BYTES, stream, a);
    hipLaunchKernelGGL((hybrid_fwd<5, 6>), dim3(grid), dim3(NTHR), LDS_BYTES, stream, a);
    hipLaunchKernelGGL((hybrid_fwd<6, 7>), dim3(grid), dim3(NTHR), LDS_BYTES, stream, a);
#endif
}
```

```cpp
#include <hip/hip_runtime.h>
#include <hip/hip_cooperative_groups.h>
#include <cstdio>
#include <cstdint>
constexpr size_t MiB = 1u << 20;
constexpr size_t WS_CTL = 0, WS_WIN = 1 * MiB, WS_WUQ = 41 * MiB, WS_WUK = 43 * MiB, WS_WUV = 43 * MiB + 512 * 1024, WS_WBM = 44 * MiB, WS_WBR = 48 * MiB, WS_WOUT = 52 * MiB;
constexpr size_t WS_C128 = 60 * MiB, WS_S128 = 61 * MiB + 256 * 1024, WS_C64 = 62 * MiB + 512 * 1024, WS_S64 = 63 * MiB + 256 * 1024;
constexpr size_t WS_MP = 64 * MiB, WS_R0 = 64 * MiB + 256 * 1024, WS_SSQQ = 65 * MiB, WS_SSQKV = 66 * MiB, WS_SSQO = 67 * MiB, WS_KR = 71 * MiB;
constexpr size_t WS_XN = 76 * MiB, WS_QN = 76 * MiB, WS_QR = 140 * MiB, WS_CQ = 204 * MiB, WS_CKV = 236 * MiB, WS_ZMLA = 252 * MiB, WS_RQ = 316 * MiB, WS_RK = 380 * MiB, WS_MG = 316 * MiB;
constexpr size_t WS_RV = 444 * MiB, WS_ZRET = 508 * MiB, WS_GATES = 572 * MiB, WS_KN = 828 * MiB, WS_VT = 894 * MiB, WS_END = 960 * MiB;
namespace pg8 {
#define PG8_LAS __attribute__((address_space(3)))
typedef unsigned short bf16_t;
typedef short bf16x8 __attribute__((ext_vector_type(8)));
typedef float f32x4 __attribute__((ext_vector_type(4)));
typedef unsigned u32x4 __attribute__((ext_vector_type(4)));
constexpr int BM = 256, BK = 64, HALF = 128, HTB = HALF * BK * 2  , STAGE_BYTES = 8 * HTB, NXCD = 8, WGM = 8;

__host__ __device__ __forceinline__ int lds_byte(int r, int c) { const int st = (r >> 4) * 2 + (c >> 5), rr = r & 15, cc = c & 31, ob = rr * 64 + cc * 2; return st * 1024 + (ob ^ (((ob >> 9) & 1) << 5)); }
__host__ __device__ __forceinline__ void stage_rc(int b, int& R, int& C) { const int st = b / 1024, sb = b % 1024, swz = sb ^ (((sb >> 9) & 1) << 5); R = (st >> 1) * 16 + swz / 64; C = (st & 1) * 32 + (swz % 64) / 2; }
__host__ __device__ __forceinline__ int perm32(int rho) { const int n = rho >> 4, i = rho & 15; return 8 * (i >> 2) + 4 * n + (i & 3); }

struct Unit { int pm, pn; };
struct Gemm { const bf16_t* A; const bf16_t* Bt; int M, N, K; };

struct StaticOrder {
    int nM, nN, nwg, G, c;
    __host__ __device__ void init(int M, int N, int G_, int c_) { nM = M / BM; nN = N / BM; nwg = nM * nN; G = G_; c = c_; }
    __host__ __device__ bool next(int i, Unit& u) const {
        const long L = (long)i * G + c; if (L >= nwg) return false;
        int wgid = (int)L; { const int q = nwg / NXCD, r = nwg % NXCD, xcd = wgid % NXCD, off = wgid / NXCD; wgid = (xcd < r ? xcd * (q + 1) : r * (q + 1) + (xcd - r) * q) + off; }
        const int nig = WGM * nN, gid = wgid / nig, fm = gid * WGM, gsz = (nM - fm) < WGM ? (nM - fm) : WGM;
        u.pm = fm + ((wgid % nig) % gsz); u.pn = (wgid % nig) / gsz; return true;
    }
    __device__ __forceinline__ void a_ready(const Unit&) const {}
    __device__ __forceinline__ void done(const Unit&) const {}
};

__device__ __forceinline__ unsigned cvt_pk_bf16(float lo, float hi) { unsigned r; asm volatile("v_cvt_pk_bf16_f32 %0, %1, %2" : "=v"(r) : "v"(lo), "v"(hi)); return r; }
typedef float f32x2 __attribute__((ext_vector_type(2)));
typedef unsigned u32x2 __attribute__((ext_vector_type(2)));
constexpr int TOK = 4096, KSEQ = 4160, KOFF = 64;
__device__ __forceinline__ float head_lg2(int h) { const float x = __uint_as_float((unsigned)(127 - 5 - h) << 23); const float p = x * (1.f + x * (0.5f + x * (0.33333333f + x * (0.25f + x * (0.2f + x * (0.16666667f + x * 0.14285714f)))))); return -p * 1.4426950408889634f; }
__device__ __forceinline__ float sigmoid_f(float x) { return __builtin_amdgcn_rcpf(1.f + __expf(-x)); }
__device__ __forceinline__ float bf2f(unsigned short b) { return __uint_as_float((unsigned)b << 16); }
__device__ __forceinline__ u32x4 pack8(f32x4 v0, f32x4 v1) { u32x4 w; w.x = cvt_pk_bf16(v0[0], v0[1]); w.y = cvt_pk_bf16(v0[2], v0[3]); w.z = cvt_pk_bf16(v1[0], v1[1]); w.w = cvt_pk_bf16(v1[2], v1[3]); return w; }
__device__ __forceinline__ u32x2 pack4(f32x4 v) { u32x2 w; w.x = cvt_pk_bf16(v[0], v[1]); w.y = cvt_pk_bf16(v[2], v[3]); return w; }
__device__ __forceinline__ void unpack8(u32x4 w, f32x4& a, f32x4& b) {
    a[0] = __uint_as_float(w.x << 16); a[1] = __uint_as_float(w.x & 0xffff0000u); a[2] = __uint_as_float(w.y << 16); a[3] = __uint_as_float(w.y & 0xffff0000u);
    b[0] = __uint_as_float(w.z << 16); b[1] = __uint_as_float(w.z & 0xffff0000u); b[2] = __uint_as_float(w.w << 16); b[3] = __uint_as_float(w.w & 0xffff0000u); }

struct EpiIn {
    static constexpr bool PERM = true, AFTER_DRAIN = false;
    unsigned char* ws; float *ssq_q, *ssq_kv; const float *C128, *S128, *C64, *S64;
    __device__ __forceinline__ void operator()(const f32x4 (&acc)[2][2][4][2], const Unit& u, int wr, int wc, int fr, int fq) const {
        const int pn = u.pn, row0 = u.pm * BM + wr * 64 + fr;
        if (pn < 3) {
            bf16_t* base = (bf16_t*)(ws + (pn < 2 ? WS_CQ : WS_CKV)); const int ldc = pn < 2 ? 512 : 256, colt = pn < 2 ? pn * 256 : 0;
            float* sq = pn < 2 ? ssq_q : ssq_kv; const int sld = pn < 2 ? 8 : 4, soff = (pn < 2 ? pn * 4 : 0) + wc;
#pragma unroll
            for (int ai = 0; ai < 2; ++ai)
#pragma unroll
                for (int m = 0; m < 4; ++m) { const int row = row0 + ai * HALF + m * 16; float s = 0.f;
#pragma unroll
                    for (int bj = 0; bj < 2; ++bj) { const f32x4 v0 = acc[ai][bj][m][0], v1 = acc[ai][bj][m][1];
                        s += (v0[0] * v0[0] + v0[1] * v0[1]) + (v0[2] * v0[2] + v0[3] * v0[3]) + (v1[0] * v1[0] + v1[1] * v1[1]) + (v1[2] * v1[2] + v1[3] * v1[3]);
                        *(u32x4*)(base + (size_t)row * ldc + colt + bj * HALF + wc * 32 + 8 * fq) = pack8(v0, v1); }
                    s += __shfl_xor(s, 16); s += __shfl_xor(s, 32);
                    if (fq == 0) sq[(size_t)row * sld + soff] = s; }
        } else if (pn == 3) {
            if (wc < 2) {
                const int j0 = 16 * wc + 4 * fq;
#pragma unroll
                for (int ai = 0; ai < 2; ++ai)
#pragma unroll
                    for (int m = 0; m < 4; ++m) { const int row = row0 + ai * HALF + m * 16, b = row >> 12, t = row & (TOK - 1), pos = 16 + t;
                        const f32x4 c = *(const f32x4*)(C64 + pos * 32 + j0), s = *(const f32x4*)(S64 + pos * 32 + j0);
                        const f32x4 t1 = acc[ai][0][m][0], t2 = acc[ai][0][m][1];
                        bf16_t* o = (bf16_t*)(ws + WS_KR) + (size_t)(b * KSEQ + KOFF + t) * 64 + j0;
                        *(u32x2*)o = pack4(t1 * c - t2 * s); *(u32x2*)(o + 32) = pack4(t1 * s + t2 * c); }
            }
        } else if ((pn >= 8) && (pn < 16)) {
            const bool isk = pn >= 12; bf16_t* base = (bf16_t*)(ws + (isk ? WS_RK : WS_RQ)); const int colt = (pn - (isk ? 12 : 8)) * 256; const int j0 = 16 * wc + 4 * fq;
#pragma unroll
            for (int ai = 0; ai < 2; ++ai)
#pragma unroll
                for (int m = 0; m < 4; ++m) { const int row = row0 + ai * HALF + m * 16, t = row & (TOK - 1), pos = 16 + t;
                    const f32x4 c = *(const f32x4*)(C128 + pos * 64 + j0), s = *(const f32x4*)(S128 + pos * 64 + j0);
#pragma unroll
                    for (int bj = 0; bj < 2; ++bj) { float f = 1.f;
                        if (isk) { const int h = (colt >> 7) + bj; f = 0.08838834764831845f * __builtin_amdgcn_exp2f(head_lg2(h) * (float)(127 - (t & 127))); }
                        const f32x4 t1 = acc[ai][bj][m][0] * f, t2 = acc[ai][bj][m][1] * f;
                        bf16_t* o = base + (size_t)row * 1024 + colt + bj * HALF + j0;
                        *(u32x2*)o = pack4(t1 * c - t2 * s); *(u32x2*)(o + 64) = pack4(t1 * s + t2 * c); } }
        } else {
            size_t boff; int ldc, colt, act;
            if (pn < 8) { boff = WS_ZMLA; ldc = 1024; colt = (pn - 4) * 256; act = 1; }
            else if (pn < 20) { boff = WS_RV; ldc = 1024; colt = (pn - 16) * 256; act = 0; }
            else if (pn < 24) { boff = WS_ZRET; ldc = 1024; colt = (pn - 20) * 256; act = 1; }
            else { boff = WS_GATES; ldc = 4096; colt = (pn - 24) * 256; act = 2; }
            bf16_t* base = (bf16_t*)(ws + boff);
#pragma unroll
            for (int ai = 0; ai < 2; ++ai)
#pragma unroll
                for (int m = 0; m < 4; ++m) { const int row = row0 + ai * HALF + m * 16;
#pragma unroll
                    for (int bj = 0; bj < 2; ++bj) { f32x4 v0 = acc[ai][bj][m][0], v1 = acc[ai][bj][m][1];
                        if (act != 0) {
#pragma unroll
                            for (int i = 0; i < 4; ++i) { const float s0 = sigmoid_f(v0[i]), s1 = sigmoid_f(v1[i]); v0[i] = act == 1 ? v0[i] * s0 : s0; v1[i] = act == 1 ? v1[i] * s1 : s1; } }
                        *(u32x4*)(base + (size_t)row * ldc + colt + bj * HALF + wc * 32 + 8 * fq) = pack8(v0, v1); } }
        }
    }
};

__device__ __forceinline__ float rs_from(const float* p, int n, float inv_d, float eps) { float s = 0.f; for (int i = 0; i < n; ++i) s += p[i]; return 1.0f / sqrtf(s * inv_d + eps); }

struct EpiQ {
    static constexpr bool PERM = true, AFTER_DRAIN = false;
    bf16_t *QN, *QR; const float *ssq_q, *C64, *S64; float qscale;
    __device__ __forceinline__ void operator()(const f32x4 (&acc)[2][2][4][2], const Unit& u, int wr, int wc, int fr, int fq) const {
        const int pn = u.pn, row0 = u.pm * BM + wr * 64 + fr;
#pragma unroll
        for (int ai = 0; ai < 2; ++ai)
#pragma unroll
            for (int m = 0; m < 4; ++m) { const int row = row0 + ai * HALF + m * 16;
                const f32x4 q0 = *(const f32x4*)(ssq_q + (size_t)row * 8), q1 = *(const f32x4*)(ssq_q + (size_t)row * 8 + 4);
                const float ss = ((q0[0] + q0[1]) + (q0[2] + q0[3])) + ((q1[0] + q1[1]) + (q1[2] + q1[3]));
                const float f = qscale / sqrtf(ss * (1.f / 512.f) + 1e-6f);
                if (pn < 4) {
#pragma unroll
                    for (int bj = 0; bj < 2; ++bj) *(u32x4*)(QN + (size_t)row * 1024 + pn * 256 + bj * HALF + wc * 32 + 8 * fq) = pack8(acc[ai][bj][m][0] * f, acc[ai][bj][m][1] * f);
                } else {
                    const int pos = 16 + (row & (TOK - 1)), j0 = 16 * (wc & 1) + 4 * fq;
                    const f32x4 c = *(const f32x4*)(C64 + pos * 32 + j0), s = *(const f32x4*)(S64 + pos * 32 + j0);
#pragma unroll
                    for (int bj = 0; bj < 2; ++bj) { const int head = (pn - 4) * 4 + bj * 2 + (wc >> 1);
                        const f32x4 t1 = acc[ai][bj][m][0] * f, t2 = acc[ai][bj][m][1] * f;
                        bf16_t* o = QR + (size_t)row * 512 + head * 64 + j0;
                        *(u32x2*)o = pack4(t1 * c - t2 * s); *(u32x2*)(o + 32) = pack4(t1 * s + t2 * c); }
                }
            }
    }
};
struct EpiK {
    static constexpr bool PERM = true, AFTER_DRAIN = false;
    bf16_t* KN; const float* ssq_kv;
    __device__ __forceinline__ void operator()(const f32x4 (&acc)[2][2][4][2], const Unit& u, int wr, int wc, int fr, int fq) const {
        const int pn = u.pn, row0 = u.pm * BM + wr * 64 + fr;
#pragma unroll
        for (int ai = 0; ai < 2; ++ai)
#pragma unroll
            for (int m = 0; m < 4; ++m) { const int row = row0 + ai * HALF + m * 16, b = row >> 12, t = row & (TOK - 1);
                const f32x4 q0 = *(const f32x4*)(ssq_kv + (size_t)row * 4);
                const float f = 1.0f / sqrtf(((q0[0] + q0[1]) + (q0[2] + q0[3])) * (1.f / 256.f) + 1e-6f);
#pragma unroll
                for (int bj = 0; bj < 2; ++bj) *(u32x4*)(KN + (size_t)(b * KSEQ + KOFF + t) * 1024 + pn * 256 + bj * HALF + wc * 32 + 8 * fq) = pack8(acc[ai][bj][m][0] * f, acc[ai][bj][m][1] * f);
                asm volatile("" ::: "memory"); }
    }
};
struct EpiVT {
    static constexpr bool PERM = true, AFTER_DRAIN = false;
    bf16_t* VT; const float* ssq_kv;
    __device__ __forceinline__ void operator()(const f32x4 (&acc)[2][2][4][2], const Unit& u, int wr, int wc, int fr, int fq) const {
        const int pn = u.pn, row0 = u.pm * BM + wr * 64 + fr;
#pragma unroll
        for (int bj = 0; bj < 2; ++bj) { const int col = pn * 256 + bj * HALF + wc * 32 + 8 * fq, b = col >> 12, t = col & (TOK - 1);
            f32x4 f0, f1;
#pragma unroll
            for (int i = 0; i < 4; ++i) { const f32x4 a = *(const f32x4*)(ssq_kv + (size_t)(col + i) * 4);
                f0[i] = 1.0f / sqrtf(((a[0] + a[1]) + (a[2] + a[3])) * (1.f / 256.f) + 1e-6f); asm volatile("" : "+v"(f0[i]) :: "memory"); }
#pragma unroll
            for (int i = 0; i < 4; ++i) { const f32x4 c = *(const f32x4*)(ssq_kv + (size_t)(col + 4 + i) * 4);
                f1[i] = 1.0f / sqrtf(((c[0] + c[1]) + (c[2] + c[3])) * (1.f / 256.f) + 1e-6f); asm volatile("" : "+v"(f1[i]) :: "memory"); }
#pragma unroll
            for (int ai = 0; ai < 2; ++ai)
#pragma unroll
                for (int m = 0; m < 4; ++m) { const int row = row0 + ai * HALF + m * 16;
                    bf16_t* o = VT + (size_t)row * (8 * KSEQ) + b * KSEQ + KOFF + (t & ~15) + ((t & 8) ? 4 : 0);
                    *(u32x2*)o = pack4(acc[ai][bj][m][0] * f0); *(u32x2*)(o + 8) = pack4(acc[ai][bj][m][1] * f1); } }
    }
};
template <int PASS> struct EpiMerge {
    static constexpr bool PERM = true, AFTER_DRAIN = false;
    bf16_t* MG; const bf16_t* GATES;
    __device__ __forceinline__ void operator()(const f32x4 (&acc)[2][2][4][2], const Unit& u, int wr, int wc, int fr, int fq) const {
        const int pn = u.pn, row0 = u.pm * BM + wr * 64 + fr;
#pragma unroll
        for (int ai = 0; ai < 2; ++ai)
#pragma unroll
            for (int m = 0; m < 4; ++m) { const int row = row0 + ai * HALF + m * 16;
#pragma unroll
                for (int bj = 0; bj < 2; ++bj) { const int col = pn * 256 + bj * HALF + wc * 32 + 8 * fq;
                    f32x4 g0, g1; unpack8(*(const u32x4*)(GATES + (size_t)row * 4096 + PASS * 2048 + col), g0, g1);
                    f32x4 v0 = acc[ai][bj][m][0] * g0, v1 = acc[ai][bj][m][1] * g1;
                    if (PASS == 1) { f32x4 p0, p1; unpack8(*(const u32x4*)(MG + (size_t)row * 2048 + col), p0, p1); v0 += p0; v1 += p1; }
                    *(u32x4*)(MG + (size_t)row * 2048 + col) = pack8(v0, v1); } }
    }
};
struct EpiOut {
    static constexpr bool PERM = true, AFTER_DRAIN = false;
    bf16_t* PRE;
    __device__ __forceinline__ void operator()(const f32x4 (&acc)[2][2][4][2], const Unit& u, int wr, int wc, int fr, int fq) const {
        const int pn = u.pn, row0 = u.pm * BM + wr * 64 + fr;
#pragma unroll
        for (int ai = 0; ai < 2; ++ai)
#pragma unroll
            for (int m = 0; m < 4; ++m) { const int row = row0 + ai * HALF + m * 16;
#pragma unroll
                for (int bj = 0; bj < 2; ++bj) *(u32x4*)(PRE + (size_t)row * 2048 + pn * 256 + bj * HALF + wc * 32 + 8 * fq) = pack8(acc[ai][bj][m][0], acc[ai][bj][m][1]); }
    }
};
template <class Epi, class Sched, bool ALIGN_EPI = false, bool SP2 = false>
__device__ __forceinline__ void gemm_phase(PG8_LAS unsigned char* lds, const Gemm g, const Sched& S, const Epi& E) {
    int tid = threadIdx.x; asm volatile("" : "+v"(tid));
    const int wid = __builtin_amdgcn_readfirstlane(tid >> 6), lane = tid & 63, wr = wid >> 2, wc = wid & 3, fr = lane & 15, fq = lane >> 4;
    const int K = g.K, nt = K / BK;
    unsigned voffA[2], voffB[2];
#pragma unroll
    for (int i = 0; i < 2; ++i) { int R, C; stage_rc(tid * 16 + i * 8192, R, C); const int Rb = Epi::PERM ? ((R & ~31) + perm32(R & 31)) : R;
        voffA[i] = (unsigned)(R * K + C) * 2u; voffB[i] = (unsigned)(Rb * K + C) * 2u; }
    const size_t kstep = (size_t)(BK * 2);
    const size_t hstep = (size_t)HALF * K * 2;
    const size_t tstep = 2 * hstep;
    const unsigned ldsw = (unsigned)wid * 1024u;
    const int aoff = lds_byte(wr * 64 + fr, fq * 8), boff = lds_byte(wc * 32 + fr, fq * 8);
#define PG8_SA(b, h) (((b) * 2 + (h)) * HTB)
#define PG8_SB(b, h) ((4 + (b) * 2 + (h)) * HTB)
#define PG8_STAGE(bufoff, gbase, voff) do { _Pragma("unroll") for (int _i = 0; _i < 2; ++_i) \
        __builtin_amdgcn_global_load_lds((const unsigned*)((const char*)(gbase) + (voff)[_i]), (PG8_LAS unsigned*)(lds + (bufoff) + ldsw + _i * 8192), 16, 0, 0); } while (0)
#define PG8_LDA(dst, b, h) do { _Pragma("unroll") for (int m = 0; m < 4; ++m) _Pragma("unroll") for (int k = 0; k < 2; ++k) dst[m][k] = *(const PG8_LAS bf16x8*)(lds + PG8_SA(b, h) + aoff + m * 2048 + k * 1024); } while (0)
#define PG8_LDB(dst, b, h) do { _Pragma("unroll") for (int n = 0; n < 2; ++n) _Pragma("unroll") for (int k = 0; k < 2; ++k) dst[n][k] = *(const PG8_LAS bf16x8*)(lds + PG8_SB(b, h) + boff + n * 2048 + k * 1024); } while (0)
#define PG8_MMA(ai, bj, At, Bt) do { __builtin_amdgcn_s_setprio(1); _Pragma("unroll") for (int m = 0; m < 4; ++m) _Pragma("unroll") for (int n = 0; n < 2; ++n) _Pragma("unroll") for (int k = 0; k < 2; ++k) \
        acc[ai][bj][m][n] = __builtin_amdgcn_mfma_f32_16x16x32_bf16(Bt[n][k], At[m][k], acc[ai][bj][m][n], 0, 0, 0); __builtin_amdgcn_s_setprio(0); } while (0)
#define PG8_WAIT_V(n) asm volatile("s_waitcnt vmcnt(" #n ")" ::: "memory")
#define PG8_WAIT_L(n) asm volatile("s_waitcnt lgkmcnt(" #n ")" ::: "memory")
#define PG8_BAR __builtin_amdgcn_s_barrier()
#define PG8_SCHED __builtin_amdgcn_sched_barrier(0)
    Unit cur, nxt; int ui = 0;
    if (!S.next(0, cur)) return;
    f32x4 acc[2][2][4][2];
#pragma unroll
    for (int a = 0; a < 2; ++a)
#pragma unroll
        for (int b = 0; b < 2; ++b)
#pragma unroll
            for (int m = 0; m < 4; ++m)
#pragma unroll
                for (int n = 0; n < 2; ++n) acc[a][b][m][n] = (f32x4){0.f, 0.f, 0.f, 0.f};
    bf16x8 At[4][2], B0[2][2], B1[2][2];
    const char* cA = (const char*)g.A + (size_t)cur.pm * tstep; const char* cB = (const char*)g.Bt + (size_t)cur.pn * tstep;
    S.a_ready(cur);
    if constexpr (SP2) {
        PG8_STAGE(PG8_SB(0, 0), cB, voffB); PG8_STAGE(PG8_SB(0, 1), cB + hstep, voffB); PG8_STAGE(PG8_SA(0, 0), cA, voffA); PG8_STAGE(PG8_SA(0, 1), cA + hstep, voffA);
        if (wr == 1) PG8_BAR;
        PG8_WAIT_V(2); PG8_BAR;
        PG8_STAGE(PG8_SB(1, 0), cB + kstep, voffB); PG8_STAGE(PG8_SA(1, 0), cA + kstep, voffA); PG8_STAGE(PG8_SB(1, 1), cB + hstep + kstep, voffB);
        PG8_WAIT_V(6); PG8_BAR;
    } else {
        PG8_STAGE(PG8_SB(0, 0), cB, voffB); PG8_STAGE(PG8_SA(0, 0), cA, voffA); PG8_STAGE(PG8_SB(0, 1), cB + hstep, voffB); PG8_STAGE(PG8_SA(0, 1), cA + hstep, voffA);
        if (wr == 1) PG8_BAR;
        PG8_WAIT_V(4); PG8_BAR;
        PG8_STAGE(PG8_SB(1, 0), cB + kstep, voffB); PG8_STAGE(PG8_SA(1, 0), cA + kstep, voffA); PG8_STAGE(PG8_SB(1, 1), cB + hstep + kstep, voffB);
        PG8_WAIT_V(6); PG8_BAR;
    }
    for (;;) {
        const bool has_next = S.next(ui + 1, nxt);
        const char* nA = has_next ? (const char*)g.A + (size_t)nxt.pm * tstep : cA; const char* nB = has_next ? (const char*)g.Bt + (size_t)nxt.pn * tstep : cB;
#pragma nounroll
        for (int t = 0; t < nt; t += 2) {
            const bool last = (t == nt - 2);
            const char* a1 = cA + (size_t)(t + 1) * kstep;
            const char* a2 = last ? nA : cA + (size_t)(t + 2) * kstep; const char* b2 = last ? nB : cB + (size_t)(t + 2) * kstep;
            const char* a3 = a2 + kstep; const char* b3 = b2 + kstep;
            if (last && has_next) S.a_ready(nxt);
            if constexpr (SP2) {
            PG8_LDB(B0, 0, 0); PG8_LDB(B1, 0, 1); PG8_SCHED; PG8_LDA(At, 0, 0); PG8_STAGE(PG8_SA(1, 1), a1 + hstep, voffA);
            PG8_WAIT_V(8); PG8_WAIT_L(0); PG8_BAR; PG8_MMA(0, 0, At, B0); PG8_MMA(0, 1, At, B1); PG8_BAR; PG8_SCHED;
            PG8_LDA(At, 0, 1); PG8_STAGE(PG8_SB(0, 0), b2, voffB); PG8_STAGE(PG8_SB(0, 1), b2 + hstep, voffB); PG8_STAGE(PG8_SA(0, 0), a2, voffA);
            PG8_WAIT_V(8); PG8_WAIT_L(0); PG8_BAR; PG8_MMA(1, 0, At, B0); PG8_MMA(1, 1, At, B1); PG8_BAR; PG8_SCHED;
            PG8_LDB(B0, 1, 0); PG8_LDB(B1, 1, 1); PG8_SCHED; PG8_LDA(At, 1, 0); PG8_STAGE(PG8_SA(0, 1), a2 + hstep, voffA);
            PG8_WAIT_V(8); PG8_WAIT_L(0); PG8_BAR; PG8_MMA(0, 0, At, B0); PG8_MMA(0, 1, At, B1); PG8_BAR; PG8_SCHED;
            PG8_LDA(At, 1, 1); PG8_STAGE(PG8_SB(1, 0), b3, voffB); PG8_STAGE(PG8_SB(1, 1), b3 + hstep, voffB); PG8_STAGE(PG8_SA(1, 0), a3, voffA);
            PG8_WAIT_V(8); PG8_WAIT_L(0); PG8_BAR; PG8_MMA(1, 0, At, B0); PG8_MMA(1, 1, At, B1); PG8_BAR; PG8_SCHED;
            } else {
            PG8_LDB(B0, 0, 0); PG8_SCHED; PG8_LDA(At, 0, 0); PG8_STAGE(PG8_SA(1, 1), a1 + hstep, voffA);
            PG8_WAIT_L(8); PG8_BAR; PG8_WAIT_L(0); PG8_MMA(0, 0, At, B0); PG8_BAR; PG8_SCHED;
            PG8_LDB(B1, 0, 1); PG8_STAGE(PG8_SB(0, 0), b2, voffB);
            PG8_BAR; PG8_WAIT_L(0); PG8_MMA(0, 1, At, B1); PG8_BAR;
            PG8_LDA(At, 0, 1); PG8_STAGE(PG8_SA(0, 0), a2, voffA);
            PG8_BAR; PG8_WAIT_L(0); PG8_MMA(1, 0, At, B0); PG8_BAR; PG8_SCHED;
            PG8_STAGE(PG8_SB(0, 1), b2 + hstep, voffB);
            PG8_WAIT_V(6); PG8_BAR; PG8_MMA(1, 1, At, B1); PG8_BAR;
            PG8_LDB(B0, 1, 0); PG8_SCHED; PG8_LDA(At, 1, 0); PG8_STAGE(PG8_SA(0, 1), a2 + hstep, voffA);
            PG8_WAIT_L(8); PG8_BAR; PG8_WAIT_L(0); PG8_MMA(0, 0, At, B0); PG8_BAR; PG8_SCHED;
            PG8_LDB(B1, 1, 1); PG8_STAGE(PG8_SB(1, 0), b3, voffB);
            PG8_BAR; PG8_WAIT_L(0); PG8_MMA(0, 1, At, B1); PG8_BAR;
            PG8_LDA(At, 1, 1); PG8_STAGE(PG8_SA(1, 0), a3, voffA);
            PG8_BAR; PG8_WAIT_L(0); PG8_MMA(1, 0, At, B0); PG8_BAR; PG8_SCHED;
            PG8_STAGE(PG8_SB(1, 1), b3 + hstep, voffB);
            PG8_WAIT_V(6); PG8_BAR; PG8_MMA(1, 1, At, B1); PG8_BAR;
            }
        }
        if constexpr (ALIGN_EPI) { if (wr == 0) PG8_BAR; }
        if constexpr (!Epi::AFTER_DRAIN) { E(acc, cur, wr, wc, fr, fq); S.done(cur); }
        if (!has_next) break;
#pragma unroll
        for (int a = 0; a < 2; ++a)
#pragma unroll
            for (int b = 0; b < 2; ++b)
#pragma unroll
                for (int m = 0; m < 4; ++m)
#pragma unroll
                    for (int n = 0; n < 2; ++n) acc[a][b][m][n] = (f32x4){0.f, 0.f, 0.f, 0.f};
        cur = nxt; cA = nA; cB = nB; ++ui;
        if constexpr (ALIGN_EPI) { if (wr == 1) PG8_BAR; }
    }
    PG8_WAIT_V(0);
    if constexpr (!ALIGN_EPI) { if (wr == 0) PG8_BAR; }
    PG8_BAR;
    if constexpr (Epi::AFTER_DRAIN) { E.fused(acc, cur, wr, wc, fr, fq, lds, wid, lane); S.done(cur); }
#undef PG8_SA
#undef PG8_SB
#undef PG8_STAGE
#undef PG8_LDA
#undef PG8_LDB
#undef PG8_MMA
#undef PG8_WAIT_V
#undef PG8_WAIT_L
#undef PG8_BAR
#undef PG8_SCHED
}
}
namespace cg = cooperative_groups;
#define LAS __attribute__((address_space(3)))
typedef unsigned short bf16;
using pg8::f32x4; using pg8::bf16x8; using pg8::u32x4; using pg8::u32x2; using pg8::cvt_pk_bf16; using pg8::bf2f;
typedef float f32x16 __attribute__((ext_vector_type(16)));
typedef short s16x4 __attribute__((ext_vector_type(4)));
using pg8::TOK; using pg8::KSEQ; using pg8::KOFF;
constexpr int NB = 8, M = NB * TOK, D = 2048, NIN = 10048, NINP = 10240, NPOS = 4112;
constexpr int NWAVES = 8, NTHR = 512, LDS_BYTES = 147456, QWORD_OFF = 147200;
constexpr int NMP = 2368;
constexpr float NORM_EPS = 1e-6f, GN_EPS = 1e-5f;

struct Args { const float* in[14]; float* out; unsigned char* ws; };

__device__ __forceinline__ unsigned f2bf(float f) { unsigned u = __float_as_uint(f); return (u + 0x7fffu + ((u >> 16) & 1u)) >> 16; }
__device__ __forceinline__ unsigned pk2(float lo, float hi) { return f2bf(lo) | (f2bf(hi) << 16); }
__device__ __forceinline__ float wave_sum(float v) {
#pragma unroll
    for (int o = 1; o < 64; o <<= 1) v += __shfl_xor(v, o);
    return v;
}
__device__ __forceinline__ float head_lg2(int h) { return pg8::head_lg2(h); }

__device__ __forceinline__ int src_in(int n) {
    if (n < 768) return n;
    if (n < 1024) { const int p = n - 768; if (p >= 64) return -1; const int wc = p >> 5, fq = (p >> 3) & 3, nn = (p >> 2) & 1, i = p & 3; return 768 + 32 * nn + 16 * wc + 4 * fq + i; }
    if (n < 2048) return 832 + (n - 1024);
    if (n < 4096) { const int q = n - 2048, hb = q >> 7, p = q & 127, wc = p >> 5, fq = (p >> 3) & 3, nn = (p >> 2) & 1, i = p & 3; return 1856 + hb * 128 + 64 * nn + 16 * wc + 4 * fq + i; }
    if (n < 6144) return 3904 + (n - 4096);
    return 5952 + (n - 6144);
}
__device__ __forceinline__ int src_uq(int n) {
    if (n < 1024) return (n >> 7) * 192 + (n & 127);
    const int q = n - 1024, blk = q >> 7, p = q & 127, wc = p >> 5, fq = (p >> 3) & 3, nn = (p >> 2) & 1, i = p & 3;
    return (2 * blk + (wc >> 1)) * 192 + 128 + 32 * nn + 16 * (wc & 1) + 4 * fq + i;
}
template <int KIND> __device__ __forceinline__ void p0_item(const float* W, int ldw, int K, bf16* WT, const float* ksc, int item, int nblk, LAS float* scr, int lane) {
    const int kb = item / nblk, nb = item % nblk, k0 = 64 * kb, n0 = 32 * nb, nl = lane & 31;
    int sc;
    if (KIND == 0) sc = n0 + nl; else if (KIND == 1) sc = src_in(n0 + nl); else if (KIND == 2) sc = src_uq(n0 + nl);
    else if (KIND == 3) sc = ((n0 + nl) >> 7) * 256 + ((n0 + nl) & 127); else sc = ((n0 + nl) >> 7) * 256 + 128 + ((n0 + nl) & 127);
#pragma unroll 16
    for (int i = 0; i < 32; ++i) { const int kk = 2 * i + (lane >> 5); float v = sc >= 0 ? W[(size_t)(k0 + kk) * ldw + sc] : 0.f; if (ksc) v *= ksc[k0 + kk]; scr[kk * 33 + nl] = v; }
    asm volatile("s_waitcnt lgkmcnt(0)" ::: "memory");
    const int c = lane & 7;
#pragma unroll
    for (int j = 0; j < 4; ++j) { const int n = (lane >> 3) + 8 * j; const LAS float* s = scr + (8 * c) * 33 + n;
        u32x4 o; o.x = pk2(s[0 * 33], s[1 * 33]); o.y = pk2(s[2 * 33], s[3 * 33]); o.z = pk2(s[4 * 33], s[5 * 33]); o.w = pk2(s[6 * 33], s[7 * 33]);
        *(u32x4*)(WT + (size_t)(n0 + n) * K + k0 + 8 * c) = o; }
    asm volatile("s_waitcnt lgkmcnt(0)" ::: "memory");
}

struct Ptrs {
    const Args* a; unsigned char* ws;
    __device__ __forceinline__ const float* x() const { return a->in[0]; }
    __device__ __forceinline__ const float* meta() const { return a->in[1]; }
    __device__ __forceinline__ const float* norm_w() const { return a->in[2]; }
    __device__ __forceinline__ const float* w_in() const { return a->in[3]; }
    __device__ __forceinline__ const float* qnw() const { return a->in[4]; }
    __device__ __forceinline__ const float* w_uq() const { return a->in[5]; }
    __device__ __forceinline__ const float* kvnw() const { return a->in[6]; }
    __device__ __forceinline__ const float* w_ukv() const { return a->in[7]; }
    __device__ __forceinline__ const float* gnw() const { return a->in[8]; }
    __device__ __forceinline__ const float* gnb() const { return a->in[9]; }
    __device__ __forceinline__ const float* w_bm() const { return a->in[10]; }
    __device__ __forceinline__ const float* w_br() const { return a->in[11]; }
    __device__ __forceinline__ const float* w_out() const { return a->in[12]; }
    __device__ __forceinline__ const float* fnw() const { return a->in[13]; }
    __device__ __forceinline__ float* out() const { return a->out; }
    __device__ __forceinline__ bf16* WIN() const { return (bf16*)(ws + WS_WIN); }
    __device__ __forceinline__ bf16* WUQ() const { return (bf16*)(ws + WS_WUQ); }
    __device__ __forceinline__ bf16* WUK() const { return (bf16*)(ws + WS_WUK); }
    __device__ __forceinline__ bf16* WUV() const { return (bf16*)(ws + WS_WUV); }
    __device__ __forceinline__ bf16* WBM() const { return (bf16*)(ws + WS_WBM); }
    __device__ __forceinline__ bf16* WBR() const { return (bf16*)(ws + WS_WBR); }
    __device__ __forceinline__ bf16* WOUT() const { return (bf16*)(ws + WS_WOUT); }
    __device__ __forceinline__ bf16* KR() const { return (bf16*)(ws + WS_KR); }
    __device__ __forceinline__ bf16* XN() const { return (bf16*)(ws + WS_XN); }
    __device__ __forceinline__ bf16* QN() const { return (bf16*)(ws + WS_QN); }
    __device__ __forceinline__ bf16* QR() const { return (bf16*)(ws + WS_QR); }
    __device__ __forceinline__ bf16* CQ() const { return (bf16*)(ws + WS_CQ); }
    __device__ __forceinline__ bf16* CKV() const { return (bf16*)(ws + WS_CKV); }
    __device__ __forceinline__ bf16* ZMLA() const { return (bf16*)(ws + WS_ZMLA); }
    __device__ __forceinline__ bf16* RQ() const { return (bf16*)(ws + WS_RQ); }
    __device__ __forceinline__ bf16* RK() const { return (bf16*)(ws + WS_RK); }
    __device__ __forceinline__ bf16* MG() const { return (bf16*)(ws + WS_MG); }
    __device__ __forceinline__ bf16* RV() const { return (bf16*)(ws + WS_RV); }
    __device__ __forceinline__ bf16* ZRET() const { return (bf16*)(ws + WS_ZRET); }
    __device__ __forceinline__ bf16* GATES() const { return (bf16*)(ws + WS_GATES); }
    __device__ __forceinline__ bf16* KN() const { return (bf16*)(ws + WS_KN); }
    __device__ __forceinline__ bf16* VT() const { return (bf16*)(ws + WS_VT); }
    __device__ __forceinline__ float* C128() const { return (float*)(ws + WS_C128); }
    __device__ __forceinline__ float* S128() const { return (float*)(ws + WS_S128); }
    __device__ __forceinline__ float* C64() const { return (float*)(ws + WS_C64); }
    __device__ __forceinline__ float* S64() const { return (float*)(ws + WS_S64); }
    __device__ __forceinline__ float* MP() const { return (float*)(ws + WS_MP); }
    __device__ __forceinline__ float* R0() const { return (float*)(ws + WS_R0); }
    __device__ __forceinline__ float* SSQQ() const { return (float*)(ws + WS_SSQQ); }
    __device__ __forceinline__ float* SSQKV() const { return (float*)(ws + WS_SSQKV); }
    __device__ __forceinline__ float* SSQO() const { return (float*)(ws + WS_SSQO); }
    __device__ __forceinline__ unsigned* ctl() const { return (unsigned*)(ws + WS_CTL); }
};

__device__ __forceinline__ void p0_prologue(const Ptrs& P, LAS unsigned char* lds, int tid, int lane, int wave) {
    const int G = gridDim.x, bx = blockIdx.x;
    const int gtid = bx * NTHR + tid, NT = G * NTHR;
    if (gtid == 0) { P.ctl()[0] = 0u; P.ctl()[64] = 0u; P.ctl()[128] = 0u; P.ctl()[192] = 0u; }
    for (int i = gtid; i < NB * 48 * 512; i += NT) { const int b = i / (48 * 512), r = i % (48 * 512); ((unsigned*)(P.KN() + (size_t)b * KSEQ * 1024))[r] = 0u; }
    for (int i = gtid; i < NB * 48 * 32; i += NT) { const int b = i / (48 * 32), r = i % (48 * 32); ((unsigned*)(P.KR() + (size_t)b * KSEQ * 64))[r] = 0u; }
    for (int i = gtid; i < 1024 * NB * 24; i += NT) { const int row = i / (NB * 24), r = i % (NB * 24), b = r / 24, c = r % 24; ((unsigned*)(P.VT() + (size_t)row * (NB * KSEQ) + b * KSEQ))[c] = 0u; }
    for (int i = gtid; i < NPOS * 96; i += NT) { const int pos = i / 96, j = i % 96;
        const double e = j < 64 ? (double)j / 64.0 : (double)(j - 64) / 32.0;
        const float inv = (float)exp2(-e * 13.287712379549449); const float ang = (float)pos * inv;
        const double rev = (double)ang * 0.15915494309189535; const float a = (float)((rev - rint(rev)) * 6.283185307179586);
        const float c = cosf(a), s = sinf(a);
        if (j < 64) { P.C128()[pos * 64 + j] = c; P.S128()[pos * 64 + j] = s; } else { P.C64()[pos * 32 + j - 64] = c; P.S64()[pos * 32 + j - 64] = s; } }
    if (bx < NMP / 16) {
        LAS float* mx = (LAS float*)lds;
        for (int rr = 0; rr < 2; ++rr) { const int row = 2 * wave + rr; f32x4 v[8]; float ss = 0.f;
#pragma unroll
            for (int j = 0; j < 8; ++j) { v[j] = *(const f32x4*)(P.meta() + (size_t)row * D + 4 * lane + 256 * j); ss += (v[j][0] * v[j][0] + v[j][1] * v[j][1]) + (v[j][2] * v[j][2] + v[j][3] * v[j][3]); }
            const float rs = 1.0f / sqrtf(wave_sum(ss) * (1.f / D) + NORM_EPS);
#pragma unroll
            for (int j = 0; j < 8; ++j) { const f32x4 w = *(const f32x4*)(P.norm_w() + 4 * lane + 256 * j); *(LAS f32x4*)(mx + row * D + 4 * lane + 256 * j) = v[j] * rs * w; } }
        __syncthreads();
        const int c16 = lane & 15, ks = lane >> 4, q = 16 * bx + c16, orig = q < 320 ? 512 + q : 2880 + (q - 320);
        float acc[16];
#pragma unroll
        for (int i = 0; i < 16; ++i) acc[i] = 0.f;
        const float* wp = P.w_in() + (size_t)(256 * wave + ks) * NIN + orig;
#pragma unroll 8
        for (int j = 0; j < 64; ++j) { const float wv = wp[(size_t)(4 * j) * NIN]; const int k = 256 * wave + 4 * j + ks;
#pragma unroll
            for (int i = 0; i < 16; ++i) acc[i] += mx[i * D + k] * wv; }
#pragma unroll
        for (int i = 0; i < 16; ++i) { acc[i] += __shfl_xor(acc[i], 16); acc[i] += __shfl_xor(acc[i], 32); }
        __syncthreads();
        LAS float* red = (LAS float*)lds;
        if (ks == 0) {
#pragma unroll
            for (int i = 0; i < 16; ++i) red[(wave * 16 + i) * 16 + c16] = acc[i]; }
        __syncthreads();
        if (tid < 256) { float sum = 0.f;
#pragma unroll
            for (int w = 0; w < 8; ++w) sum += red[w * 256 + tid];
            P.MP()[(tid >> 4) * NMP + 16 * bx + (tid & 15)] = sum; }
        __syncthreads();
    }
    LAS float* scr = (LAS float*)(lds + wave * 16384);
    const int gw = bx * NWAVES + wave, NGW = G * NWAVES;
    constexpr int I_IN = 32 * 320, I_UQ = 8 * 48, I_UK = 4 * 32, I_B = 16 * 64, I_O = 32 * 64;
    constexpr int NITEMS = I_IN + I_UQ + 2 * I_UK + 2 * I_B + I_O;
    for (int it = gw; it < NITEMS; it += NGW) { int r = it;
        if (r < I_IN) { p0_item<1>(P.w_in(), NIN, D, P.WIN(), nullptr, r, 320, scr, lane); continue; } r -= I_IN;
        if (r < I_UQ) { p0_item<2>(P.w_uq(), 1536, 512, P.WUQ(), P.qnw(), r, 48, scr, lane); continue; } r -= I_UQ;
        if (r < I_UK) { p0_item<3>(P.w_ukv(), 2048, 256, P.WUK(), P.kvnw(), r, 32, scr, lane); continue; } r -= I_UK;
        if (r < I_UK) { p0_item<4>(P.w_ukv(), 2048, 256, P.WUV(), P.kvnw(), r, 32, scr, lane); continue; } r -= I_UK;
        if (r < I_B) { p0_item<0>(P.w_bm(), D, 1024, P.WBM(), nullptr, r, 64, scr, lane); continue; } r -= I_B;
        if (r < I_B) { p0_item<0>(P.w_br(), D, 1024, P.WBR(), nullptr, r, 64, scr, lane); continue; } r -= I_B;
        p0_item<0>(P.w_out(), D, D, P.WOUT(), nullptr, r, 64, scr, lane); }
    for (int m = gw; m < M; m += 2 * NGW) {
        const int m2 = m + NGW; const float* xr = P.x() + (size_t)m * D; const float* xr2 = P.x() + (size_t)m2 * D; f32x4 v[8], u[8]; float ss = 0.f, ss2 = 0.f;
#pragma unroll
        for (int j = 0; j < 8; ++j) { v[j] = *(const f32x4*)(xr + 4 * lane + 256 * j); u[j] = *(const f32x4*)(xr2 + 4 * lane + 256 * j); }
#pragma unroll
        for (int j = 0; j < 8; ++j) { ss += (v[j][0] * v[j][0] + v[j][1] * v[j][1]) + (v[j][2] * v[j][2] + v[j][3] * v[j][3]); ss2 += (u[j][0] * u[j][0] + u[j][1] * u[j][1]) + (u[j][2] * u[j][2] + u[j][3] * u[j][3]); }
        const float rs = 1.0f / sqrtf(wave_sum(ss) * (1.f / D) + NORM_EPS), rs2 = 1.0f / sqrtf(wave_sum(ss2) * (1.f / D) + NORM_EPS);
#pragma unroll
        for (int j = 0; j < 8; ++j) { const f32x4 w = *(const f32x4*)(P.norm_w() + 4 * lane + 256 * j); const f32x4 o = v[j] * rs * w, o2 = u[j] * rs2 * w;
            u32x2 pk; pk.x = pk2(o[0], o[1]); pk.y = pk2(o[2], o[3]); *(u32x2*)(P.XN() + (size_t)m * D + 4 * lane + 256 * j) = pk;
            pk.x = pk2(o2[0], o2[1]); pk.y = pk2(o2[2], o2[3]); *(u32x2*)(P.XN() + (size_t)m2 * D + 4 * lane + 256 * j) = pk; } }
}

__device__ __forceinline__ void meta_stage2(const Ptrs& P, int tid) {
    const int gtid = blockIdx.x * NTHR + tid, NT = gridDim.x * NTHR;
    for (int idx = gtid; idx < 8 * 128 * 128; idx += NT) { const int h = idx >> 14, d = (idx >> 7) & 127, e = idx & 127, j = d & 63; const float lg2 = head_lg2(h); float s = 0.f;
        for (int i = 0; i < 16; ++i) { const float k1 = P.MP()[i * NMP + 320 + h * 128 + j], k2 = P.MP()[i * NMP + 320 + h * 128 + j + 64], c = P.C128()[i * 64 + j], sn = P.S128()[i * 64 + j];
            const float kd = d < 64 ? k1 * c - k2 * sn : k1 * sn + k2 * c;
            s += kd * 0.08838834764831845f * exp2f(lg2 * (float)(15 - i)) * P.MP()[i * NMP + 1344 + h * 128 + e]; }
        P.R0()[idx] = s; }
    if (gtid < 2048) { const int n = gtid, head = n >> 8, wi = n & 255; float dot[16], ss[16];
#pragma unroll
        for (int i = 0; i < 16; ++i) { dot[i] = 0.f; ss[i] = 0.f; }
        for (int k = 0; k < 256; ++k) { const float wv = P.w_ukv()[(size_t)k * 2048 + n] * P.kvnw()[k];
#pragma unroll
            for (int i = 0; i < 16; ++i) { const float c = P.MP()[i * NMP + k]; dot[i] += c * wv; ss[i] += c * c; } }
#pragma unroll
        for (int i = 0; i < 16; ++i) { const float v = dot[i] / sqrtf(ss[i] * (1.f / 256.f) + NORM_EPS); const bf16 bv = (bf16)f2bf(v);
            for (int b = 0; b < NB; ++b) { if (wi < 128) P.KN()[(size_t)(b * KSEQ + 48 + i) * 1024 + head * 128 + wi] = bv; else P.VT()[(size_t)(head * 128 + wi - 128) * (NB * KSEQ) + b * KSEQ + 48 + ((i & 3) | ((i & 4) << 1) | ((i & 8) >> 1))] = bv; } }
    } else if (gtid < 2048 + 512) { const int idx = gtid - 2048, i = idx >> 5, j = idx & 31;
        const float t1 = P.MP()[i * NMP + 256 + j], t2 = P.MP()[i * NMP + 256 + 32 + j], c = P.C64()[i * 32 + j], s = P.S64()[i * 32 + j];
        const bf16 o1 = (bf16)f2bf(t1 * c - t2 * s), o2 = (bf16)f2bf(t1 * s + t2 * c);
        for (int b = 0; b < NB; ++b) { P.KR()[(size_t)(b * KSEQ + 48 + i) * 64 + j] = o1; P.KR()[(size_t)(b * KSEQ + 48 + i) * 64 + 32 + j] = o2; } }
}

constexpr int AT_KB = 64 * 24 * 16, AT_VB = 128 * 8 * 16, AT_BUF = AT_KB + AT_VB;
__device__ __forceinline__ void attn_unit(const Ptrs& P, LAS unsigned char* lds, int b, int h, int qb, int tid, int lane, int wave, bool do_store = true) {
    asm volatile("" : "+v"(tid), "+v"(lane));
    const int r = lane & 31, hh = lane >> 5;
    const int trow = 256 * qb + 32 * wave + r;
    const size_t row = (size_t)b * TOK + trow;
    bf16x8 qf[12];
#pragma unroll
    for (int s = 0; s < 8; ++s) qf[s] = *(const bf16x8*)(P.QN() + row * 1024 + h * 128 + 16 * s + 8 * hh);
#pragma unroll
    for (int s = 0; s < 4; ++s) qf[8 + s] = *(const bf16x8*)(P.QR() + row * 512 + h * 64 + 16 * s + 8 * hh);
    const int ntiles = 4 * qb + 5, kt_last = 4 * qb + 1 + (wave >> 1);
    f32x16 o[4];
#pragma unroll
    for (int e = 0; e < 4; ++e)
#pragma unroll
        for (int i = 0; i < 16; ++i) o[e][i] = 0.f;
    float mrun = -1e30f, lsum = 0.f;
    const char* kbase = (const char*)(P.KN() + (size_t)b * KSEQ * 1024 + h * 128); const char* rbase = (const char*)(P.KR() + (size_t)b * KSEQ * 64);
    const char* vbase = (const char*)(P.VT() + (size_t)(h * 128) * (NB * KSEQ) + (size_t)b * KSEQ);
    const char* ksrc[3]; unsigned kstr[3]; const char* vsrc[2];
#pragma unroll
    for (int i = 0; i < 3; ++i) { const int q = (3 * wave + i) * 64 + lane, key = q / 24, cc = (q % 24) ^ ((key >> 1) & 7);
        ksrc[i] = cc < 16 ? kbase + (size_t)key * 2048 + cc * 16 : rbase + (size_t)key * 128 + (cc - 16) * 16; kstr[i] = cc < 16 ? 64u * 2048u : 64u * 128u; }
#pragma unroll
    for (int i = 0; i < 2; ++i) { const int q = (2 * wave + i) * 64 + lane, e = q >> 3, cc = (q & 7) ^ ((e >> 1) & 7); vsrc[i] = vbase + (size_t)e * (NB * KSEQ * 2) + cc * 16; }
#define AT_ISSUE(kt, slot) do { LAS unsigned char* kb_ = lds + (slot) * AT_BUF; \
        _Pragma("unroll") for (int i = 0; i < 3; ++i) __builtin_amdgcn_global_load_lds((const unsigned*)(ksrc[i] + (size_t)(kt) * kstr[i]), (LAS unsigned*)(kb_ + (3 * wave + i) * 1024), 16, 0, 0); \
        _Pragma("unroll") for (int i = 0; i < 2; ++i) __builtin_amdgcn_global_load_lds((const unsigned*)(vsrc[i] + (size_t)(kt) * 128), (LAS unsigned*)(kb_ + AT_KB + (2 * wave + i) * 1024), 16, 0, 0); } while (0)
    const int swz = (r >> 1) & 7;
    asm volatile("s_waitcnt vmcnt(0)" ::: "memory");
    __builtin_amdgcn_s_barrier();
    AT_ISSUE(0, 0); AT_ISSUE(1, 1);
#define AT_TILE(kt, SLOT) do { \
        if (kt + 1 < ntiles) asm volatile("s_waitcnt vmcnt(5)" ::: "memory"); else asm volatile("s_waitcnt vmcnt(0)" ::: "memory"); \
        __builtin_amdgcn_s_barrier(); \
        asm volatile("" ::: "memory"); \
        if (kt + 2 < ntiles) AT_ISSUE(kt + 2, (SLOT + 2) % 3); \
        if (kt <= kt_last) { \
            const LAS unsigned char* kb = lds + SLOT * AT_BUF; const LAS unsigned char* vb = kb + AT_KB; \
            f32x16 p0, p1; \
            _Pragma("unroll") for (int i = 0; i < 16; ++i) { p0[i] = 0.f; p1[i] = 0.f; } \
            __builtin_amdgcn_s_setprio(1); \
            _Pragma("unroll") for (int s = 0; s < 12; ++s) { const LAS unsigned char* ka = kb + r * 384 + (((2 * s + hh) ^ swz) * 16); \
                const bf16x8 a0 = *(const LAS bf16x8*)ka, a1 = *(const LAS bf16x8*)(ka + 32 * 384); \
                p0 = __builtin_amdgcn_mfma_f32_32x32x16_bf16(a0, qf[s], p0, 0, 0, 0); p1 = __builtin_amdgcn_mfma_f32_32x32x16_bf16(a1, qf[s], p1, 0, 0, 0); } \
            __builtin_amdgcn_s_setprio(0); \
            if (kt == 0 || kt >= 4 * qb + 1) { \
                const int kmax = KOFF + trow, k0 = 64 * kt + 4 * hh; \
                _Pragma("unroll") for (int i = 0; i < 16; ++i) { const int kk = k0 + (i & 3) + 8 * (i >> 2); if (kk < 48 || kk > kmax) p0[i] = -1e30f; if (kk + 32 < 48 || kk + 32 > kmax) p1[i] = -1e30f; } \
            } \
            float mx = fmaxf(p0[0], p1[0]); \
            _Pragma("unroll") for (int i = 1; i < 16; ++i) mx = fmaxf(mx, fmaxf(p0[i], p1[i])); \
            mx = fmaxf(mx, __shfl_xor(mx, 32)); \
            if (__builtin_amdgcn_ballot_w64(mx > mrun) != 0ull) { \
                const float mnew = fmaxf(mrun, mx), alpha = __builtin_amdgcn_exp2f(mrun - mnew); mrun = mnew; lsum *= alpha; \
                _Pragma("unroll") for (int e = 0; e < 4; ++e) \
                    _Pragma("unroll") for (int i = 0; i < 16; ++i) o[e][i] *= alpha; \
            } \
            float ps = 0.f; \
            _Pragma("unroll") for (int i = 0; i < 16; ++i) { p0[i] = __builtin_amdgcn_exp2f(p0[i] - mrun); p1[i] = __builtin_amdgcn_exp2f(p1[i] - mrun); ps += p0[i] + p1[i]; } \
            lsum += ps; \
            _Pragma("unroll") for (int s2 = 0; s2 < 4; ++s2) { u32x4 pw; \
                if (s2 == 0) { pw.x = cvt_pk_bf16(p0[0], p0[1]); pw.y = cvt_pk_bf16(p0[2], p0[3]); pw.z = cvt_pk_bf16(p0[4], p0[5]); pw.w = cvt_pk_bf16(p0[6], p0[7]); } \
                else if (s2 == 1) { pw.x = cvt_pk_bf16(p0[8], p0[9]); pw.y = cvt_pk_bf16(p0[10], p0[11]); pw.z = cvt_pk_bf16(p0[12], p0[13]); pw.w = cvt_pk_bf16(p0[14], p0[15]); } \
                else if (s2 == 2) { pw.x = cvt_pk_bf16(p1[0], p1[1]); pw.y = cvt_pk_bf16(p1[2], p1[3]); pw.z = cvt_pk_bf16(p1[4], p1[5]); pw.w = cvt_pk_bf16(p1[6], p1[7]); } \
                else { pw.x = cvt_pk_bf16(p1[8], p1[9]); pw.y = cvt_pk_bf16(p1[10], p1[11]); pw.z = cvt_pk_bf16(p1[12], p1[13]); pw.w = cvt_pk_bf16(p1[14], p1[15]); } \
                const bf16x8 pb = __builtin_bit_cast(bf16x8, pw); \
                _Pragma("unroll") for (int e = 0; e < 4; ++e) { const bf16x8 va = *(const LAS bf16x8*)(vb + (32 * e + r) * 128 + (((2 * s2 + hh) ^ swz) * 16)); \
                    o[e] = __builtin_amdgcn_mfma_f32_32x32x16_bf16(va, pb, o[e], 0, 0, 0); } } \
        } \
    } while (0)
    for (int kt0 = 0; kt0 < ntiles; kt0 += 3) {
        { const int kt = kt0; AT_TILE(kt, 0); }
        if (kt0 + 1 < ntiles) { const int kt = kt0 + 1; AT_TILE(kt, 1); }
        if (kt0 + 2 < ntiles) { const int kt = kt0 + 2; AT_TILE(kt, 2); }
    }
#undef AT_TILE
#undef AT_ISSUE
    const float inv = 1.0f / (lsum + __shfl_xor(lsum, 32));
    bf16* yrow = P.ZMLA() + row * 1024 + h * 128;
#pragma unroll
    for (int e = 0; e < 4; ++e)
#pragma unroll
        for (int g = 0; g < 4; ++g) { bf16* p = yrow + 32 * e + 8 * g + 4 * hh; const u32x2 z = *(const u32x2*)p;
            const float z0 = __uint_as_float(z.x << 16), z1 = __uint_as_float(z.x & 0xffff0000u), z2 = __uint_as_float(z.y << 16), z3 = __uint_as_float(z.y & 0xffff0000u);
            u32x2 w; w.x = cvt_pk_bf16(o[e][4 * g] * inv * z0, o[e][4 * g + 1] * inv * z1); w.y = cvt_pk_bf16(o[e][4 * g + 2] * inv * z2, o[e][4 * g + 3] * inv * z3); if (do_store) *(u32x2*)p = w; }
}

constexpr int RT_S = 272, RT_T = 128 * RT_S;
typedef short v4i16_t __attribute__((ext_vector_type(4)));
__device__ __forceinline__ s16x4 tr_read(const LAS unsigned char* p) { return __builtin_bit_cast(s16x4, __builtin_amdgcn_ds_read_tr16_b64_v4i16((LAS v4i16_t*)p)); }
__device__ __forceinline__ void ret_unit(const Ptrs& P, LAS unsigned char* lds, int b, int h, int tid, int lane, int wave, bool do_store = true) {
    asm volatile("" : "+v"(tid), "+v"(lane));
    const int c16 = lane & 15, q4 = lane >> 4, tq = c16 >> 2, tp = c16 & 3;
    LAS unsigned char* Ks = lds; LAS unsigned char* Vs = lds + RT_T; LAS unsigned char* Ps = lds + 2 * RT_T; LAS unsigned char* RTs = lds + 3 * RT_T;
    const float lg2 = head_lg2(h), G = exp2f(lg2 * 128.f);
    f32x4 R[8];
#pragma unroll
    for (int eb = 0; eb < 8; ++eb)
#pragma unroll
        for (int i = 0; i < 4; ++i) R[eb][i] = P.R0()[(h * 128 + 16 * wave + 4 * q4 + i) * 128 + 16 * eb + c16];
    __syncthreads();
#pragma unroll
    for (int eb = 0; eb < 8; ++eb) { u32x2 w; w.x = cvt_pk_bf16(R[eb][0], R[eb][1]); w.y = cvt_pk_bf16(R[eb][2], R[eb][3]); *(LAS u32x2*)(RTs + (16 * eb + c16) * RT_S + (16 * wave + 4 * q4) * 2) = w; }
    float rowfac[4], xi[4];
#pragma unroll
    for (int i = 0; i < 4; ++i) { const int n = 16 * wave + 4 * q4 + i; rowfac[i] = exp2f(lg2 * (float)(n - 127)); xi[i] = exp2f(lg2 * (float)(n + 1)); }
    float gw[8], gb[8];
#pragma unroll
    for (int eb = 0; eb < 8; ++eb) { gw[eb] = P.gnw()[h * 128 + 16 * eb + c16]; gb[eb] = P.gnb()[h * 128 + 16 * eb + c16]; }
    for (int ch = 0; ch < 32; ++ch) {
        const size_t row0 = (size_t)b * TOK + 128 * ch;
#pragma unroll
        for (int i = 0; i < 4; ++i) { const int id = tid + 512 * i, m = id >> 4, cc = id & 15;
            *(LAS u32x4*)(Ks + m * RT_S + cc * 16) = *(const u32x4*)(P.RK() + (row0 + m) * 1024 + h * 128 + cc * 8);
            *(LAS u32x4*)(Vs + m * RT_S + cc * 16) = *(const u32x4*)(P.RV() + (row0 + m) * 1024 + h * 128 + cc * 8); }
        bf16x8 qf[4];
#pragma unroll
        for (int s = 0; s < 4; ++s) qf[s] = *(const bf16x8*)(P.RQ() + (row0 + 16 * wave + c16) * 1024 + h * 128 + 32 * s + 8 * q4);
        __syncthreads();
        f32x4 sacc[8], oacc[8];
#pragma unroll
        for (int mb = 0; mb < 8; ++mb) { f32x4 a = {0.f, 0.f, 0.f, 0.f}, c = {0.f, 0.f, 0.f, 0.f};
#pragma unroll
            for (int s = 0; s < 4; ++s) { const bf16x8 kf = *(const LAS bf16x8*)(Ks + (16 * mb + c16) * RT_S + (32 * s + 8 * q4) * 2), rf = *(const LAS bf16x8*)(RTs + (16 * mb + c16) * RT_S + (32 * s + 8 * q4) * 2);
                a = __builtin_amdgcn_mfma_f32_16x16x32_bf16(qf[s], kf, a, 0, 0, 0); c = __builtin_amdgcn_mfma_f32_16x16x32_bf16(qf[s], rf, c, 0, 0, 0); }
            sacc[mb] = a; oacc[mb] = c; }
#pragma unroll
        for (int mb = 0; mb < 8; ++mb)
#pragma unroll
            for (int i = 0; i < 4; ++i) { const int n = 16 * wave + 4 * q4 + i, m = 16 * mb + c16; const float pv = m <= n ? sacc[mb][i] * rowfac[i] : 0.f;
                *(LAS bf16*)(Ps + n * RT_S + m * 2) = (bf16)f2bf(pv); oacc[mb][i] *= xi[i]; }
        __syncthreads();
        bf16x8 pf[4], ktf[4];
#pragma unroll
        for (int s = 0; s < 4; ++s) { pf[s] = *(const LAS bf16x8*)(Ps + (16 * wave + c16) * RT_S + (32 * s + 8 * q4) * 2);
            const s16x4 lo = tr_read(Ks + (32 * s + 8 * q4 + tq) * RT_S + (16 * wave + 4 * tp) * 2), hi = tr_read(Ks + (32 * s + 8 * q4 + 4 + tq) * RT_S + (16 * wave + 4 * tp) * 2);
            ktf[s] = __builtin_shufflevector(lo, hi, 0, 1, 2, 3, 4, 5, 6, 7); }
#pragma unroll
        for (int eb = 0; eb < 8; ++eb) { f32x4 kv = {0.f, 0.f, 0.f, 0.f};
#pragma unroll
            for (int s = 0; s < 4; ++s) { const s16x4 lo = tr_read(Vs + (32 * s + 8 * q4 + tq) * RT_S + (16 * eb + 4 * tp) * 2), hi = tr_read(Vs + (32 * s + 8 * q4 + 4 + tq) * RT_S + (16 * eb + 4 * tp) * 2);
                const bf16x8 vf = __builtin_shufflevector(lo, hi, 0, 1, 2, 3, 4, 5, 6, 7);
                oacc[eb] = __builtin_amdgcn_mfma_f32_16x16x32_bf16(pf[s], vf, oacc[eb], 0, 0, 0); kv = __builtin_amdgcn_mfma_f32_16x16x32_bf16(ktf[s], vf, kv, 0, 0, 0); }
            R[eb] = R[eb] * G + kv;
            u32x2 w; w.x = cvt_pk_bf16(R[eb][0], R[eb][1]); w.y = cvt_pk_bf16(R[eb][2], R[eb][3]); *(LAS u32x2*)(RTs + (16 * eb + c16) * RT_S + (16 * wave + 4 * q4) * 2) = w; }
#pragma unroll
        for (int i = 0; i < 4; ++i) { float s = 0.f;
#pragma unroll
            for (int eb = 0; eb < 8; ++eb) s += oacc[eb][i];
            s += __shfl_xor(s, 1); s += __shfl_xor(s, 2); s += __shfl_xor(s, 4); s += __shfl_xor(s, 8);
            const float mu = s * (1.f / 128.f); float v = 0.f;
#pragma unroll
            for (int eb = 0; eb < 8; ++eb) { const float d = oacc[eb][i] - mu; v += d * d; }
            v += __shfl_xor(v, 1); v += __shfl_xor(v, 2); v += __shfl_xor(v, 4); v += __shfl_xor(v, 8);
            const float rstd = 1.0f / sqrtf(v * (1.f / 128.f) + GN_EPS);
            bf16* yr = P.ZRET() + (row0 + 16 * wave + 4 * q4 + i) * 1024 + h * 128 + c16;
#pragma unroll
            for (int eb = 0; eb < 8; ++eb) { const float z = bf2f(yr[16 * eb]); const bf16 yv = (bf16)f2bf(((oacc[eb][i] - mu) * rstd * gw[eb] + gb[eb]) * z); if (do_store) yr[16 * eb] = yv; } }
        __syncthreads();
    }
}

template <int PH> __device__ __forceinline__ void run_phase(const Ptrs& P, LAS unsigned char* lds, int tid, int lane, int wave);

template <int ph_lo, int ph_hi> __global__ void __launch_bounds__(NTHR, 2) hybrid_fwd(Args args) {
    extern __shared__ __attribute__((aligned(16))) unsigned char lds_raw[];
    LAS unsigned char* lds = (LAS unsigned char*)lds_raw;
    const int tid = threadIdx.x, lane = tid & 63, wave = __builtin_amdgcn_readfirstlane(tid >> 6);
    const int G = gridDim.x, bx = blockIdx.x;
    constexpr bool multi = (ph_hi - ph_lo) > 1;
#ifndef PHMASK
#define PHMASK 0x7f
#endif
#ifndef DUPMASK
#define DUPMASK 0
#endif
#define NREP(k) (((DUPMASK >> (k)) & 1) ? 2 : 1)
#define IN(k) (((PHMASK >> (k)) & 1) && ph_lo <= (k) && (k) < ph_hi)
#define PHASE_PTRS() Ptrs P; { unsigned char* ws_ = args.ws; asm volatile("" : "+s"(ws_)); P.a = &args; P.ws = ws_; } unsigned char* ws = P.ws; (void)ws
#define SEAM(k) do { if (multi && IN((k) + 1)) cg::this_grid().sync(); } while (0)

    if (IN(0)) { PHASE_PTRS(); for (int rep_ = 0; rep_ < NREP(0); ++rep_) { p0_prologue(P, lds, tid, lane, wave); __syncthreads(); } SEAM(0); }
    if (IN(1)) { PHASE_PTRS();
      for (int rep_ = 0; rep_ < NREP(1); ++rep_) {
        pg8::Gemm g{P.XN(), P.WIN(), M, NINP, D}; pg8::StaticOrder S; S.init(M, NINP, G, bx);
        pg8::EpiIn E{ws, P.SSQQ(), P.SSQKV(), P.C128(), P.S128(), P.C64(), P.S64()};
        pg8::gemm_phase<pg8::EpiIn, pg8::StaticOrder, true, true>(lds, g, S, E);
      }
        SEAM(1);
    }
    if (IN(2)) { PHASE_PTRS();
        meta_stage2(P, tid);
      for (int rep_ = 0; rep_ < NREP(2); ++rep_) {
        { pg8::Gemm g{P.CQ(), P.WUQ(), M, 1536, 512}; pg8::StaticOrder S; S.init(M, 1536, G, bx);
          pg8::EpiQ E{P.QN(), P.QR(), P.SSQQ(), P.C64(), P.S64(), 0.07216878364870322f * 1.4426950408889634f};
          pg8::gemm_phase<pg8::EpiQ, pg8::StaticOrder, true, true>(lds, g, S, E); }
        { pg8::Gemm g{P.CKV(), P.WUK(), M, 1024, 256}; pg8::StaticOrder S; S.init(M, 1024, G, bx);
          pg8::EpiK E{P.KN(), P.SSQKV()};
          pg8::gemm_phase<pg8::EpiK, pg8::StaticOrder, true, true>(lds, g, S, E); }
        { pg8::Gemm g{P.WUV(), P.CKV(), 1024, M, 256}; pg8::StaticOrder S; S.init(1024, M, G, bx);
          pg8::EpiVT E{P.VT(), P.SSQKV()};
          pg8::gemm_phase<pg8::EpiVT, pg8::StaticOrder, true, true>(lds, g, S, E); }
      }
        SEAM(2);
    }
    if (IN(3)) { PHASE_PTRS();
        volatile LAS unsigned* qw = (volatile LAS unsigned*)(lds + QWORD_OFF);
#if defined(PROBE_RET2)
        for (;;) { __syncthreads(); if (tid == 0) *qw = __hip_atomic_fetch_add(P.ctl() + 128, 1u, __ATOMIC_RELAXED, __HIP_MEMORY_SCOPE_AGENT); __syncthreads();
            const int idx = (int)__builtin_amdgcn_readfirstlane(*qw); if (idx >= 64) break; ret_unit(P, lds, idx >> 3, idx & 7, tid, lane, wave, P.ws == nullptr); }
#endif
#if defined(PROBE_ATT2)
        for (;;) { __syncthreads(); if (tid == 0) *qw = __hip_atomic_fetch_add(P.ctl() + 192, 1u, __ATOMIC_RELAXED, __HIP_MEMORY_SCOPE_AGENT); __syncthreads();
            const int a = (int)__builtin_amdgcn_readfirstlane(*qw); if (a >= 1024) break; attn_unit(P, lds, (a & 63) >> 3, a & 7, 15 - (a >> 6), tid, lane, wave, P.ws == nullptr); }
#endif
#ifndef NO_RET
        for (;;) {
            __syncthreads();
            if (tid == 0) *qw = __hip_atomic_fetch_add(P.ctl(), 1u, __ATOMIC_RELAXED, __HIP_MEMORY_SCOPE_AGENT);
            __syncthreads();
            const int idx = (int)__builtin_amdgcn_readfirstlane(*qw);
            if (idx >= 64) break;
            ret_unit(P, lds, idx >> 3, idx & 7, tid, lane, wave);
        }
#endif
#ifndef NO_ATT
        for (;;) {
            __syncthreads();
            if (tid == 0) *qw = __hip_atomic_fetch_add(P.ctl() + 64, 1u, __ATOMIC_RELAXED, __HIP_MEMORY_SCOPE_AGENT);
            __syncthreads();
            const int a = (int)__builtin_amdgcn_readfirstlane(*qw);
            if (a >= 1024) break;
            attn_unit(P, lds, (a & 63) >> 3, a & 7, 15 - (a >> 6), tid, lane, wave);
        }
#endif
        SEAM(3);
    }
    if (IN(4)) { PHASE_PTRS();
      for (int rep_ = 0; rep_ < NREP(4); ++rep_) {
        { pg8::Gemm g{P.ZMLA(), P.WBM(), M, D, 1024}; pg8::StaticOrder S; S.init(M, D, G, bx);
          pg8::EpiMerge<0> E{P.MG(), P.GATES()};
          pg8::gemm_phase<pg8::EpiMerge<0>, pg8::StaticOrder, true, true>(lds, g, S, E); }
        { pg8::Gemm g{P.ZRET(), P.WBR(), M, D, 1024}; pg8::StaticOrder S; S.init(M, D, G, bx);
          pg8::EpiMerge<1> E{P.MG(), P.GATES()};
          pg8::gemm_phase<pg8::EpiMerge<1>, pg8::StaticOrder, true, true>(lds, g, S, E); }
      }
        SEAM(4);
    }
    if (IN(5)) { PHASE_PTRS();
      for (int rep_ = 0; rep_ < NREP(5); ++rep_) {
        pg8::Gemm g{P.MG(), P.WOUT(), M, D, D}; pg8::StaticOrder S; S.init(M, D, G, bx);
        pg8::EpiOut E{P.XN()};
        pg8::gemm_phase<pg8::EpiOut, pg8::StaticOrder, true, true>(lds, g, S, E);
      }
        SEAM(5);
    }
    if (IN(6)) { PHASE_PTRS();
        const int gw = bx * NWAVES + wave, NGW = G * NWAVES;
        for (int m = gw; m < M; m += NGW) { float* orow = P.out() + (size_t)m * D; const bf16* prow = P.XN() + (size_t)m * D; const float* xrow = P.x() + (size_t)m * D;
            f32x4 hv[8]; float ss = 0.f;
#pragma unroll
            for (int j = 0; j < 4; ++j) { const int c0 = 8 * (lane + 64 * j); f32x4 d0, d1; pg8::unpack8(*(const u32x4*)(prow + c0), d0, d1);
                hv[2 * j] = d0 + *(const f32x4*)(xrow + c0); hv[2 * j + 1] = d1 + *(const f32x4*)(xrow + c0 + 4); }
#pragma unroll
            for (int j = 0; j < 8; ++j) ss += (hv[j][0] * hv[j][0] + hv[j][1] * hv[j][1]) + (hv[j][2] * hv[j][2] + hv[j][3] * hv[j][3]);
            const float rs = 1.0f / sqrtf(wave_sum(ss) * (1.f / D) + NORM_EPS);
#pragma unroll
            for (int j = 0; j < 4; ++j) { const int c0 = 8 * (lane + 64 * j);
                const f32x4 w0 = *(const f32x4*)(P.fnw() + c0), w1 = *(const f32x4*)(P.fnw() + c0 + 4);
                *(f32x4*)(orow + c0) = hv[2 * j] * rs * w0; *(f32x4*)(orow + c0 + 4) = hv[2 * j + 1] * rs * w1; } }
    }
#undef IN
#undef SEAM
}

#ifndef N_LAUNCHES
#define N_LAUNCHES 1
#endif
template <int LO, int HI> static bool setup_one(int& per_cu) {
    if (hipFuncSetAttribute((const void*)hybrid_fwd<LO, HI>, hipFuncAttributeMaxDynamicSharedMemorySize, LDS_BYTES) != hipSuccess) { fprintf(stderr, "kernel_launch: hipFuncSetAttribute failed\n"); return false; }
    if (hipOccupancyMaxActiveBlocksPerMultiprocessor(&per_cu, (const void*)hybrid_fwd<LO, HI>, NTHR, LDS_BYTES) != hipSuccess || per_cu < 1) { fprintf(stderr, "kernel_launch: occupancy query says %d blocks per CU\n", per_cu); per_cu = 1; }
    (void)hipGetLastError();
    return true;
}
extern "C" void kernel_launch(void* const* d_in, const int* in_sizes, int n_in, void* d_out, int out_size, void* d_ws, size_t ws_size, hipStream_t stream) {
    static int grid = 0;
    if (grid == 0) {
        if (n_in != 14 || out_size != M * D || ws_size < WS_END) { fprintf(stderr, "kernel_launch: unexpected shapes (n_in %d, out %d, ws %zu)\n", n_in, out_size, ws_size); grid = -1; return; }
        int dev = 0, cus = 0, per_cu = 1; bool ok = true;
        (void)hipGetDevice(&dev); (void)hipDeviceGetAttribute(&cus, hipDeviceAttributeMultiprocessorCount, dev);
#if N_LAUNCHES == 1
        ok = setup_one<0, 7>(per_cu);
#else
        ok = setup_one<0, 1>(per_cu) && setup_one<1, 2>(per_cu) && setup_one<2, 3>(per_cu) && setup_one<3, 4>(per_cu) && setup_one<4, 5>(per_cu) && setup_one<5, 6>(per_cu) && setup_one<6, 7>(per_cu);
#endif
        if (!ok) { grid = -1; return; }
        grid = cus * per_cu;
        if (grid != 256) fprintf(stderr, "kernel_launch: note: grid = %d workgroups\n", grid);
    }
    if (grid < 0) return;
    Args a{};
    for (int i = 0; i < 14; ++i) a.in[i] = (const float*)d_in[i];
    a.out = (float*)d_out; a.ws = (unsigned char*)d_ws;
#if N_LAUNCHES == 1
    void* kargs[] = {&a};
    hipError_t e = hipLaunchCooperativeKernel((const void*)hybrid_fwd<0, 7>, dim3(grid), dim3(NTHR), kargs, LDS_BYTES, stream);
    if (e != hipSuccess) fprintf(stderr, "kernel_launch: cooperative launch failed: %s (grid %d)\n", hipGetErrorString(e), grid);
#else
    hipLaunchKernelGGL((hybrid_fwd<0, 1>), dim3(grid), dim3(NTHR), LDS_BYTES, stream, a);
    hipLaunchKernelGGL((hybrid_fwd<1, 2>), dim3(grid), dim3(NTHR), LDS_BYTES, stream, a);
    hipLaunchKernelGGL((hybrid_fwd<2, 3>), dim3(grid), dim3(NTHR), LDS_BYTES, stream, a);
    hipLaunchKernelGGL((hybrid_fwd<3, 4>), dim3(grid), dim3(NTHR), LDS_BYTES, stream, a);
    hipLaunchKernelGGL((hybrid_fwd<4, 5>), dim3(grid), dim3(NTHR), LDS_BYTES, stream, a);
    hipLaunchKernelGGL((hybrid_fwd<5, 6>), dim3(grid), dim3(NTHR), LDS_BYTES, stream, a);
    hipLaunchKernelGGL((hybrid_fwd<6, 7>), dim3(grid), dim3(NTHR), LDS_BYTES, stream, a);
#endif
}
```

```cpp
#include <hip/hip_runtime.h>
#include <hip/hip_cooperative_groups.h>
#include <cstdio>
#include <cstdint>
constexpr size_t MiB = 1u << 20;
constexpr size_t WS_CTL = 0, WS_WIN = 1 * MiB, WS_WUQ = 41 * MiB, WS_WUK = 43 * MiB, WS_WUV = 43 * MiB + 512 * 1024, WS_WB2 = 44 * MiB, WS_WOUT = 52 * MiB;
constexpr size_t WS_C128 = 60 * MiB, WS_S128 = 61 * MiB + 256 * 1024, WS_C64 = 62 * MiB + 512 * 1024, WS_S64 = 63 * MiB + 256 * 1024;
constexpr size_t WS_MP = 64 * MiB, WS_R0 = 64 * MiB + 256 * 1024, WS_SSQQ = 65 * MiB, WS_SSQKV = 66 * MiB, WS_SSQO = 67 * MiB, WS_KR = 71 * MiB;
constexpr size_t WS_XN = 76 * MiB, WS_QN = 76 * MiB, WS_QR = 140 * MiB, WS_CQ = 204 * MiB, WS_CKV = 236 * MiB, WS_ZMLA = 252 * MiB  , WS_ZRET = 252 * MiB + 2048, WS_RQ = 380 * MiB, WS_RK = 444 * MiB, WS_MG = 380 * MiB;
constexpr size_t WS_RV = 508 * MiB, WS_GATES = 572 * MiB, WS_KN = 828 * MiB, WS_VT = 894 * MiB, WS_END = 960 * MiB;
namespace pg8 {
#define PG8_LAS __attribute__((address_space(3)))
typedef unsigned short bf16_t;
typedef short bf16x8 __attribute__((ext_vector_type(8)));
typedef float f32x4 __attribute__((ext_vector_type(4)));
typedef unsigned u32x4 __attribute__((ext_vector_type(4)));
constexpr int BM = 256, BK = 64, HALF = 128, HTB = HALF * BK * 2  , STAGE_BYTES = 8 * HTB, NXCD = 8, WGM = 4;

__host__ __device__ __forceinline__ int lds_byte(int r, int c) { const int st = (r >> 4) * 2 + (c >> 5), rr = r & 15, cc = c & 31, ob = rr * 64 + cc * 2; return st * 1024 + (ob ^ (((ob >> 9) & 1) << 5)); }
__host__ __device__ __forceinline__ void stage_rc(int b, int& R, int& C) { const int st = b / 1024, sb = b % 1024, swz = sb ^ (((sb >> 9) & 1) << 5); R = (st >> 1) * 16 + swz / 64; C = (st & 1) * 32 + (swz % 64) / 2; }
__host__ __device__ __forceinline__ int perm32(int rho) { const int n = rho >> 4, i = rho & 15; return 8 * (i >> 2) + 4 * n + (i & 3); }

struct Unit { int pm, pn; };
struct Gemm { const bf16_t* A; const bf16_t* Bt; int M, N, K; };

struct StaticOrder {
    int nM, nN, nwg, G, c;
    __host__ __device__ void init(int M, int N, int G_, int c_) { nM = M / BM; nN = N / BM; nwg = nM * nN; G = G_; c = c_; }
    __host__ __device__ bool next(int i, Unit& u) const {
        const long L = (long)i * G + c; if (L >= nwg) return false;
        int wgid = (int)L; { const int q = nwg / NXCD, r = nwg % NXCD, xcd = wgid % NXCD, off = wgid / NXCD; wgid = (xcd < r ? xcd * (q + 1) : r * (q + 1) + (xcd - r) * q) + off; }
        const int nig = WGM * nN, gid = wgid / nig, fm = gid * WGM, gsz = (nM - fm) < WGM ? (nM - fm) : WGM;
        u.pm = fm + ((wgid % nig) % gsz); u.pn = (wgid % nig) / gsz; return true;
    }
    __device__ __forceinline__ void a_ready(const Unit&) const {}
    __device__ __forceinline__ void done(const Unit&) const {}
};

__device__ __forceinline__ unsigned cvt_pk_bf16(float lo, float hi) { unsigned r; asm volatile("v_cvt_pk_bf16_f32 %0, %1, %2" : "=v"(r) : "v"(lo), "v"(hi)); return r; }
typedef float f32x2 __attribute__((ext_vector_type(2)));
typedef unsigned u32x2 __attribute__((ext_vector_type(2)));
constexpr int TOK = 4096, KSEQ = 4160, KOFF = 64;
__device__ __forceinline__ float head_lg2(int h) { const float x = __uint_as_float((unsigned)(127 - 5 - h) << 23); const float p = x * (1.f + x * (0.5f + x * (0.33333333f + x * (0.25f + x * (0.2f + x * (0.16666667f + x * 0.14285714f)))))); return -p * 1.4426950408889634f; }
__device__ __forceinline__ void rope_cs4(int pos, int j0, float inv_half  , f32x4& c, f32x4& s) {
#pragma unroll
    for (int i = 0; i < 4; ++i) { const float rev = (float)pos * __builtin_amdgcn_exp2f(-(float)(j0 + i) * inv_half * 13.287712379549449f - 2.651496129472319f);
        const float f = __builtin_amdgcn_fractf(rev); c[i] = __builtin_amdgcn_cosf(f); s[i] = __builtin_amdgcn_sinf(f); }
}
__device__ __forceinline__ float sigmoid_f(float x) { return __builtin_amdgcn_rcpf(1.f + __expf(-x)); }
__device__ __forceinline__ float bf2f(unsigned short b) { return __uint_as_float((unsigned)b << 16); }
__device__ __forceinline__ u32x4 pack8(f32x4 v0, f32x4 v1) { u32x4 w; w.x = cvt_pk_bf16(v0[0], v0[1]); w.y = cvt_pk_bf16(v0[2], v0[3]); w.z = cvt_pk_bf16(v1[0], v1[1]); w.w = cvt_pk_bf16(v1[2], v1[3]); return w; }
__device__ __forceinline__ u32x2 pack4(f32x4 v) { u32x2 w; w.x = cvt_pk_bf16(v[0], v[1]); w.y = cvt_pk_bf16(v[2], v[3]); return w; }
__device__ __forceinline__ void unpack8(u32x4 w, f32x4& a, f32x4& b) {
    a[0] = __uint_as_float(w.x << 16); a[1] = __uint_as_float(w.x & 0xffff0000u); a[2] = __uint_as_float(w.y << 16); a[3] = __uint_as_float(w.y & 0xffff0000u);
    b[0] = __uint_as_float(w.z << 16); b[1] = __uint_as_float(w.z & 0xffff0000u); b[2] = __uint_as_float(w.w << 16); b[3] = __uint_as_float(w.w & 0xffff0000u); }

struct EpiIn {
    static constexpr bool PERM = true, AFTER_DRAIN = false, HAS_MID = false;
    unsigned char* ws; float *ssq_q, *ssq_kv; const float *C128, *S128, *C64, *S64;
    __device__ __forceinline__ void operator()(const f32x4 (&acc)[2][2][4][2], const Unit& u, int wr, int wc, int fr, int fq) const {
        const int pn = u.pn, row0 = u.pm * BM + wr * 64 + fr;
        if (pn < 3) {
            bf16_t* base = (bf16_t*)(ws + (pn < 2 ? WS_CQ : WS_CKV)); const int ldc = pn < 2 ? 512 : 256, colt = pn < 2 ? pn * 256 : 0;
            float* sq = pn < 2 ? ssq_q : ssq_kv; const int sld = pn < 2 ? 8 : 4, soff = (pn < 2 ? pn * 4 : 0) + wc;
#pragma unroll
            for (int ai = 0; ai < 2; ++ai)
#pragma unroll
                for (int m = 0; m < 4; ++m) { const int row = row0 + ai * HALF + m * 16; float s = 0.f;
#pragma unroll
                    for (int bj = 0; bj < 2; ++bj) { const f32x4 v0 = acc[ai][bj][m][0], v1 = acc[ai][bj][m][1];
                        s += (v0[0] * v0[0] + v0[1] * v0[1]) + (v0[2] * v0[2] + v0[3] * v0[3]) + (v1[0] * v1[0] + v1[1] * v1[1]) + (v1[2] * v1[2] + v1[3] * v1[3]);
                        *(u32x4*)(base + (size_t)row * ldc + colt + bj * HALF + wc * 32 + 8 * fq) = pack8(v0, v1); }
                    s += __shfl_xor(s, 16); s += __shfl_xor(s, 32);
                    if (fq == 0) sq[(size_t)row * sld + soff] = s; }
        } else if (pn == 3) {
            if (wc < 2) {
                const int j0 = 16 * wc + 4 * fq;
#pragma unroll
                for (int ai = 0; ai < 2; ++ai)
#pragma unroll
                    for (int m = 0; m < 4; ++m) { const int row = row0 + ai * HALF + m * 16, b = row >> 12, t = row & (TOK - 1);
                        f32x4 c, s; rope_cs4(16 + t, j0, 1.f / 32.f, c, s);
                        const f32x4 t1 = acc[ai][0][m][0], t2 = acc[ai][0][m][1];
                        bf16_t* o = (bf16_t*)(ws + WS_KR) + (size_t)(b * KSEQ + KOFF + t) * 64 + j0;
                        *(u32x2*)o = pack4(t1 * c - t2 * s); *(u32x2*)(o + 32) = pack4(t1 * s + t2 * c); }
            }
        } else if ((pn >= 8) && (pn < 16)) {
            const bool isk = pn >= 12; bf16_t* base = (bf16_t*)(ws + (isk ? WS_RK : WS_RQ)); const int colt = (pn - (isk ? 12 : 8)) * 256; const int j0 = 16 * wc + 4 * fq;
#pragma unroll
            for (int ai = 0; ai < 2; ++ai) {
#pragma unroll
                for (int m = 0; m < 4; ++m) { const int row = row0 + ai * HALF + m * 16, t = row & (TOK - 1);
                    f32x4 c, s; rope_cs4(16 + t, j0, 1.f / 64.f, c, s);
#pragma unroll
                    for (int bj = 0; bj < 2; ++bj) { float f = 1.f;
                        if (isk) { const int h = (colt >> 7) + bj; f = 0.08838834764831845f * __builtin_amdgcn_exp2f(head_lg2(h) * (float)(127 - (t & 127))); }
                        const f32x4 t1 = acc[ai][bj][m][0] * f, t2 = acc[ai][bj][m][1] * f;
                        bf16_t* o = base + (size_t)row * 1024 + colt + bj * HALF + j0;
                        *(u32x2*)o = pack4(t1 * c - t2 * s); *(u32x2*)(o + 64) = pack4(t1 * s + t2 * c); } }
                asm volatile("" ::: "memory");
            }
        } else {
            size_t boff; int ldc, colt, act;
            if (pn < 8) { boff = WS_ZMLA; ldc = 2048; colt = (pn - 4) * 256; act = 1; }
            else if (pn < 20) { boff = WS_RV; ldc = 1024; colt = (pn - 16) * 256; act = 0; }
            else if (pn < 24) { boff = WS_ZRET; ldc = 2048; colt = (pn - 20) * 256; act = 1; }
            else { boff = WS_GATES; ldc = 4096; colt = (pn - 24) * 256; act = 2; }
            bf16_t* base = (bf16_t*)(ws + boff);
#pragma unroll
            for (int ai = 0; ai < 2; ++ai)
#pragma unroll
                for (int m = 0; m < 4; ++m) { const int row = row0 + ai * HALF + m * 16;
#pragma unroll
                    for (int bj = 0; bj < 2; ++bj) { f32x4 v0 = acc[ai][bj][m][0], v1 = acc[ai][bj][m][1];
                        if (act != 0) {
#pragma unroll
                            for (int i = 0; i < 4; ++i) { const float s0 = sigmoid_f(v0[i]), s1 = sigmoid_f(v1[i]); v0[i] = act == 1 ? v0[i] * s0 : s0; v1[i] = act == 1 ? v1[i] * s1 : s1; } }
                        *(u32x4*)(base + (size_t)row * ldc + colt + bj * HALF + wc * 32 + 8 * fq) = pack8(v0, v1); } }
        }
    }
};

__device__ __forceinline__ float rs_from(const float* p, int n, float inv_d, float eps) { float s = 0.f; for (int i = 0; i < n; ++i) s += p[i]; return 1.0f / sqrtf(s * inv_d + eps); }

struct EpiQ {
    static constexpr bool PERM = true, AFTER_DRAIN = false, HAS_MID = false;
    bf16_t *QN, *QR; const float *ssq_q, *C64, *S64; float qscale;
    __device__ __forceinline__ void operator()(const f32x4 (&acc)[2][2][4][2], const Unit& u, int wr, int wc, int fr, int fq) const {
        const int pn = u.pn, row0 = u.pm * BM + wr * 64 + fr;
        if (pn < 4) {
            asm volatile("" ::: "memory");
#pragma unroll
            for (int ai = 0; ai < 2; ++ai)
#pragma unroll
                for (int m = 0; m < 4; ++m) { const int row = row0 + ai * HALF + m * 16; const float f = qscale;
#pragma unroll
                    for (int bj = 0; bj < 2; ++bj) *(u32x4*)(QN + (size_t)row * 1024 + pn * 256 + bj * HALF + wc * 32 + 8 * fq) = pack8(acc[ai][bj][m][0] * f, acc[ai][bj][m][1] * f); }
        } else {
            const int j0 = 16 * (wc & 1) + 4 * fq;
#pragma unroll
            for (int ai = 0; ai < 2; ++ai) {
#pragma unroll
                for (int m = 0; m < 4; ++m) { const int row = row0 + ai * HALF + m * 16; const float f = qscale; f32x4 c, s; rope_cs4(16 + (row & (TOK - 1)), j0, 1.f / 32.f, c, s);
#pragma unroll
                    for (int bj = 0; bj < 2; ++bj) { const int head = (pn - 4) * 4 + bj * 2 + (wc >> 1);
                        const f32x4 t1 = acc[ai][bj][m][0] * f, t2 = acc[ai][bj][m][1] * f;
                        bf16_t* o = QR + (size_t)row * 512 + head * 64 + j0;
                        *(u32x2*)o = pack4(t1 * c - t2 * s); *(u32x2*)(o + 32) = pack4(t1 * s + t2 * c); } }
                asm volatile("" ::: "memory");
            }
        }
    }
};
struct EpiK {
    static constexpr bool PERM = true, AFTER_DRAIN = false, HAS_MID = false;
    bf16_t* KN; const float* ssq_kv;
    __device__ __forceinline__ void operator()(const f32x4 (&acc)[2][2][4][2], const Unit& u, int wr, int wc, int fr, int fq) const {
        const int pn = u.pn, row0 = u.pm * BM + wr * 64 + fr;
        float fs[2][4];
#pragma unroll
        for (int ai = 0; ai < 2; ++ai)
#pragma unroll
            for (int m = 0; m < 4; ++m) { const int row = row0 + ai * HALF + m * 16; const f32x4 q0 = *(const f32x4*)(ssq_kv + (size_t)row * 4);
                fs[ai][m] = 1.0f / sqrtf(((q0[0] + q0[1]) + (q0[2] + q0[3])) * (1.f / 256.f) + 1e-6f); }
        asm volatile("" ::: "memory");
#pragma unroll
        for (int ai = 0; ai < 2; ++ai)
#pragma unroll
            for (int m = 0; m < 4; ++m) { const int row = row0 + ai * HALF + m * 16, b = row >> 12, t = row & (TOK - 1); const float f = fs[ai][m];
#pragma unroll
                for (int bj = 0; bj < 2; ++bj) *(u32x4*)(KN + (size_t)(b * KSEQ + KOFF + t) * 1024 + pn * 256 + bj * HALF + wc * 32 + 8 * fq) = pack8(acc[ai][bj][m][0] * f, acc[ai][bj][m][1] * f); }
    }
};
struct EpiVT {
    static constexpr bool PERM = true, AFTER_DRAIN = false, HAS_MID = false;
    bf16_t* VT; const float* ssq_kv;
    __device__ __forceinline__ void operator()(const f32x4 (&acc)[2][2][4][2], const Unit& u, int wr, int wc, int fr, int fq) const {
        const int pn = u.pn, row0 = u.pm * BM + wr * 64 + fr;
#pragma unroll
        for (int bj = 0; bj < 2; ++bj) { const int col = pn * 256 + bj * HALF + wc * 32 + 8 * fq, b = col >> 12, t = col & (TOK - 1);
            f32x4 f0, f1;
#pragma unroll
            for (int i = 0; i < 4; ++i) { const f32x4 a = *(const f32x4*)(ssq_kv + (size_t)(col + i) * 4);
                f0[i] = 1.0f / sqrtf(((a[0] + a[1]) + (a[2] + a[3])) * (1.f / 256.f) + 1e-6f); }
#pragma unroll
            for (int i = 0; i < 4; ++i) { const f32x4 c = *(const f32x4*)(ssq_kv + (size_t)(col + 4 + i) * 4);
                f1[i] = 1.0f / sqrtf(((c[0] + c[1]) + (c[2] + c[3])) * (1.f / 256.f) + 1e-6f); }
#pragma unroll
            for (int ai = 0; ai < 2; ++ai)
#pragma unroll
                for (int m = 0; m < 4; ++m) { const int row = row0 + ai * HALF + m * 16;
                    bf16_t* o = VT + (size_t)row * (8 * KSEQ) + b * KSEQ + KOFF + (t & ~15) + ((t & 8) ? 4 : 0);
                    *(u32x2*)o = pack4(acc[ai][bj][m][0] * f0); *(u32x2*)(o + 8) = pack4(acc[ai][bj][m][1] * f1); } }
    }
};
struct EpiMerge2 {
    static constexpr bool PERM = true, AFTER_DRAIN = false, HAS_MID = true;
    bf16_t* MG; const bf16_t* GATES;
    __device__ __forceinline__ void mid(f32x4 (&acc)[2][2][4][2], const Unit& u, int wr, int wc, int fr, int fq) const {
        asm volatile("" : "+v"(fr), "+v"(fq));
        const int row0 = u.pm * BM + wr * 64 + fr, col0 = u.pn * 256 + wc * 32 + 8 * fq;
#pragma unroll
        for (int ai = 0; ai < 2; ++ai)
#pragma unroll
            for (int mh = 0; mh < 2; ++mh) {
                u32x4 ga[2][2], gb[2][2];
#pragma unroll
                for (int mm = 0; mm < 2; ++mm)
#pragma unroll
                    for (int bj = 0; bj < 2; ++bj) { const size_t row = (size_t)(row0 + ai * HALF + (2 * mh + mm) * 16);
                        ga[mm][bj] = *(const u32x4*)(GATES + row * 4096 + col0 + bj * HALF); gb[mm][bj] = *(const u32x4*)(GATES + row * 4096 + 2048 + col0 + bj * HALF); }
                asm volatile("" ::: "memory");
#pragma unroll
                for (int mm = 0; mm < 2; ++mm)
#pragma unroll
                    for (int bj = 0; bj < 2; ++bj) { const int m = 2 * mh + mm; f32x4 a0, a1, b0, b1; unpack8(ga[mm][bj], a0, a1); unpack8(gb[mm][bj], b0, b1);
#pragma unroll
                        for (int i = 0; i < 4; ++i) { acc[ai][bj][m][0][i] *= a0[i] * __builtin_amdgcn_rcpf(fmaxf(b0[i], 1e-30f)); acc[ai][bj][m][1][i] *= a1[i] * __builtin_amdgcn_rcpf(fmaxf(b1[i], 1e-30f)); } }
                asm volatile("" ::: "memory");
            }
    }
    __device__ __forceinline__ void operator()(const f32x4 (&acc)[2][2][4][2], const Unit& u, int wr, int wc, int fr, int fq) const {
        asm volatile("" : "+v"(fr), "+v"(fq));
        const int row0 = u.pm * BM + wr * 64 + fr, col0 = u.pn * 256 + wc * 32 + 8 * fq;
#pragma unroll
        for (int ai = 0; ai < 2; ++ai) {
            u32x4 gb[4][2];
#pragma unroll
            for (int m = 0; m < 4; ++m)
#pragma unroll
                for (int bj = 0; bj < 2; ++bj) gb[m][bj] = *(const u32x4*)(GATES + (size_t)(row0 + ai * HALF + m * 16) * 4096 + 2048 + col0 + bj * HALF);
            asm volatile("" ::: "memory");
#pragma unroll
            for (int m = 0; m < 4; ++m)
#pragma unroll
                for (int bj = 0; bj < 2; ++bj) { f32x4 b0, b1; unpack8(gb[m][bj], b0, b1);
                    *(u32x4*)(MG + (size_t)(row0 + ai * HALF + m * 16) * 2048 + col0 + bj * HALF) = pack8(acc[ai][bj][m][0] * b0, acc[ai][bj][m][1] * b1); }
            asm volatile("" ::: "memory");
        }
    }
};
struct EpiOut {
    static constexpr bool PERM = true, AFTER_DRAIN = false, HAS_MID = false;
    bf16_t* PRE;
    __device__ __forceinline__ void operator()(const f32x4 (&acc)[2][2][4][2], const Unit& u, int wr, int wc, int fr, int fq) const {
        const int pn = u.pn, row0 = u.pm * BM + wr * 64 + fr;
#pragma unroll
        for (int ai = 0; ai < 2; ++ai)
#pragma unroll
            for (int m = 0; m < 4; ++m) { const int row = row0 + ai * HALF + m * 16;
#pragma unroll
                for (int bj = 0; bj < 2; ++bj) *(u32x4*)(PRE + (size_t)row * 2048 + pn * 256 + bj * HALF + wc * 32 + 8 * fq) = pack8(acc[ai][bj][m][0], acc[ai][bj][m][1]); }
    }
};

struct EpiNull {
    static constexpr bool PERM = true, AFTER_DRAIN = false, HAS_MID = false;
    float* sink;
    __device__ __forceinline__ void operator()(const f32x4 (&acc)[2][2][4][2], const Unit& u, int wr, int wc, int fr, int fq) const {
        float s = 0.f;
#pragma unroll
        for (int ai = 0; ai < 2; ++ai)
#pragma unroll
            for (int bj = 0; bj < 2; ++bj)
#pragma unroll
                for (int m = 0; m < 4; ++m)
#pragma unroll
                    for (int n = 0; n < 2; ++n) s += acc[ai][bj][m][n][0] + acc[ai][bj][m][n][3];
        if (s == 1.2345e-30f) sink[0] = s;
    }
};
template <class Epi, class Sched, bool ALIGN_EPI = false, bool SP2 = false>
__device__ __forceinline__ void gemm_phase(PG8_LAS unsigned char* lds, const Gemm g, const Sched& S, const Epi& E) {
    int tid = threadIdx.x; asm volatile("" : "+v"(tid));
    const int wid = __builtin_amdgcn_readfirstlane(tid >> 6), lane = tid & 63, wr = wid >> 2, wc = wid & 3, fr = lane & 15, fq = lane >> 4;
    const int K = g.K, nt = K / BK;
    unsigned voffA[2], voffB[2];
#pragma unroll
    for (int i = 0; i < 2; ++i) { int R, C; stage_rc(tid * 16 + i * 8192, R, C); const int Rb = Epi::PERM ? ((R & ~31) + perm32(R & 31)) : R;
        voffA[i] = (unsigned)(R * K + C) * 2u; voffB[i] = (unsigned)(Rb * K + C) * 2u; }
    const size_t kstep = (size_t)(BK * 2);
    const size_t hstep = (size_t)HALF * K * 2;
    const size_t tstep = 2 * hstep;
    const unsigned ldsw = (unsigned)wid * 1024u;
    const int aoff = lds_byte(wr * 64 + fr, fq * 8), boff = lds_byte(wc * 32 + fr, fq * 8);
#define PG8_SA(b, h) (((b) * 2 + (h)) * HTB)
#define PG8_SB(b, h) ((4 + (b) * 2 + (h)) * HTB)
#define PG8_STAGE(bufoff, gbase, voff) do { _Pragma("unroll") for (int _i = 0; _i < 2; ++_i) \
        __builtin_amdgcn_global_load_lds((const unsigned*)((const char*)(gbase) + (voff)[_i]), (PG8_LAS unsigned*)(lds + (bufoff) + ldsw + _i * 8192), 16, 0, 0); } while (0)
#define PG8_LDA(dst, b, h) do { _Pragma("unroll") for (int m = 0; m < 4; ++m) _Pragma("unroll") for (int k = 0; k < 2; ++k) dst[m][k] = *(const PG8_LAS bf16x8*)(lds + PG8_SA(b, h) + aoff + m * 2048 + k * 1024); } while (0)
#define PG8_LDB(dst, b, h) do { _Pragma("unroll") for (int n = 0; n < 2; ++n) _Pragma("unroll") for (int k = 0; k < 2; ++k) dst[n][k] = *(const PG8_LAS bf16x8*)(lds + PG8_SB(b, h) + boff + n * 2048 + k * 1024); } while (0)
#define PG8_MMA(ai, bj, At, Bt) do { __builtin_amdgcn_s_setprio(1); _Pragma("unroll") for (int m = 0; m < 4; ++m) _Pragma("unroll") for (int n = 0; n < 2; ++n) _Pragma("unroll") for (int k = 0; k < 2; ++k) \
        acc[ai][bj][m][n] = __builtin_amdgcn_mfma_f32_16x16x32_bf16(Bt[n][k], At[m][k], acc[ai][bj][m][n], 0, 0, 0); __builtin_amdgcn_s_setprio(0); } while (0)
#define PG8_WAIT_V(n) asm volatile("s_waitcnt vmcnt(" #n ")" ::: "memory")
#define PG8_WAIT_L(n) asm volatile("s_waitcnt lgkmcnt(" #n ")" ::: "memory")
#define PG8_BAR __builtin_amdgcn_s_barrier()
#define PG8_SCHED __builtin_amdgcn_sched_barrier(0)
    Unit cur, nxt; int ui = 0;
    if (!S.next(0, cur)) return;
    f32x4 acc[2][2][4][2];
#pragma unroll
    for (int a = 0; a < 2; ++a)
#pragma unroll
        for (int b = 0; b < 2; ++b)
#pragma unroll
            for (int m = 0; m < 4; ++m)
#pragma unroll
                for (int n = 0; n < 2; ++n) acc[a][b][m][n] = (f32x4){0.f, 0.f, 0.f, 0.f};
    bf16x8 At[4][2], B0[2][2], B1[2][2];
    const char* cA = (const char*)g.A + (size_t)cur.pm * tstep; const char* cB = (const char*)g.Bt + (size_t)cur.pn * tstep;
    S.a_ready(cur);
    if constexpr (SP2) {
        PG8_STAGE(PG8_SB(0, 0), cB, voffB); PG8_STAGE(PG8_SB(0, 1), cB + hstep, voffB); PG8_STAGE(PG8_SA(0, 0), cA, voffA); PG8_STAGE(PG8_SA(0, 1), cA + hstep, voffA);
        if (wr == 1) PG8_BAR;
        PG8_WAIT_V(2); PG8_BAR;
        PG8_STAGE(PG8_SB(1, 0), cB + kstep, voffB); PG8_STAGE(PG8_SA(1, 0), cA + kstep, voffA); PG8_STAGE(PG8_SB(1, 1), cB + hstep + kstep, voffB);
        PG8_WAIT_V(6); PG8_BAR;
    } else {
        PG8_STAGE(PG8_SB(0, 0), cB, voffB); PG8_STAGE(PG8_SA(0, 0), cA, voffA); PG8_STAGE(PG8_SB(0, 1), cB + hstep, voffB); PG8_STAGE(PG8_SA(0, 1), cA + hstep, voffA);
        if (wr == 1) PG8_BAR;
        PG8_WAIT_V(4); PG8_BAR;
        PG8_STAGE(PG8_SB(1, 0), cB + kstep, voffB); PG8_STAGE(PG8_SA(1, 0), cA + kstep, voffA); PG8_STAGE(PG8_SB(1, 1), cB + hstep + kstep, voffB);
        PG8_WAIT_V(6); PG8_BAR;
    }
    for (;;) {
        const bool has_next = S.next(ui + 1, nxt);
        const char* nA = has_next ? (const char*)g.A + (size_t)nxt.pm * tstep : cA; const char* nB = has_next ? (const char*)g.Bt + (size_t)nxt.pn * tstep : cB;
#pragma nounroll
        for (int t = 0; t < nt; t += 2) {
            if constexpr (Epi::HAS_MID) { if (t == nt / 2) { PG8_SCHED; E.mid(acc, cur, wr, wc, fr, fq); PG8_SCHED; } }
            const bool last = (t == nt - 2);
            const char* a1 = cA + (size_t)(t + 1) * kstep;
            const char* a2 = last ? nA : cA + (size_t)(t + 2) * kstep; const char* b2 = last ? nB : cB + (size_t)(t + 2) * kstep;
            const char* a3 = a2 + kstep; const char* b3 = b2 + kstep;
            if (last && has_next) S.a_ready(nxt);
            if constexpr (SP2) {
            PG8_LDB(B0, 0, 0); PG8_LDB(B1, 0, 1); PG8_SCHED; PG8_LDA(At, 0, 0); PG8_STAGE(PG8_SA(1, 1), a1 + hstep, voffA);
            PG8_WAIT_V(8); PG8_WAIT_L(0); PG8_BAR; PG8_MMA(0, 0, At, B0); PG8_MMA(0, 1, At, B1); PG8_BAR; PG8_SCHED;
            PG8_LDA(At, 0, 1); PG8_STAGE(PG8_SB(0, 0), b2, voffB); PG8_STAGE(PG8_SB(0, 1), b2 + hstep, voffB); PG8_STAGE(PG8_SA(0, 0), a2, voffA);
            PG8_WAIT_V(8); PG8_WAIT_L(0); PG8_BAR; PG8_MMA(1, 0, At, B0); PG8_MMA(1, 1, At, B1); PG8_BAR; PG8_SCHED;
            PG8_LDB(B0, 1, 0); PG8_LDB(B1, 1, 1); PG8_SCHED; PG8_LDA(At, 1, 0); PG8_STAGE(PG8_SA(0, 1), a2 + hstep, voffA);
            PG8_WAIT_V(8); PG8_WAIT_L(0); PG8_BAR; PG8_MMA(0, 0, At, B0); PG8_MMA(0, 1, At, B1); PG8_BAR; PG8_SCHED;
            PG8_LDA(At, 1, 1); PG8_STAGE(PG8_SB(1, 0), b3, voffB); PG8_STAGE(PG8_SB(1, 1), b3 + hstep, voffB); PG8_STAGE(PG8_SA(1, 0), a3, voffA);
            PG8_WAIT_V(8); PG8_WAIT_L(0); PG8_BAR; PG8_MMA(1, 0, At, B0); PG8_MMA(1, 1, At, B1); PG8_BAR; PG8_SCHED;
            } else {
            PG8_LDB(B0, 0, 0); PG8_SCHED; PG8_LDA(At, 0, 0); PG8_STAGE(PG8_SA(1, 1), a1 + hstep, voffA);
            PG8_WAIT_L(8); PG8_BAR; PG8_WAIT_L(0); PG8_MMA(0, 0, At, B0); PG8_BAR; PG8_SCHED;
            PG8_LDB(B1, 0, 1); PG8_STAGE(PG8_SB(0, 0), b2, voffB);
            PG8_BAR; PG8_WAIT_L(0); PG8_MMA(0, 1, At, B1); PG8_BAR;
            PG8_LDA(At, 0, 1); PG8_STAGE(PG8_SA(0, 0), a2, voffA);
            PG8_BAR; PG8_WAIT_L(0); PG8_MMA(1, 0, At, B0); PG8_BAR; PG8_SCHED;
            PG8_STAGE(PG8_SB(0, 1), b2 + hstep, voffB);
            PG8_WAIT_V(6); PG8_BAR; PG8_MMA(1, 1, At, B1); PG8_BAR;
            PG8_LDB(B0, 1, 0); PG8_SCHED; PG8_LDA(At, 1, 0); PG8_STAGE(PG8_SA(0, 1), a2 + hstep, voffA);
            PG8_WAIT_L(8); PG8_BAR; PG8_WAIT_L(0); PG8_MMA(0, 0, At, B0); PG8_BAR; PG8_SCHED;
            PG8_LDB(B1, 1, 1); PG8_STAGE(PG8_SB(1, 0), b3, voffB);
            PG8_BAR; PG8_WAIT_L(0); PG8_MMA(0, 1, At, B1); PG8_BAR;
            PG8_LDA(At, 1, 1); PG8_STAGE(PG8_SA(1, 0), a3, voffA);
            PG8_BAR; PG8_WAIT_L(0); PG8_MMA(1, 0, At, B0); PG8_BAR; PG8_SCHED;
            PG8_STAGE(PG8_SB(1, 1), b3 + hstep, voffB);
            PG8_WAIT_V(6); PG8_BAR; PG8_MMA(1, 1, At, B1); PG8_BAR;
            }
        }
        if constexpr (ALIGN_EPI) { if (wr == 0) PG8_BAR; }
        if constexpr (!Epi::AFTER_DRAIN) { E(acc, cur, wr, wc, fr, fq); S.done(cur); }
        if (!has_next) break;
#pragma unroll
        for (int a = 0; a < 2; ++a)
#pragma unroll
            for (int b = 0; b < 2; ++b)
#pragma unroll
                for (int m = 0; m < 4; ++m)
#pragma unroll
                    for (int n = 0; n < 2; ++n) acc[a][b][m][n] = (f32x4){0.f, 0.f, 0.f, 0.f};
        cur = nxt; cA = nA; cB = nB; ++ui;
        if constexpr (ALIGN_EPI) { if (wr == 1) PG8_BAR; }
    }
    PG8_WAIT_V(0);
    if constexpr (!ALIGN_EPI) { if (wr == 0) PG8_BAR; }
    PG8_BAR;
    if constexpr (Epi::AFTER_DRAIN) { E.fused(acc, cur, wr, wc, fr, fq, lds, wid, lane); S.done(cur); }
#undef PG8_SA
#undef PG8_SB
#undef PG8_STAGE
#undef PG8_LDA
#undef PG8_LDB
#undef PG8_MMA
#undef PG8_WAIT_V
#undef PG8_WAIT_L
#undef PG8_BAR
#undef PG8_SCHED
}
}
namespace cg = cooperative_groups;
#define LAS __attribute__((address_space(3)))
typedef unsigned short bf16;
using pg8::f32x4; using pg8::bf16x8; using pg8::u32x4; using pg8::u32x2; using pg8::cvt_pk_bf16; using pg8::bf2f;
typedef float f32x16 __attribute__((ext_vector_type(16)));
typedef short s16x4 __attribute__((ext_vector_type(4)));
using pg8::TOK; using pg8::KSEQ; using pg8::KOFF;
constexpr int NB = 8, M = NB * TOK, D = 2048, NIN = 10048, NINP = 10240, NPOS = 4112;
constexpr int NWAVES = 8, NTHR = 512, LDS_BYTES = 147456, QWORD_OFF = 147200;
constexpr int NMP = 2368;
constexpr float NORM_EPS = 1e-6f, GN_EPS = 1e-5f;

struct Args { const float* in[14]; float* out; unsigned char* ws; };

__device__ __forceinline__ unsigned f2bf(float f) { unsigned u = __float_as_uint(f); return (u + 0x7fffu + ((u >> 16) & 1u)) >> 16; }
__device__ __forceinline__ unsigned pk2(float lo, float hi) { return f2bf(lo) | (f2bf(hi) << 16); }
__device__ __forceinline__ float wave_sum(float v) {
#pragma unroll
    for (int o = 1; o < 64; o <<= 1) v += __shfl_xor(v, o);
    return v;
}
__device__ __forceinline__ float head_lg2(int h) { return pg8::head_lg2(h); }

__device__ __forceinline__ int src_in(int n) {
    if (n < 768) return n;
    if (n < 1024) { const int p = n - 768; if (p >= 64) return -1; const int wc = p >> 5, fq = (p >> 3) & 3, nn = (p >> 2) & 1, i = p & 3; return 768 + 32 * nn + 16 * wc + 4 * fq + i; }
    if (n < 2048) return 832 + (n - 1024);
    if (n < 4096) { const int q = n - 2048, hb = q >> 7, p = q & 127, wc = p >> 5, fq = (p >> 3) & 3, nn = (p >> 2) & 1, i = p & 3; return 1856 + hb * 128 + 64 * nn + 16 * wc + 4 * fq + i; }
    if (n < 6144) return 3904 + (n - 4096);
    return 5952 + (n - 6144);
}
__device__ __forceinline__ int src_uq(int n) {
    if (n < 1024) return (n >> 7) * 192 + (n & 127);
    const int q = n - 1024, blk = q >> 7, p = q & 127, wc = p >> 5, fq = (p >> 3) & 3, nn = (p >> 2) & 1, i = p & 3;
    return (2 * blk + (wc >> 1)) * 192 + 128 + 32 * nn + 16 * (wc & 1) + 4 * fq + i;
}
template <int KIND> __device__ __forceinline__ void p0_item(const float* W, int ldw, int K, bf16* WT, const float* ksc, int item, int nblk, LAS float* scr, int lane) {
    const int kb = item / nblk, nb = item % nblk, k0 = 64 * kb, n0 = 32 * nb, nl = lane & 31;
    int sc;
    if (KIND == 0) sc = n0 + nl; else if (KIND == 1) sc = src_in(n0 + nl); else if (KIND == 2) sc = src_uq(n0 + nl);
    else if (KIND == 3) sc = ((n0 + nl) >> 7) * 256 + ((n0 + nl) & 127); else sc = ((n0 + nl) >> 7) * 256 + 128 + ((n0 + nl) & 127);
#pragma unroll 16
    for (int i = 0; i < 32; ++i) { const int kk = 2 * i + (lane >> 5); float v = sc >= 0 ? W[(size_t)(k0 + kk) * ldw + sc] : 0.f; if (ksc) v *= ksc[k0 + kk]; scr[kk * 33 + nl] = v; }
    asm volatile("s_waitcnt lgkmcnt(0)" ::: "memory");
    const int c = lane & 7;
#pragma unroll
    for (int j = 0; j < 4; ++j) { const int n = (lane >> 3) + 8 * j; const LAS float* s = scr + (8 * c) * 33 + n;
        u32x4 o; o.x = pk2(s[0 * 33], s[1 * 33]); o.y = pk2(s[2 * 33], s[3 * 33]); o.z = pk2(s[4 * 33], s[5 * 33]); o.w = pk2(s[6 * 33], s[7 * 33]);
        *(u32x4*)(WT + (size_t)(n0 + n) * K + k0 + 8 * c) = o; }
    asm volatile("s_waitcnt lgkmcnt(0)" ::: "memory");
}

struct Ptrs {
    const Args* a; unsigned char* ws;
    __device__ __forceinline__ const float* x() const { return a->in[0]; }
    __device__ __forceinline__ const float* meta() const { return a->in[1]; }
    __device__ __forceinline__ const float* norm_w() const { return a->in[2]; }
    __device__ __forceinline__ const float* w_in() const { return a->in[3]; }
    __device__ __forceinline__ const float* qnw() const { return a->in[4]; }
    __device__ __forceinline__ const float* w_uq() const { return a->in[5]; }
    __device__ __forceinline__ const float* kvnw() const { return a->in[6]; }
    __device__ __forceinline__ const float* w_ukv() const { return a->in[7]; }
    __device__ __forceinline__ const float* gnw() const { return a->in[8]; }
    __device__ __forceinline__ const float* gnb() const { return a->in[9]; }
    __device__ __forceinline__ const float* w_bm() const { return a->in[10]; }
    __device__ __forceinline__ const float* w_br() const { return a->in[11]; }
    __device__ __forceinline__ const float* w_out() const { return a->in[12]; }
    __device__ __forceinline__ const float* fnw() const { return a->in[13]; }
    __device__ __forceinline__ float* out() const { return a->out; }
    __device__ __forceinline__ bf16* WIN() const { return (bf16*)(ws + WS_WIN); }
    __device__ __forceinline__ bf16* WUQ() const { return (bf16*)(ws + WS_WUQ); }
    __device__ __forceinline__ bf16* WUK() const { return (bf16*)(ws + WS_WUK); }
    __device__ __forceinline__ bf16* WUV() const { return (bf16*)(ws + WS_WUV); }
    __device__ __forceinline__ bf16* WB2() const { return (bf16*)(ws + WS_WB2); }
    __device__ __forceinline__ bf16* WOUT() const { return (bf16*)(ws + WS_WOUT); }
    __device__ __forceinline__ bf16* KR() const { return (bf16*)(ws + WS_KR); }
    __device__ __forceinline__ bf16* XN() const { return (bf16*)(ws + WS_XN); }
    __device__ __forceinline__ bf16* QN() const { return (bf16*)(ws + WS_QN); }
    __device__ __forceinline__ bf16* QR() const { return (bf16*)(ws + WS_QR); }
    __device__ __forceinline__ bf16* CQ() const { return (bf16*)(ws + WS_CQ); }
    __device__ __forceinline__ bf16* CKV() const { return (bf16*)(ws + WS_CKV); }
    __device__ __forceinline__ bf16* ZMLA() const { return (bf16*)(ws + WS_ZMLA); }
    __device__ __forceinline__ bf16* RQ() const { return (bf16*)(ws + WS_RQ); }
    __device__ __forceinline__ bf16* RK() const { return (bf16*)(ws + WS_RK); }
    __device__ __forceinline__ bf16* MG() const { return (bf16*)(ws + WS_MG); }
    __device__ __forceinline__ bf16* RV() const { return (bf16*)(ws + WS_RV); }
    __device__ __forceinline__ bf16* ZRET() const { return (bf16*)(ws + WS_ZRET); }
    __device__ __forceinline__ bf16* GATES() const { return (bf16*)(ws + WS_GATES); }
    __device__ __forceinline__ bf16* KN() const { return (bf16*)(ws + WS_KN); }
    __device__ __forceinline__ bf16* VT() const { return (bf16*)(ws + WS_VT); }
    __device__ __forceinline__ float* C128() const { return (float*)(ws + WS_C128); }
    __device__ __forceinline__ float* S128() const { return (float*)(ws + WS_S128); }
    __device__ __forceinline__ float* C64() const { return (float*)(ws + WS_C64); }
    __device__ __forceinline__ float* S64() const { return (float*)(ws + WS_S64); }
    __device__ __forceinline__ float* MP() const { return (float*)(ws + WS_MP); }
    __device__ __forceinline__ float* R0() const { return (float*)(ws + WS_R0); }
    __device__ __forceinline__ float* SSQQ() const { return (float*)(ws + WS_SSQQ); }
    __device__ __forceinline__ float* SSQKV() const { return (float*)(ws + WS_SSQKV); }
    __device__ __forceinline__ float* SSQO() const { return (float*)(ws + WS_SSQO); }
    __device__ __forceinline__ unsigned* ctl() const { return (unsigned*)(ws + WS_CTL); }
};

__device__ __forceinline__ void p0_prologue(const Ptrs& P, LAS unsigned char* lds, int tid, int lane, int wave) {
    const int G = gridDim.x, bx = blockIdx.x;
    const int gtid = bx * NTHR + tid, NT = G * NTHR;
    for (int i = gtid; i < 3456  ; i += NT) P.ctl()[4096 + i] = 0u;
    if (gtid < 32) P.ctl()[64 * gtid] = 0u;
    for (int i = gtid; i < NB * 48 * 512; i += NT) { const int b = i / (48 * 512), r = i % (48 * 512); ((unsigned*)(P.KN() + (size_t)b * KSEQ * 1024))[r] = 0u; }
    for (int i = gtid; i < NB * 48 * 32; i += NT) { const int b = i / (48 * 32), r = i % (48 * 32); ((unsigned*)(P.KR() + (size_t)b * KSEQ * 64))[r] = 0u; }
    for (int i = gtid; i < 1024 * NB * 24; i += NT) { const int row = i / (NB * 24), r = i % (NB * 24), b = r / 24, c = r % 24; ((unsigned*)(P.VT() + (size_t)row * (NB * KSEQ) + b * KSEQ))[c] = 0u; }
    for (int i = gtid; i < NPOS * 96; i += NT) { const int pos = i / 96, j = i % 96;
        const double e = j < 64 ? (double)j / 64.0 : (double)(j - 64) / 32.0;
        const float inv = (float)exp2(-e * 13.287712379549449); const float ang = (float)pos * inv;
        const double rev = (double)ang * 0.15915494309189535; const float a = (float)((rev - rint(rev)) * 6.283185307179586);
        const float c = cosf(a), s = sinf(a);
        if (j < 64) { P.C128()[pos * 64 + j] = c; P.S128()[pos * 64 + j] = s; } else { P.C64()[pos * 32 + j - 64] = c; P.S64()[pos * 32 + j - 64] = s; } }
    if (bx < NMP / 16) {
        LAS float* mx = (LAS float*)lds;
        for (int rr = 0; rr < 2; ++rr) { const int row = 2 * wave + rr; f32x4 v[8]; float ss = 0.f;
#pragma unroll
            for (int j = 0; j < 8; ++j) { v[j] = *(const f32x4*)(P.meta() + (size_t)row * D + 4 * lane + 256 * j); ss += (v[j][0] * v[j][0] + v[j][1] * v[j][1]) + (v[j][2] * v[j][2] + v[j][3] * v[j][3]); }
            const float rs = 1.0f / sqrtf(wave_sum(ss) * (1.f / D) + NORM_EPS);
#pragma unroll
            for (int j = 0; j < 8; ++j) { const f32x4 w = *(const f32x4*)(P.norm_w() + 4 * lane + 256 * j); *(LAS f32x4*)(mx + row * D + 4 * lane + 256 * j) = v[j] * rs * w; } }
        __syncthreads();
        const int c16 = lane & 15, ks = lane >> 4, q = 16 * bx + c16, orig = q < 320 ? 512 + q : 2880 + (q - 320);
        float acc[16];
#pragma unroll
        for (int i = 0; i < 16; ++i) acc[i] = 0.f;
        const float* wp = P.w_in() + (size_t)(256 * wave + ks) * NIN + orig;
#pragma unroll 8
        for (int j = 0; j < 64; ++j) { const float wv = wp[(size_t)(4 * j) * NIN]; const int k = 256 * wave + 4 * j + ks;
#pragma unroll
            for (int i = 0; i < 16; ++i) acc[i] += mx[i * D + k] * wv; }
#pragma unroll
        for (int i = 0; i < 16; ++i) { acc[i] += __shfl_xor(acc[i], 16); acc[i] += __shfl_xor(acc[i], 32); }
        __syncthreads();
        LAS float* red = (LAS float*)lds;
        if (ks == 0) {
#pragma unroll
            for (int i = 0; i < 16; ++i) red[(wave * 16 + i) * 16 + c16] = acc[i]; }
        __syncthreads();
        if (tid < 256) { float sum = 0.f;
#pragma unroll
            for (int w = 0; w < 8; ++w) sum += red[w * 256 + tid];
            P.MP()[(tid >> 4) * NMP + 16 * bx + (tid & 15)] = sum; }
        __syncthreads();
    }
    LAS float* scr = (LAS float*)(lds + wave * 16384);
    const int gw = bx * NWAVES + wave, NGW = G * NWAVES;
    constexpr int I_IN = 32 * 320, I_UQ = 8 * 48, I_UK = 4 * 32, I_B = 16 * 64, I_O = 32 * 64;
    constexpr int NITEMS = I_IN + I_UQ + 2 * I_UK + 2 * I_B + I_O;
    for (int it = gw; it < NITEMS; it += NGW) { int r = it;
        if (r < I_IN) { p0_item<1>(P.w_in(), NIN, D, P.WIN(), nullptr, r, 320, scr, lane); continue; } r -= I_IN;
        if (r < I_UQ) { p0_item<2>(P.w_uq(), 1536, 512, P.WUQ(), P.qnw(), r, 48, scr, lane); continue; } r -= I_UQ;
        if (r < I_UK) { p0_item<3>(P.w_ukv(), 2048, 256, P.WUK(), P.kvnw(), r, 32, scr, lane); continue; } r -= I_UK;
        if (r < I_UK) { p0_item<4>(P.w_ukv(), 2048, 256, P.WUV(), P.kvnw(), r, 32, scr, lane); continue; } r -= I_UK;
        if (r < I_B) { p0_item<0>(P.w_bm(), D, 2048, P.WB2(), nullptr, r, 64, scr, lane); continue; } r -= I_B;
        if (r < I_B) { p0_item<0>(P.w_br(), D, 2048, P.WB2() + 1024, nullptr, r, 64, scr, lane); continue; } r -= I_B;
        p0_item<0>(P.w_out(), D, D, P.WOUT(), nullptr, r, 64, scr, lane); }
    {
        f32x4 nw[8];
#pragma unroll
        for (int j = 0; j < 8; ++j) nw[j] = *(const f32x4*)(P.norm_w() + 4 * lane + 256 * j);
        f32x4 v[8], u[8];
#pragma unroll
        for (int j = 0; j < 8; ++j) { v[j] = *(const f32x4*)(P.x() + (size_t)gw * D + 4 * lane + 256 * j); u[j] = *(const f32x4*)(P.x() + (size_t)(gw + NGW) * D + 4 * lane + 256 * j); }
        for (int m = gw; m < M; m += 2 * NGW) { const int m2 = m + NGW, mn = m + 2 * NGW;
            f32x4 vn[8], un[8];
            if (mn < M) {
#pragma unroll
                for (int j = 0; j < 8; ++j) { vn[j] = *(const f32x4*)(P.x() + (size_t)mn * D + 4 * lane + 256 * j); un[j] = *(const f32x4*)(P.x() + (size_t)(mn + NGW) * D + 4 * lane + 256 * j); } }
            float ss = 0.f, ss2 = 0.f;
#pragma unroll
            for (int j = 0; j < 8; ++j) { ss += (v[j][0] * v[j][0] + v[j][1] * v[j][1]) + (v[j][2] * v[j][2] + v[j][3] * v[j][3]); ss2 += (u[j][0] * u[j][0] + u[j][1] * u[j][1]) + (u[j][2] * u[j][2] + u[j][3] * u[j][3]); }
            const float rs = 1.0f / sqrtf(wave_sum(ss) * (1.f / D) + NORM_EPS), rs2 = 1.0f / sqrtf(wave_sum(ss2) * (1.f / D) + NORM_EPS);
#pragma unroll
            for (int j = 0; j < 8; ++j) { const f32x4 o = v[j] * rs * nw[j], o2 = u[j] * rs2 * nw[j];
                u32x2 pk; pk.x = pk2(o[0], o[1]); pk.y = pk2(o[2], o[3]); *(u32x2*)(P.XN() + (size_t)m * D + 4 * lane + 256 * j) = pk;
                pk.x = pk2(o2[0], o2[1]); pk.y = pk2(o2[2], o2[3]); *(u32x2*)(P.XN() + (size_t)m2 * D + 4 * lane + 256 * j) = pk; }
            if (mn < M) {
#pragma unroll
                for (int j = 0; j < 8; ++j) { v[j] = vn[j]; u[j] = un[j]; } }
        }
    }
}

__device__ __forceinline__ void meta_stage2(const Ptrs& P, int tid) {
    const int gtid = blockIdx.x * NTHR + tid, NT = gridDim.x * NTHR;
    for (int idx = gtid; idx < 8 * 128 * 128; idx += NT) { const int h = idx >> 14, d = (idx >> 7) & 127, e = idx & 127, j = d & 63; const float lg2 = head_lg2(h); float s = 0.f;
        for (int i = 0; i < 16; ++i) { const float k1 = P.MP()[i * NMP + 320 + h * 128 + j], k2 = P.MP()[i * NMP + 320 + h * 128 + j + 64], c = P.C128()[i * 64 + j], sn = P.S128()[i * 64 + j];
            const float kd = d < 64 ? k1 * c - k2 * sn : k1 * sn + k2 * c;
            s += kd * 0.08838834764831845f * exp2f(lg2 * (float)(15 - i)) * P.MP()[i * NMP + 1344 + h * 128 + e]; }
        P.R0()[idx] = s; }
    if (gtid < 32768) { const int n = gtid >> 4, ks = gtid & 15, head = n >> 8, wi = n & 255; float dot[16], ss[16];
#pragma unroll
        for (int i = 0; i < 16; ++i) { dot[i] = 0.f; ss[i] = 0.f; }
#pragma unroll 4
        for (int kk = 0; kk < 16; ++kk) { const int k = 16 * ks + kk; const float wv = P.w_ukv()[(size_t)k * 2048 + n] * P.kvnw()[k];
#pragma unroll
            for (int i = 0; i < 16; ++i) { const float c = P.MP()[i * NMP + k]; dot[i] += c * wv; ss[i] += c * c; } }
#pragma unroll
        for (int i = 0; i < 16; ++i) {
#pragma unroll
            for (int o = 1; o < 16; o <<= 1) { dot[i] += __shfl_xor(dot[i], o); ss[i] += __shfl_xor(ss[i], o); } }
        if (ks == 0) {
#pragma unroll
            for (int i = 0; i < 16; ++i) { const float v = dot[i] / sqrtf(ss[i] * (1.f / 256.f) + NORM_EPS); const bf16 bv = (bf16)f2bf(v);
                for (int b = 0; b < NB; ++b) { if (wi < 128) P.KN()[(size_t)(b * KSEQ + 48 + i) * 1024 + head * 128 + wi] = bv; else P.VT()[(size_t)(head * 128 + wi - 128) * (NB * KSEQ) + b * KSEQ + 48 + ((i & 3) | ((i & 4) << 1) | ((i & 8) >> 1))] = bv; } } }
    } else if (gtid < 32768 + 512) { const int idx = gtid - 32768, i = idx >> 5, j = idx & 31;
        const float t1 = P.MP()[i * NMP + 256 + j], t2 = P.MP()[i * NMP + 256 + 32 + j], c = P.C64()[i * 32 + j], s = P.S64()[i * 32 + j];
        const bf16 o1 = (bf16)f2bf(t1 * c - t2 * s), o2 = (bf16)f2bf(t1 * s + t2 * c);
        for (int b = 0; b < NB; ++b) { P.KR()[(size_t)(b * KSEQ + 48 + i) * 64 + j] = o1; P.KR()[(size_t)(b * KSEQ + 48 + i) * 64 + 32 + j] = o2; } }
}

constexpr int AT_KB = 64 * 24 * 16, AT_VB = 128 * 8 * 16, AT_BUF = AT_KB + AT_VB;
template <int VAR> __device__ __forceinline__ void attn_unit(const Ptrs& P, LAS unsigned char* lds, int b, int h, int qb, int tid, int lane, int wave, bool do_store = true) {
    asm volatile("" : "+v"(tid), "+v"(lane));
    const int r = lane & 31, hh = lane >> 5;
    const int trow = 256 * qb + 32 * wave + r;
    const size_t row = (size_t)b * TOK + trow;
    bf16x8 qf[12];
#pragma unroll
    for (int s = 0; s < 8; ++s) qf[s] = *(const bf16x8*)(P.QN() + row * 1024 + h * 128 + 16 * s + 8 * hh);
#pragma unroll
    for (int s = 0; s < 4; ++s) qf[8 + s] = *(const bf16x8*)(P.QR() + row * 512 + h * 64 + 16 * s + 8 * hh);
    const f32x4 sq0 = *(const f32x4*)(P.SSQQ() + row * 8), sq1 = *(const f32x4*)(P.SSQQ() + row * 8 + 4);
    const int ntiles = 4 * qb + 5, kt_last = 4 * qb + 1 + (wave >> 1);
    f32x16 o[4];
#pragma unroll
    for (int e = 0; e < 4; ++e)
#pragma unroll
        for (int i = 0; i < 16; ++i) o[e][i] = 0.f;
    float mrun = -1e30f, lsum = 0.f;
    const char* kbase = (const char*)(P.KN() + (size_t)b * KSEQ * 1024 + h * 128); const char* rbase = (const char*)(P.KR() + (size_t)b * KSEQ * 64);
    const char* vbase = (const char*)(P.VT() + (size_t)(h * 128) * (NB * KSEQ) + (size_t)b * KSEQ);
    const char* ksrc[3]; unsigned kstr[3]; const char* vsrc[2];
#pragma unroll
    for (int i = 0; i < 3; ++i) { const int q = (3 * wave + i) * 64 + lane, key = q / 24, cc = (q % 24) ^ ((key >> 1) & 7);
        ksrc[i] = cc < 16 ? kbase + (size_t)key * 2048 + cc * 16 : rbase + (size_t)key * 128 + (cc - 16) * 16; kstr[i] = cc < 16 ? 64u * 2048u : 64u * 128u; }
#pragma unroll
    for (int i = 0; i < 2; ++i) { const int q = (2 * wave + i) * 64 + lane, e = q >> 3, cc = (q & 7) ^ ((e >> 1) & 7); vsrc[i] = vbase + (size_t)e * (NB * KSEQ * 2) + cc * 16; }
#define AT_ISSUE(kt, slot) do { LAS unsigned char* kb_ = lds + (slot) * AT_BUF; \
        _Pragma("unroll") for (int i = 0; i < 3; ++i) __builtin_amdgcn_global_load_lds((const unsigned*)(ksrc[i] + (size_t)(kt) * kstr[i]), (LAS unsigned*)(kb_ + (3 * wave + i) * 1024), 16, 0, 0); \
        _Pragma("unroll") for (int i = 0; i < 2; ++i) __builtin_amdgcn_global_load_lds((const unsigned*)(vsrc[i] + (size_t)(kt) * 128), (LAS unsigned*)(kb_ + AT_KB + (2 * wave + i) * 1024), 16, 0, 0); } while (0)
    const int swz = (r >> 1) & 7;
    const unsigned lbase = (unsigned)(unsigned long long)lds;
    asm volatile("s_waitcnt vmcnt(0)" ::: "memory");
    {
        const float ssq = ((sq0[0] + sq0[1]) + (sq0[2] + sq0[3])) + ((sq1[0] + sq1[1]) + (sq1[2] + sq1[3])), fsc = 1.0f / sqrtf(ssq * (1.f / 512.f) + 1e-6f);
#pragma unroll
        for (int s = 0; s < 12; ++s) { u32x4 w = __builtin_bit_cast(u32x4, qf[s]);
            w.x = cvt_pk_bf16(__uint_as_float(w.x << 16) * fsc, __uint_as_float(w.x & 0xffff0000u) * fsc); w.y = cvt_pk_bf16(__uint_as_float(w.y << 16) * fsc, __uint_as_float(w.y & 0xffff0000u) * fsc);
            w.z = cvt_pk_bf16(__uint_as_float(w.z << 16) * fsc, __uint_as_float(w.z & 0xffff0000u) * fsc); w.w = cvt_pk_bf16(__uint_as_float(w.w << 16) * fsc, __uint_as_float(w.w & 0xffff0000u) * fsc);
            qf[s] = __builtin_bit_cast(bf16x8, w); } }
    __builtin_amdgcn_s_barrier();
    if (!(VAR & 16)) { AT_ISSUE(0, 0); AT_ISSUE(1, 1); }
#define DSR128(dst, addr, off) asm volatile("ds_read_b128 %0, %1 offset:%2" : "=v"(dst) : "v"(addr), "n"(off))
#define LGKM2(n, a, b) asm volatile("s_waitcnt lgkmcnt(" #n ")" : "+v"(a), "+v"(b))
#define LGKM4(n, a, b, c, d) asm volatile("s_waitcnt lgkmcnt(" #n ")" : "+v"(a), "+v"(b), "+v"(c), "+v"(d))
#define KREAD(s_) do { DSR128(kr[(s_) % 3][0], kad[(s_) & 3], ((s_) >> 2) * 128); DSR128(kr[(s_) % 3][1], kad[(s_) & 3], ((s_) >> 2) * 128 + 12288); } while (0)
#define VREAD(s2_) do { DSR128(vr[(s2_) & 1][0], vad[s2_], 0); DSR128(vr[(s2_) & 1][1], vad[s2_], 4096); DSR128(vr[(s2_) & 1][2], vad[s2_], 8192); DSR128(vr[(s2_) & 1][3], vad[s2_], 12288); } while (0)
#define QKSTEP(s_, n_) do { if ((s_) + 2 < 12) KREAD((s_) + 2); LGKM2(n_, kr[(s_) % 3][0], kr[(s_) % 3][1]); \
        p0 = __builtin_amdgcn_mfma_f32_32x32x16_bf16(kr[(s_) % 3][0], qf[s_], p0, 0, 0, 0); p1 = __builtin_amdgcn_mfma_f32_32x32x16_bf16(kr[(s_) % 3][1], qf[s_], p1, 0, 0, 0); } while (0)
#define PVSTEP(s2_, n_, pw_) do { LGKM4(n_, vr[(s2_) & 1][0], vr[(s2_) & 1][1], vr[(s2_) & 1][2], vr[(s2_) & 1][3]); const bf16x8 pb_ = __builtin_bit_cast(bf16x8, pw_); \
        _Pragma("unroll") for (int e = 0; e < 4; ++e) o[e] = __builtin_amdgcn_mfma_f32_32x32x16_bf16(vr[(s2_) & 1][e], pb_, o[e], 0, 0, 0); \
        if ((s2_) + 2 < 4) VREAD((s2_) + 2); } while (0)
#define AT_TILE(kt, SLOT) do { \
        if (kt + 1 < ntiles) asm volatile("s_waitcnt vmcnt(5)" ::: "memory"); else asm volatile("s_waitcnt vmcnt(0)" ::: "memory"); \
        __builtin_amdgcn_s_barrier(); \
        asm volatile("" ::: "memory"); \
        if (kt + 2 < ntiles && !(VAR & 16)) AT_ISSUE(kt + 2, (SLOT + 2) % 3); \
        if (kt <= kt_last && !(VAR & 8)) { \
            unsigned kad[4], vad[4]; \
            _Pragma("unroll") for (int t = 0; t < 4; ++t) { kad[t] = lbase + (SLOT) * AT_BUF + r * 384 + (((2 * t + hh) ^ swz) * 16); vad[t] = lbase + (SLOT) * AT_BUF + AT_KB + r * 128 + (((2 * t + hh) ^ swz) * 16); } \
            bf16x8 kr[3][2], vr[2][4]; \
            f32x16 p0, p1; \
            _Pragma("unroll") for (int i = 0; i < 16; ++i) { p0[i] = 0.f; p1[i] = 0.f; } \
            KREAD(0); KREAD(1); \
            if (!(VAR & 4)) { QKSTEP(0, 4); QKSTEP(1, 4); QKSTEP(2, 4); QKSTEP(3, 4); QKSTEP(4, 4); QKSTEP(5, 4); QKSTEP(6, 4); QKSTEP(7, 4); QKSTEP(8, 4); QKSTEP(9, 4); QKSTEP(10, 2); QKSTEP(11, 0); } else { LGKM2(0, kr[0][0], kr[0][1]); LGKM2(0, kr[1][0], kr[1][1]); p0[0] = __builtin_bit_cast(float, kr[0][0][0] + kr[1][0][0]); p1[0] = __builtin_bit_cast(float, (int)kr[0][1][0] + (int)kr[1][1][0]); } \
            VREAD(0); VREAD(1); \
            if (kt == 0 || kt >= 4 * qb + 1) { \
                const int kmax = KOFF + trow, k0 = 64 * kt + 4 * hh; \
                _Pragma("unroll") for (int i = 0; i < 16; ++i) { const int kk = k0 + (i & 3) + 8 * (i >> 2); if (kk < 48 || kk > kmax) p0[i] = -1e30f; if (kk + 32 < 48 || kk + 32 > kmax) p1[i] = -1e30f; } \
            } \
            float mx = fmaxf(p0[0], p1[0]); \
            _Pragma("unroll") for (int i = 1; i < 16; ++i) mx = fmaxf(mx, fmaxf(p0[i], p1[i])); \
            mx = fmaxf(mx, __shfl_xor(mx, 32)); \
            if (__builtin_amdgcn_ballot_w64(mx > mrun) != 0ull) { \
                const float mnew = fmaxf(mrun, mx), alpha = __builtin_amdgcn_exp2f(mrun - mnew); mrun = mnew; lsum *= alpha; \
                _Pragma("unroll") for (int e = 0; e < 4; ++e) \
                    _Pragma("unroll") for (int i = 0; i < 16; ++i) o[e][i] *= alpha; \
            } \
            float ps = 0.f; \
            _Pragma("unroll") for (int i = 0; i < 16; ++i) { if (VAR & 1) { p0[i] = p0[i] - mrun; p1[i] = p1[i] - mrun; } else { p0[i] = __builtin_amdgcn_exp2f(p0[i] - mrun); p1[i] = __builtin_amdgcn_exp2f(p1[i] - mrun); } ps += p0[i] + p1[i]; } \
            lsum += ps; \
            u32x4 pw0, pw1, pw2, pw3; \
            pw0.x = cvt_pk_bf16(p0[0], p0[1]); pw0.y = cvt_pk_bf16(p0[2], p0[3]); pw0.z = cvt_pk_bf16(p0[4], p0[5]); pw0.w = cvt_pk_bf16(p0[6], p0[7]); \
            pw1.x = cvt_pk_bf16(p0[8], p0[9]); pw1.y = cvt_pk_bf16(p0[10], p0[11]); pw1.z = cvt_pk_bf16(p0[12], p0[13]); pw1.w = cvt_pk_bf16(p0[14], p0[15]); \
            pw2.x = cvt_pk_bf16(p1[0], p1[1]); pw2.y = cvt_pk_bf16(p1[2], p1[3]); pw2.z = cvt_pk_bf16(p1[4], p1[5]); pw2.w = cvt_pk_bf16(p1[6], p1[7]); \
            pw3.x = cvt_pk_bf16(p1[8], p1[9]); pw3.y = cvt_pk_bf16(p1[10], p1[11]); pw3.z = cvt_pk_bf16(p1[12], p1[13]); pw3.w = cvt_pk_bf16(p1[14], p1[15]); \
            if (!(VAR & 2)) { PVSTEP(0, 4, pw0); PVSTEP(1, 4, pw1); PVSTEP(2, 4, pw2); PVSTEP(3, 0, pw3); } else { LGKM4(0, vr[0][0], vr[0][1], vr[0][2], vr[0][3]); LGKM4(0, vr[1][0], vr[1][1], vr[1][2], vr[1][3]); o[0][0] += __builtin_bit_cast(float, pw0.x ^ pw1.y ^ pw2.z ^ pw3.w) + __builtin_bit_cast(float, (int)vr[0][0][0] + (int)vr[1][1][0]); } \
        } \
    } while (0)
    if (wave >= 4) __builtin_amdgcn_s_setprio(1);
    for (int kt0 = 0; kt0 < ntiles; kt0 += 3) {
        { const int kt = kt0; AT_TILE(kt, 0); }
        if (kt0 + 1 < ntiles) { const int kt = kt0 + 1; AT_TILE(kt, 1); }
        if (kt0 + 2 < ntiles) { const int kt = kt0 + 2; AT_TILE(kt, 2); }
    }
#undef AT_TILE
    __builtin_amdgcn_s_setprio(0);
#undef DSR128
#undef LGKM2
#undef LGKM4
#undef KREAD
#undef VREAD
#undef QKSTEP
#undef PVSTEP
#undef AT_ISSUE
    const float inv = 1.0f / (lsum + __shfl_xor(lsum, 32));
    bf16* yrow = P.ZMLA() + row * 2048 + h * 128;
    u32x2 zz[4][4];
#pragma unroll
    for (int e = 0; e < 4; ++e)
#pragma unroll
        for (int g = 0; g < 4; ++g) zz[e][g] = *(const u32x2*)(yrow + 32 * e + 8 * g + 4 * hh);
    asm volatile("" ::: "memory");
#pragma unroll
    for (int e = 0; e < 4; ++e)
#pragma unroll
        for (int g = 0; g < 4; ++g) { bf16* p = yrow + 32 * e + 8 * g + 4 * hh; const u32x2 z = zz[e][g];
            const float z0 = __uint_as_float(z.x << 16), z1 = __uint_as_float(z.x & 0xffff0000u), z2 = __uint_as_float(z.y << 16), z3 = __uint_as_float(z.y & 0xffff0000u);
            u32x2 w; w.x = cvt_pk_bf16(o[e][4 * g] * inv * z0, o[e][4 * g + 1] * inv * z1); w.y = cvt_pk_bf16(o[e][4 * g + 2] * inv * z2, o[e][4 * g + 3] * inv * z3); if (do_store) *(u32x2*)p = w; }
}

constexpr int RT_S = 272, RT_T = 128 * RT_S;
typedef short v4i16_t __attribute__((ext_vector_type(4)));
__device__ __forceinline__ s16x4 tr_read(const LAS unsigned char* p) { return __builtin_bit_cast(s16x4, __builtin_amdgcn_ds_read_tr16_b64_v4i16((LAS v4i16_t*)p)); }
__device__ __forceinline__ void ret_unit(const Ptrs& P, LAS unsigned char* lds, int b, int h, int tid, int lane, int wave, bool do_store = true) {
    asm volatile("" : "+v"(tid), "+v"(lane));
    const int c16 = lane & 15, q4 = lane >> 4, tq = c16 >> 2, tp = c16 & 3;
    LAS unsigned char* Ks = lds; LAS unsigned char* Vs = lds + RT_T; LAS unsigned char* Ps = lds + 2 * RT_T; LAS unsigned char* RTs = lds + 3 * RT_T;
    const float lg2 = head_lg2(h), G = exp2f(lg2 * 128.f);
    f32x4 R[8];
#pragma unroll
    for (int eb = 0; eb < 8; ++eb)
#pragma unroll
        for (int i = 0; i < 4; ++i) R[eb][i] = P.R0()[(h * 128 + 16 * wave + 4 * q4 + i) * 128 + 16 * eb + c16];
    __syncthreads();
#pragma unroll
    for (int eb = 0; eb < 8; ++eb) { u32x2 w; w.x = cvt_pk_bf16(R[eb][0], R[eb][1]); w.y = cvt_pk_bf16(R[eb][2], R[eb][3]); *(LAS u32x2*)(RTs + (16 * eb + c16) * RT_S + (16 * wave + 4 * q4) * 2) = w; }
    float rowfac[4], xi[4];
#pragma unroll
    for (int i = 0; i < 4; ++i) { const int n = 16 * wave + 4 * q4 + i; rowfac[i] = exp2f(lg2 * (float)(n - 127)); xi[i] = exp2f(lg2 * (float)(n + 1)); }
    float gw[8], gb[8];
#pragma unroll
    for (int eb = 0; eb < 8; ++eb) { gw[eb] = P.gnw()[h * 128 + 16 * eb + c16]; gb[eb] = P.gnb()[h * 128 + 16 * eb + c16]; }
    for (int ch = 0; ch < 32; ++ch) {
        const size_t row0 = (size_t)b * TOK + 128 * ch;
#pragma unroll
        for (int i = 0; i < 4; ++i) { const int id = tid + 512 * i, m = id >> 4, cc = id & 15;
            *(LAS u32x4*)(Ks + m * RT_S + cc * 16) = *(const u32x4*)(P.RK() + (row0 + m) * 1024 + h * 128 + cc * 8);
            *(LAS u32x4*)(Vs + m * RT_S + cc * 16) = *(const u32x4*)(P.RV() + (row0 + m) * 1024 + h * 128 + cc * 8); }
        bf16x8 qf[4];
#pragma unroll
        for (int s = 0; s < 4; ++s) qf[s] = *(const bf16x8*)(P.RQ() + (row0 + 16 * wave + c16) * 1024 + h * 128 + 32 * s + 8 * q4);
        unsigned short zr[4][8];
#pragma unroll
        for (int i = 0; i < 4; ++i)
#pragma unroll
            for (int eb = 0; eb < 8; ++eb) zr[i][eb] = P.ZRET()[(row0 + 16 * wave + 4 * q4 + i) * 2048 + h * 128 + c16 + 16 * eb];
        __syncthreads();
        f32x4 sacc[8], oacc[8];
#pragma unroll
        for (int mb = 0; mb < 8; ++mb) { f32x4 a = {0.f, 0.f, 0.f, 0.f}, c = {0.f, 0.f, 0.f, 0.f};
#pragma unroll
            for (int s = 0; s < 4; ++s) { const bf16x8 kf = *(const LAS bf16x8*)(Ks + (16 * mb + c16) * RT_S + (32 * s + 8 * q4) * 2), rf = *(const LAS bf16x8*)(RTs + (16 * mb + c16) * RT_S + (32 * s + 8 * q4) * 2);
                a = __builtin_amdgcn_mfma_f32_16x16x32_bf16(qf[s], kf, a, 0, 0, 0); c = __builtin_amdgcn_mfma_f32_16x16x32_bf16(qf[s], rf, c, 0, 0, 0); }
            sacc[mb] = a; oacc[mb] = c; }
#pragma unroll
        for (int mb = 0; mb < 8; ++mb)
#pragma unroll
            for (int i = 0; i < 4; ++i) { const int n = 16 * wave + 4 * q4 + i, m = 16 * mb + c16; const float pv = m <= n ? sacc[mb][i] * rowfac[i] : 0.f;
                *(LAS bf16*)(Ps + n * RT_S + m * 2) = (bf16)f2bf(pv); oacc[mb][i] *= xi[i]; }
        __syncthreads();
        bf16x8 pf[4], ktf[4];
#pragma unroll
        for (int s = 0; s < 4; ++s) { pf[s] = *(const LAS bf16x8*)(Ps + (16 * wave + c16) * RT_S + (32 * s + 8 * q4) * 2);
            const s16x4 lo = tr_read(Ks + (32 * s + 8 * q4 + tq) * RT_S + (16 * wave + 4 * tp) * 2), hi = tr_read(Ks + (32 * s + 8 * q4 + 4 + tq) * RT_S + (16 * wave + 4 * tp) * 2);
            ktf[s] = __builtin_shufflevector(lo, hi, 0, 1, 2, 3, 4, 5, 6, 7); }
#pragma unroll
        for (int eb = 0; eb < 8; ++eb) { f32x4 kv = {0.f, 0.f, 0.f, 0.f};
#pragma unroll
            for (int s = 0; s < 4; ++s) { const s16x4 lo = tr_read(Vs + (32 * s + 8 * q4 + tq) * RT_S + (16 * eb + 4 * tp) * 2), hi = tr_read(Vs + (32 * s + 8 * q4 + 4 + tq) * RT_S + (16 * eb + 4 * tp) * 2);
                const bf16x8 vf = __builtin_shufflevector(lo, hi, 0, 1, 2, 3, 4, 5, 6, 7);
                oacc[eb] = __builtin_amdgcn_mfma_f32_16x16x32_bf16(pf[s], vf, oacc[eb], 0, 0, 0); kv = __builtin_amdgcn_mfma_f32_16x16x32_bf16(ktf[s], vf, kv, 0, 0, 0); }
            R[eb] = R[eb] * G + kv;
            u32x2 w; w.x = cvt_pk_bf16(R[eb][0], R[eb][1]); w.y = cvt_pk_bf16(R[eb][2], R[eb][3]); *(LAS u32x2*)(RTs + (16 * eb + c16) * RT_S + (16 * wave + 4 * q4) * 2) = w; }
#pragma unroll
        for (int i = 0; i < 4; ++i) { float s = 0.f;
#pragma unroll
            for (int eb = 0; eb < 8; ++eb) s += oacc[eb][i];
            s += __shfl_xor(s, 1); s += __shfl_xor(s, 2); s += __shfl_xor(s, 4); s += __shfl_xor(s, 8);
            const float mu = s * (1.f / 128.f); float v = 0.f;
#pragma unroll
            for (int eb = 0; eb < 8; ++eb) { const float d = oacc[eb][i] - mu; v += d * d; }
            v += __shfl_xor(v, 1); v += __shfl_xor(v, 2); v += __shfl_xor(v, 4); v += __shfl_xor(v, 8);
            const float rstd = 1.0f / sqrtf(v * (1.f / 128.f) + GN_EPS);
            bf16* yr = P.ZRET() + (row0 + 16 * wave + 4 * q4 + i) * 2048 + h * 128 + c16;
#pragma unroll
            for (int eb = 0; eb < 8; ++eb) { const float z = bf2f(zr[i][eb]); const bf16 yv = (bf16)f2bf(((oacc[eb][i] - mu) * rstd * gw[eb] + gb[eb]) * z); if (do_store) yr[16 * eb] = yv; } }
        __syncthreads();
    }
}

#define RLX_AGENT __ATOMIC_RELAXED, __HIP_MEMORY_SCOPE_AGENT
#define XB_TMO      128
#define XB_XCNT(j)  (256  + 64 * (j))
#define XB_XSUB(j)  (1280 + 64 * (j))
#define XB_XGEN(j)  (2304 + 64 * (j))
#define XB_TOP      3328
#define XB_TOPGEN   3392
#define XCD_BAR_WORDS 3456
#define XB_SPIN_CAP (1u << 18)

__device__ __forceinline__ unsigned xb_ld(unsigned* p)              { return __hip_atomic_load(p, __ATOMIC_RELAXED, __HIP_MEMORY_SCOPE_AGENT); }
__device__ __forceinline__ unsigned xb_add(unsigned* p, unsigned v) { return __hip_atomic_fetch_add(p, v, __ATOMIC_RELAXED, __HIP_MEMORY_SCOPE_AGENT); }
__device__ __forceinline__ unsigned xb_xcc_id() { return (unsigned)__builtin_amdgcn_s_getreg((3 << 11) | 20) & 0xFu; }
#define XB_SPIN(cond, bar) do { unsigned _sp = 0; while (cond) { __builtin_amdgcn_s_sleep(1); \
    if ((++_sp & 255u) == 0u) { if (xb_ld(&(bar)[XB_TMO])) break; if (_sp > XB_SPIN_CAP) { atomicAdd(&(bar)[XB_TMO], 1u); break; } } } } while (0)

struct XcdBarrier {
    unsigned* bar; unsigned x;
    volatile LAS unsigned* st;
};

__device__ __forceinline__ XcdBarrier xcd_barrier_post(unsigned* bar, volatile LAS unsigned* st) {
    XcdBarrier b; b.bar = bar; b.x = xb_xcc_id(); b.st = st;
    if (threadIdx.x == 0) (void)xb_add(&bar[XB_XCNT(b.x)], 1u);
    return b;
}
__device__ __forceinline__ void xcd_barrier_complete(unsigned* bar, unsigned x, unsigned& nloc, unsigned& nx) {
    const unsigned G = gridDim.x * gridDim.y * gridDim.z;
    unsigned sum, cnt, mine, sp = 0u;
    for (;;) {
        sum = 0u; cnt = 0u; mine = 0u;
#pragma unroll
        for (unsigned j = 0; j < 16; ++j) { const unsigned c = xb_ld(&bar[XB_XCNT(j)]); sum += c; cnt += (c > 0u) ? 1u : 0u; mine = (j == x) ? c : mine; }
        if (sum == G) break;
        __builtin_amdgcn_s_sleep(1);
        if ((++sp & 255u) == 0u) { if (xb_ld(&bar[XB_TMO])) break; if (sp > XB_SPIN_CAP) { atomicAdd(&bar[XB_TMO], 1u); break; } }
    }
    nloc = mine > 0u ? mine : 1u; nx = cnt > 0u ? cnt : 1u;
}

__device__ __forceinline__ void xcd_barrier(const XcdBarrier& b) {
    asm volatile("s_waitcnt vmcnt(0)" ::: "memory");
    __syncthreads();
    if (threadIdx.x == 0) {
        unsigned* bar = b.bar;
        __builtin_amdgcn_s_waitcnt(0);
        unsigned nloc = b.st[0], nx = b.st[1];
        if (nloc == 0u) { xcd_barrier_complete(bar, b.x, nloc, nx); b.st[0] = nloc; b.st[1] = nx; }
        const unsigned old = xb_add(&bar[XB_XSUB(b.x)], 1u);
        const unsigned gen = old / nloc;
        if (old + 1u == (gen + 1u) * nloc) {
            __builtin_amdgcn_fence(__ATOMIC_RELEASE, "agent");
            asm volatile("s_waitcnt vmcnt(0)" ::: "memory");
            const unsigned og = xb_add(&bar[XB_TOP], 1u);
            const unsigned tg = og / nx;
            if (og + 1u == (tg + 1u) * nx) xb_add(&bar[XB_TOPGEN], 1u);
            else XB_SPIN(xb_ld(&bar[XB_TOPGEN]) == tg, bar);
            __builtin_amdgcn_fence(__ATOMIC_ACQUIRE, "agent");
            xb_add(&bar[XB_XGEN(b.x)], 1u);
            asm volatile("s_waitcnt vmcnt(0)" ::: "memory");
        } else {
            XB_SPIN(xb_ld(&bar[XB_XGEN(b.x)]) == gen, bar);
            __builtin_amdgcn_fence(__ATOMIC_ACQUIRE, "agent");
            asm volatile("s_waitcnt vmcnt(0)" ::: "memory");
        }
    }
    __syncthreads();
}

__device__ __forceinline__ void stagger_start(int bx, int step_ticks  , int groups) {
    const unsigned long long t0 = __builtin_amdgcn_s_memrealtime(); const unsigned long long d = (unsigned long long)((bx % groups) * step_ticks);
    while (__builtin_amdgcn_s_memrealtime() - t0 < d) __builtin_amdgcn_s_sleep(16);
}
template <int PH> __device__ __forceinline__ void run_phase(const Ptrs& P, LAS unsigned char* lds, int tid, int lane, int wave);

template <int ph_lo, int ph_hi> __global__ void __launch_bounds__(NTHR, 2) hybrid_fwd(Args args) {
    extern __shared__ __attribute__((aligned(16))) unsigned char lds_raw[];
    LAS unsigned char* lds = (LAS unsigned char*)lds_raw;
    const int tid = threadIdx.x, lane = tid & 63, wave = __builtin_amdgcn_readfirstlane(tid >> 6);
    volatile LAS unsigned* xst = (volatile LAS unsigned*)(lds + QWORD_OFF + 16);
    if (tid == 0) { xst[0] = 0u; xst[1] = 0u; }
    __syncthreads();
    XcdBarrier xbar; xbar.bar = nullptr; xbar.x = 0; xbar.st = nullptr;
    const int G = gridDim.x, bx = blockIdx.x;
    constexpr bool multi = (ph_hi - ph_lo) > 1;
#ifndef PHMASK
#define PHMASK 0x7f
#endif
#ifndef STAG1_TICKS
#define STAG1_TICKS 400
#define STAG1_GROUPS 16
#endif
#ifndef DUPMASK
#define DUPMASK 0
#endif
#define NREP(k) (((DUPMASK >> (k)) & 1) ? 2 : 1)
#define IN(k) (((PHMASK >> (k)) & 1) && ph_lo <= (k) && (k) < ph_hi)
#define PHASE_PTRS() Ptrs P; P.a = &args; P.ws = args.ws; unsigned char* ws = P.ws; (void)ws
#define SEAM(k) do { if (multi && IN((k) + 1)) { if ((k) == 0) { cg::this_grid().sync(); xbar = xcd_barrier_post((unsigned*)(args.ws + WS_CTL) + 4096, xst); } else xcd_barrier(xbar); } } while (0)

    if (IN(0)) { PHASE_PTRS(); for (int rep_ = 0; rep_ < NREP(0); ++rep_) { p0_prologue(P, lds, tid, lane, wave); __syncthreads(); } SEAM(0); }
    if (IN(1)) { PHASE_PTRS();
#if defined(PROBE_KLOOP1)
        { pg8::Gemm g{P.XN(), P.WIN(), M, NINP, D}; pg8::StaticOrder S; S.init(M, NINP, G, bx); pg8::EpiNull E{P.SSQO()};
          pg8::gemm_phase<pg8::EpiNull, pg8::StaticOrder, true, true>(lds, g, S, E); }
#endif
      for (int rep_ = 0; rep_ < NREP(1); ++rep_) {
        pg8::Gemm g{P.XN(), P.WIN(), M, NINP, D}; pg8::StaticOrder S; S.init(M, NINP, G, bx);
        pg8::EpiIn E{ws, P.SSQQ(), P.SSQKV(), P.C128(), P.S128(), P.C64(), P.S64()};
        pg8::gemm_phase<pg8::EpiIn, pg8::StaticOrder, true, true>(lds, g, S, E);
      }
        SEAM(1);
    }
    if (IN(2)) { PHASE_PTRS();
        meta_stage2(P, tid);
      for (int rep_ = 0; rep_ < NREP(2); ++rep_) {
        { pg8::Gemm g{P.CQ(), P.WUQ(), M, 1536, 512}; pg8::StaticOrder S; S.init(M, 1536, G, bx);
          pg8::EpiQ E{P.QN(), P.QR(), P.SSQQ(), P.C64(), P.S64(), 0.07216878364870322f * 1.4426950408889634f};
          pg8::gemm_phase<pg8::EpiQ, pg8::StaticOrder, true, true>(lds, g, S, E); }
        { pg8::Gemm g{P.CKV(), P.WUK(), M, 1024, 256}; pg8::StaticOrder S; S.init(M, 1024, G, bx);
          pg8::EpiK E{P.KN(), P.SSQKV()};
          pg8::gemm_phase<pg8::EpiK, pg8::StaticOrder, true, true>(lds, g, S, E); }
        { pg8::Gemm g{P.WUV(), P.CKV(), 1024, M, 256}; pg8::StaticOrder S; S.init(1024, M, G, bx);
          pg8::EpiVT E{P.VT(), P.SSQKV()};
          pg8::gemm_phase<pg8::EpiVT, pg8::StaticOrder, true, true>(lds, g, S, E); }
      }
        SEAM(2);
    }
    if (IN(3)) { PHASE_PTRS();
        volatile LAS unsigned* qw = (volatile LAS unsigned*)(lds + QWORD_OFF);
#if defined(PROBE_RET2)
        for (;;) { __syncthreads(); if (tid == 0) *qw = __hip_atomic_fetch_add(P.ctl() + 64 * 26, 1u, __ATOMIC_RELAXED, __HIP_MEMORY_SCOPE_AGENT); __syncthreads();
            const int idx = (int)__builtin_amdgcn_readfirstlane(*qw); if (idx >= 64) break; ret_unit(P, lds, idx >> 3, idx & 7, tid, lane, wave, P.ws == nullptr); }
#endif
#ifndef AT_PROBE_VAR
#define AT_PROBE_VAR 0
#endif
#if defined(PROBE_ATT2)
        for (;;) { __syncthreads(); if (tid == 0) *qw = __hip_atomic_fetch_add(P.ctl() + 64 * 27, 1u, __ATOMIC_RELAXED, __HIP_MEMORY_SCOPE_AGENT); __syncthreads();
            const int a = (int)__builtin_amdgcn_readfirstlane(*qw); if (a >= 1024) break; attn_unit<AT_PROBE_VAR>(P, lds, (a & 63) >> 3, a & 7, 15 - (a >> 6), tid, lane, wave, P.ws == nullptr); }
#endif
#ifndef NO_RET
        for (;;) {
            __syncthreads();
            if (tid == 0) *qw = __hip_atomic_fetch_add(P.ctl() + 64, 1u, __ATOMIC_RELAXED, __HIP_MEMORY_SCOPE_AGENT);
            __syncthreads();
            const int idx = (int)__builtin_amdgcn_readfirstlane(*qw);
            if (idx >= 64) break;
            ret_unit(P, lds, idx >> 3, idx & 7, tid, lane, wave);
        }
#endif
#ifndef NO_ATT
        for (;;) {
            __syncthreads();
            if (tid == 0) *qw = __hip_atomic_fetch_add(P.ctl() + 128, 1u, __ATOMIC_RELAXED, __HIP_MEMORY_SCOPE_AGENT);
            __syncthreads();
            const int a = (int)__builtin_amdgcn_readfirstlane(*qw);
            if (a >= 1024) break;
            attn_unit<0>(P, lds, (a & 63) >> 3, a & 7, 15 - (a >> 6), tid, lane, wave);
        }
#endif
        SEAM(3);
    }
    if (IN(4)) { PHASE_PTRS();
        { pg8::Gemm g{P.ZMLA(), P.WB2(), M, D, 2048}; pg8::StaticOrder S; S.init(M, D, G, bx);
          pg8::EpiMerge2 E{P.MG(), P.GATES()};
          pg8::gemm_phase<pg8::EpiMerge2, pg8::StaticOrder, true, true>(lds, g, S, E); }
        SEAM(4);
    }
    if (IN(5)) { PHASE_PTRS();
      for (int rep_ = 0; rep_ < NREP(5); ++rep_) {
        pg8::Gemm g{P.MG(), P.WOUT(), M, D, D}; pg8::StaticOrder S; S.init(M, D, G, bx);
        pg8::EpiOut E{P.XN()};
        pg8::gemm_phase<pg8::EpiOut, pg8::StaticOrder, true, true>(lds, g, S, E);
#if defined(PROBE_DUP5)
        { pg8::Gemm g{P.MG(), P.WOUT(), M, D, D}; pg8::StaticOrder S; S.init(M, D, G, bx);
        pg8::EpiOut E{P.XN()};
        pg8::gemm_phase<pg8::EpiOut, pg8::StaticOrder, true, true>(lds, g, S, E); }
#endif
      }
        SEAM(5);
    }
    if (IN(6)) { PHASE_PTRS();
        const int gw = bx * NWAVES + wave, NGW = G * NWAVES;
        f32x4 fw[8];
#pragma unroll
        for (int j = 0; j < 4; ++j) { const int c0 = 8 * (lane + 64 * j); fw[2 * j] = *(const f32x4*)(P.fnw() + c0); fw[2 * j + 1] = *(const f32x4*)(P.fnw() + c0 + 4); }
        u32x4 dv[4]; f32x4 xv[8];
        if (gw < M) {
#pragma unroll
            for (int j = 0; j < 4; ++j) { const int c0 = 8 * (lane + 64 * j); dv[j] = *(const u32x4*)(P.XN() + (size_t)gw * D + c0); xv[2 * j] = *(const f32x4*)(P.x() + (size_t)gw * D + c0); xv[2 * j + 1] = *(const f32x4*)(P.x() + (size_t)gw * D + c0 + 4); } }
        for (int m = gw; m < M; m += NGW) { float* orow = P.out() + (size_t)m * D; const int mn = m + NGW;
            u32x4 dn[4]; f32x4 xq[8];
            if (mn < M) {
#pragma unroll
                for (int j = 0; j < 4; ++j) { const int c0 = 8 * (lane + 64 * j); dn[j] = *(const u32x4*)(P.XN() + (size_t)mn * D + c0); xq[2 * j] = *(const f32x4*)(P.x() + (size_t)mn * D + c0); xq[2 * j + 1] = *(const f32x4*)(P.x() + (size_t)mn * D + c0 + 4); } }
            f32x4 hv[8]; float ss = 0.f;
#pragma unroll
            for (int j = 0; j < 4; ++j) { f32x4 d0, d1; pg8::unpack8(dv[j], d0, d1); hv[2 * j] = d0 + xv[2 * j]; hv[2 * j + 1] = d1 + xv[2 * j + 1]; }
#pragma unroll
            for (int j = 0; j < 8; ++j) ss += (hv[j][0] * hv[j][0] + hv[j][1] * hv[j][1]) + (hv[j][2] * hv[j][2] + hv[j][3] * hv[j][3]);
            const float rs = 1.0f / sqrtf(wave_sum(ss) * (1.f / D) + NORM_EPS);
#pragma unroll
            for (int j = 0; j < 4; ++j) { const int c0 = 8 * (lane + 64 * j);
                *(f32x4*)(orow + c0) = hv[2 * j] * rs * fw[2 * j]; *(f32x4*)(orow + c0 + 4) = hv[2 * j + 1] * rs * fw[2 * j + 1]; }
            if (mn < M) {
#pragma unroll
                for (int j = 0; j < 4; ++j) dv[j] = dn[j];
#pragma unroll
                for (int j = 0; j < 8; ++j) xv[j] = xq[j]; }
        }
    }
#undef IN
#undef SEAM
}

#ifndef N_LAUNCHES
#define N_LAUNCHES 1
#endif
template <int LO, int HI> static bool setup_one(int& per_cu) {
    if (hipFuncSetAttribute((const void*)hybrid_fwd<LO, HI>, hipFuncAttributeMaxDynamicSharedMemorySize, LDS_BYTES) != hipSuccess) { fprintf(stderr, "kernel_launch: hipFuncSetAttribute failed\n"); return false; }
    if (hipOccupancyMaxActiveBlocksPerMultiprocessor(&per_cu, (const void*)hybrid_fwd<LO, HI>, NTHR, LDS_BYTES) != hipSuccess || per_cu < 1) { fprintf(stderr, "kernel_launch: occupancy query says %d blocks per CU\n", per_cu); per_cu = 1; }
    (void)hipGetLastError();
    return true;
}
extern "C" void kernel_launch(void* const* d_in, const int* in_sizes, int n_in, void* d_out, int out_size, void* d_ws, size_t ws_size, hipStream_t stream) {
    static int grid = 0;
    if (grid == 0) {
        if (n_in != 14 || out_size != M * D || ws_size < WS_END) { fprintf(stderr, "kernel_launch: unexpected shapes (n_in %d, out %d, ws %zu)\n", n_in, out_size, ws_size); grid = -1; return; }
        int dev = 0, cus = 0, per_cu = 1; bool ok = true;
        (void)hipGetDevice(&dev); (void)hipDeviceGetAttribute(&cus, hipDeviceAttributeMultiprocessorCount, dev);
#if N_LAUNCHES == 1
        ok = setup_one<0, 7>(per_cu);
#else
        ok = setup_one<0, 1>(per_cu) && setup_one<1, 2>(per_cu) && setup_one<2, 3>(per_cu) && setup_one<3, 4>(per_cu) && setup_one<4, 5>(per_cu) && setup_one<5, 6>(per_cu) && setup_one<6, 7>(per_cu);
#endif
        if (!ok) { grid = -1; return; }
        grid = cus * per_cu;
        if (grid != 256) fprintf(stderr, "kernel_launch: note: grid = %d workgroups\n", grid);
    }
    if (grid < 0) return;
    Args a{};
    for (int i = 0; i < 14; ++i) a.in[i] = (const float*)d_in[i];
    a.out = (float*)d_out; a.ws = (unsigned char*)d_ws;
#if N_LAUNCHES == 1
    void* kargs[] = {&a};
    hipError_t e = hipLaunchCooperativeKernel((const void*)hybrid_fwd<0, 7>, dim3(grid), dim3(NTHR), kargs, LDS_BYTES, stream);
    if (e != hipSuccess) fprintf(stderr, "kernel_launch: cooperative launch failed: %s (grid %d)\n", hipGetErrorString(e), grid);
#else
    hipLaunchKernelGGL((hybrid_fwd<0, 1>), dim3(grid), dim3(NTHR), LDS_BYTES, stream, a);
    hipLaunchKernelGGL((hybrid_fwd<1, 2>), dim3(grid), dim3(NTHR), LDS_BYTES, stream, a);
    hipLaunchKernelGGL((hybrid_fwd<2, 3>), dim3(grid), dim3(NTHR), LDS_BYTES, stream, a);
    hipLaunchKernelGGL((hybrid_fwd<3, 4>), dim3(grid), dim3(NTHR), LDS_BYTES, stream, a);
    hipLaunchKernelGGL((hybrid_fwd<4, 5>), dim3(grid), dim3(NTHR), LDS_BYTES, stream, a);
    hipLaunchKernelGGL((hybrid_fwd<5, 6>), dim3(grid), dim3(NTHR), LDS_BYTES, stream, a);
    hipLaunchKernelGGL((hybrid_fwd<6, 7>), dim3(grid), dim3(NTHR), LDS_BYTES, stream, a);
#endif
}
```

```cpp
#include <hip/hip_runtime.h>
#include <hip/hip_cooperative_groups.h>
#include <cstdio>
#include <cstdint>
constexpr size_t MiB = 1u << 20;
constexpr size_t WS_CTL = 0, WS_WIN = 1 * MiB, WS_WUQ = 41 * MiB, WS_WUK = 43 * MiB, WS_WUV = 43 * MiB + 512 * 1024, WS_WB2 = 44 * MiB, WS_WOUT = 52 * MiB;
constexpr size_t WS_C128 = 60 * MiB, WS_S128 = 61 * MiB + 256 * 1024, WS_C64 = 62 * MiB + 512 * 1024, WS_S64 = 63 * MiB + 256 * 1024;
constexpr size_t WS_MP = 64 * MiB, WS_R0 = 64 * MiB + 256 * 1024, WS_SSQQ = 65 * MiB, WS_SSQKV = 66 * MiB, WS_SSQO = 67 * MiB, WS_KR = 71 * MiB;
constexpr size_t WS_XN = 76 * MiB, WS_QN = 76 * MiB, WS_QR = 140 * MiB, WS_CQ = 204 * MiB, WS_CKV = 236 * MiB, WS_ZMLA = 252 * MiB  , WS_ZRET = 252 * MiB + 2048, WS_RQ = 380 * MiB, WS_RK = 444 * MiB, WS_MG = 380 * MiB;
constexpr size_t WS_RV = 508 * MiB, WS_GATES = 572 * MiB, WS_KN = 828 * MiB, WS_VT = 894 * MiB, WS_END = 960 * MiB;
namespace pg8 {
#define PG8_LAS __attribute__((address_space(3)))
typedef unsigned short bf16_t;
typedef short bf16x8 __attribute__((ext_vector_type(8)));
typedef float f32x4 __attribute__((ext_vector_type(4)));
typedef unsigned u32x4 __attribute__((ext_vector_type(4)));
constexpr int BM = 256, BK = 64, HALF = 128, HTB = HALF * BK * 2  , STAGE_BYTES = 8 * HTB, NXCD = 8, WGM = 4;

__host__ __device__ __forceinline__ int lds_byte(int r, int c) { const int st = (r >> 4) * 2 + (c >> 5), rr = r & 15, cc = c & 31, ob = rr * 64 + cc * 2; return st * 1024 + (ob ^ (((ob >> 9) & 1) << 5)); }
__host__ __device__ __forceinline__ void stage_rc(int b, int& R, int& C) { const int st = b / 1024, sb = b % 1024, swz = sb ^ (((sb >> 9) & 1) << 5); R = (st >> 1) * 16 + swz / 64; C = (st & 1) * 32 + (swz % 64) / 2; }
__host__ __device__ __forceinline__ int perm32(int rho) { const int n = rho >> 4, i = rho & 15; return 8 * (i >> 2) + 4 * n + (i & 3); }

struct Unit { int pm, pn; };
struct Gemm { const bf16_t* A; const bf16_t* Bt; int M, N, K; };

struct StaticOrder {
    int nM, nN, nwg, G, c;
    __host__ __device__ void init(int M, int N, int G_, int c_) { nM = M / BM; nN = N / BM; nwg = nM * nN; G = G_; c = c_; }
    __host__ __device__ bool next(int i, Unit& u) const {
        const long L = (long)i * G + c; if (L >= nwg) return false;
        int wgid = (int)L; { const int q = nwg / NXCD, r = nwg % NXCD, xcd = wgid % NXCD, off = wgid / NXCD; wgid = (xcd < r ? xcd * (q + 1) : r * (q + 1) + (xcd - r) * q) + off; }
        const int nig = WGM * nN, gid = wgid / nig, fm = gid * WGM, gsz = (nM - fm) < WGM ? (nM - fm) : WGM;
        u.pm = fm + ((wgid % nig) % gsz); u.pn = (wgid % nig) / gsz; return true;
    }
    __device__ __forceinline__ void a_ready(const Unit&) const {}
    __device__ __forceinline__ void done(const Unit&) const {}
};

__device__ __forceinline__ unsigned cvt_pk_bf16(float lo, float hi) { unsigned r; asm volatile("v_cvt_pk_bf16_f32 %0, %1, %2" : "=v"(r) : "v"(lo), "v"(hi)); return r; }
typedef float f32x2 __attribute__((ext_vector_type(2)));
typedef unsigned u32x2 __attribute__((ext_vector_type(2)));
constexpr int TOK = 4096, KSEQ = 4160, KOFF = 64;
__device__ __forceinline__ float head_lg2(int h) { const float x = __uint_as_float((unsigned)(127 - 5 - h) << 23); const float p = x * (1.f + x * (0.5f + x * (0.33333333f + x * (0.25f + x * (0.2f + x * (0.16666667f + x * 0.14285714f)))))); return -p * 1.4426950408889634f; }
__device__ __forceinline__ void rope_cs4(int pos, int j0, float inv_half  , f32x4& c, f32x4& s) {
#pragma unroll
    for (int i = 0; i < 4; ++i) { const float rev = (float)pos * __builtin_amdgcn_exp2f(-(float)(j0 + i) * inv_half * 13.287712379549449f - 2.651496129472319f);
        const float f = __builtin_amdgcn_fractf(rev); c[i] = __builtin_amdgcn_cosf(f); s[i] = __builtin_amdgcn_sinf(f); }
}
__device__ __forceinline__ float sigmoid_f(float x) { return __builtin_amdgcn_rcpf(1.f + __expf(-x)); }
__device__ __forceinline__ float bf2f(unsigned short b) { return __uint_as_float((unsigned)b << 16); }
__device__ __forceinline__ u32x4 pack8(f32x4 v0, f32x4 v1) { u32x4 w; w.x = cvt_pk_bf16(v0[0], v0[1]); w.y = cvt_pk_bf16(v0[2], v0[3]); w.z = cvt_pk_bf16(v1[0], v1[1]); w.w = cvt_pk_bf16(v1[2], v1[3]); return w; }
__device__ __forceinline__ u32x2 pack4(f32x4 v) { u32x2 w; w.x = cvt_pk_bf16(v[0], v[1]); w.y = cvt_pk_bf16(v[2], v[3]); return w; }
__device__ __forceinline__ void unpack8(u32x4 w, f32x4& a, f32x4& b) {
    a[0] = __uint_as_float(w.x << 16); a[1] = __uint_as_float(w.x & 0xffff0000u); a[2] = __uint_as_float(w.y << 16); a[3] = __uint_as_float(w.y & 0xffff0000u);
    b[0] = __uint_as_float(w.z << 16); b[1] = __uint_as_float(w.z & 0xffff0000u); b[2] = __uint_as_float(w.w << 16); b[3] = __uint_as_float(w.w & 0xffff0000u); }

struct EpiIn {
    static constexpr bool PERM = true, AFTER_DRAIN = false, HAS_MID = false;
    unsigned char* ws; float *ssq_q, *ssq_kv; const float *C128, *S128, *C64, *S64;
    __device__ __forceinline__ void operator()(const f32x4 (&acc)[2][2][4][2], const Unit& u, int wr, int wc, int fr, int fq) const {
        const int pn = u.pn, row0 = u.pm * BM + wr * 64 + fr;
        if (pn < 3) {
            bf16_t* base = (bf16_t*)(ws + (pn < 2 ? WS_CQ : WS_CKV)); const int ldc = pn < 2 ? 512 : 256, colt = pn < 2 ? pn * 256 : 0;
            float* sq = pn < 2 ? ssq_q : ssq_kv; const int sld = pn < 2 ? 8 : 4, soff = (pn < 2 ? pn * 4 : 0) + wc;
#pragma unroll
            for (int ai = 0; ai < 2; ++ai)
#pragma unroll
                for (int m = 0; m < 4; ++m) { const int row = row0 + ai * HALF + m * 16; float s = 0.f;
#pragma unroll
                    for (int bj = 0; bj < 2; ++bj) { const f32x4 v0 = acc[ai][bj][m][0], v1 = acc[ai][bj][m][1];
                        s += (v0[0] * v0[0] + v0[1] * v0[1]) + (v0[2] * v0[2] + v0[3] * v0[3]) + (v1[0] * v1[0] + v1[1] * v1[1]) + (v1[2] * v1[2] + v1[3] * v1[3]);
                        *(u32x4*)(base + (size_t)row * ldc + colt + bj * HALF + wc * 32 + 8 * fq) = pack8(v0, v1); }
                    s += __shfl_xor(s, 16); s += __shfl_xor(s, 32);
                    if (fq == 0) sq[(size_t)row * sld + soff] = s; }
        } else if (pn == 3) {
            if (wc < 2) {
                const int j0 = 16 * wc + 4 * fq;
#pragma unroll
                for (int ai = 0; ai < 2; ++ai)
#pragma unroll
                    for (int m = 0; m < 4; ++m) { const int row = row0 + ai * HALF + m * 16, b = row >> 12, t = row & (TOK - 1);
                        f32x4 c, s; rope_cs4(16 + t, j0, 1.f / 32.f, c, s);
                        const f32x4 t1 = acc[ai][0][m][0], t2 = acc[ai][0][m][1];
                        bf16_t* o = (bf16_t*)(ws + WS_KR) + (size_t)(b * KSEQ + KOFF + t) * 64 + j0;
                        *(u32x2*)o = pack4(t1 * c - t2 * s); *(u32x2*)(o + 32) = pack4(t1 * s + t2 * c); }
            }
        } else if ((pn >= 8) && (pn < 16)) {
            const bool isk = pn >= 12; bf16_t* base = (bf16_t*)(ws + (isk ? WS_RK : WS_RQ)); const int colt = (pn - (isk ? 12 : 8)) * 256; const int j0 = 16 * wc + 4 * fq;
#pragma unroll
            for (int ai = 0; ai < 2; ++ai) {
#pragma unroll
                for (int m = 0; m < 4; ++m) { const int row = row0 + ai * HALF + m * 16, t = row & (TOK - 1);
                    f32x4 c, s; rope_cs4(16 + t, j0, 1.f / 64.f, c, s);
#pragma unroll
                    for (int bj = 0; bj < 2; ++bj) { float f = 1.f;
                        if (isk) { const int h = (colt >> 7) + bj; f = 0.08838834764831845f * __builtin_amdgcn_exp2f(head_lg2(h) * (float)(127 - (t & 127))); }
                        const f32x4 t1 = acc[ai][bj][m][0] * f, t2 = acc[ai][bj][m][1] * f;
                        bf16_t* o = base + (size_t)row * 1024 + colt + bj * HALF + j0;
                        *(u32x2*)o = pack4(t1 * c - t2 * s); *(u32x2*)(o + 64) = pack4(t1 * s + t2 * c); } }
                asm volatile("" ::: "memory");
            }
        } else {
            size_t boff; int ldc, colt, act;
            if (pn < 8) { boff = WS_ZMLA; ldc = 2048; colt = (pn - 4) * 256; act = 1; }
            else if (pn < 20) { boff = WS_RV; ldc = 1024; colt = (pn - 16) * 256; act = 0; }
            else if (pn < 24) { boff = WS_ZRET; ldc = 2048; colt = (pn - 20) * 256; act = 1; }
            else { boff = WS_GATES; ldc = 4096; colt = (pn - 24) * 256; act = 2; }
            bf16_t* base = (bf16_t*)(ws + boff);
#pragma unroll
            for (int ai = 0; ai < 2; ++ai)
#pragma unroll
                for (int m = 0; m < 4; ++m) { const int row = row0 + ai * HALF + m * 16;
#pragma unroll
                    for (int bj = 0; bj < 2; ++bj) { f32x4 v0 = acc[ai][bj][m][0], v1 = acc[ai][bj][m][1];
                        if (act != 0) {
#pragma unroll
                            for (int i = 0; i < 4; ++i) { const float s0 = sigmoid_f(v0[i]), s1 = sigmoid_f(v1[i]); v0[i] = act == 1 ? v0[i] * s0 : s0; v1[i] = act == 1 ? v1[i] * s1 : s1; } }
                        *(u32x4*)(base + (size_t)row * ldc + colt + bj * HALF + wc * 32 + 8 * fq) = pack8(v0, v1); } }
        }
    }
};

__device__ __forceinline__ float rs_from(const float* p, int n, float inv_d, float eps) { float s = 0.f; for (int i = 0; i < n; ++i) s += p[i]; return 1.0f / sqrtf(s * inv_d + eps); }

struct EpiQ {
    static constexpr bool PERM = true, AFTER_DRAIN = false, HAS_MID = false;
    bf16_t *QN, *QR; const float *ssq_q, *C64, *S64; float qscale;
    __device__ __forceinline__ void operator()(const f32x4 (&acc)[2][2][4][2], const Unit& u, int wr, int wc, int fr, int fq) const {
        const int pn = u.pn, row0 = u.pm * BM + wr * 64 + fr;
        float fs[2][4];
#pragma unroll
        for (int ai = 0; ai < 2; ++ai)
#pragma unroll
            for (int m = 0; m < 4; ++m) { const int row = row0 + ai * HALF + m * 16;
                const f32x4 q0 = *(const f32x4*)(ssq_q + (size_t)row * 8), q1 = *(const f32x4*)(ssq_q + (size_t)row * 8 + 4);
                const float ss = ((q0[0] + q0[1]) + (q0[2] + q0[3])) + ((q1[0] + q1[1]) + (q1[2] + q1[3]));
                fs[ai][m] = qscale / sqrtf(ss * (1.f / 512.f) + 1e-6f); }
        if (pn < 4) {
            asm volatile("" ::: "memory");
#pragma unroll
            for (int ai = 0; ai < 2; ++ai)
#pragma unroll
                for (int m = 0; m < 4; ++m) { const int row = row0 + ai * HALF + m * 16; const float f = fs[ai][m];
#pragma unroll
                    for (int bj = 0; bj < 2; ++bj) *(u32x4*)(QN + (size_t)row * 1024 + pn * 256 + bj * HALF + wc * 32 + 8 * fq) = pack8(acc[ai][bj][m][0] * f, acc[ai][bj][m][1] * f); }
        } else {
            const int j0 = 16 * (wc & 1) + 4 * fq;
#pragma unroll
            for (int ai = 0; ai < 2; ++ai) {
#pragma unroll
                for (int m = 0; m < 4; ++m) { const int row = row0 + ai * HALF + m * 16; const float f = fs[ai][m]; f32x4 c, s; rope_cs4(16 + (row & (TOK - 1)), j0, 1.f / 32.f, c, s);
#pragma unroll
                    for (int bj = 0; bj < 2; ++bj) { const int head = (pn - 4) * 4 + bj * 2 + (wc >> 1);
                        const f32x4 t1 = acc[ai][bj][m][0] * f, t2 = acc[ai][bj][m][1] * f;
                        bf16_t* o = QR + (size_t)row * 512 + head * 64 + j0;
                        *(u32x2*)o = pack4(t1 * c - t2 * s); *(u32x2*)(o + 32) = pack4(t1 * s + t2 * c); } }
                asm volatile("" ::: "memory");
            }
        }
    }
};
struct EpiK {
    static constexpr bool PERM = true, AFTER_DRAIN = false, HAS_MID = false;
    bf16_t* KN; const float* ssq_kv;
    __device__ __forceinline__ void operator()(const f32x4 (&acc)[2][2][4][2], const Unit& u, int wr, int wc, int fr, int fq) const {
        const int pn = u.pn, row0 = u.pm * BM + wr * 64 + fr;
        float fs[2][4];
#pragma unroll
        for (int ai = 0; ai < 2; ++ai)
#pragma unroll
            for (int m = 0; m < 4; ++m) { const int row = row0 + ai * HALF + m * 16; const f32x4 q0 = *(const f32x4*)(ssq_kv + (size_t)row * 4);
                fs[ai][m] = 1.0f / sqrtf(((q0[0] + q0[1]) + (q0[2] + q0[3])) * (1.f / 256.f) + 1e-6f); }
        asm volatile("" ::: "memory");
#pragma unroll
        for (int ai = 0; ai < 2; ++ai)
#pragma unroll
            for (int m = 0; m < 4; ++m) { const int row = row0 + ai * HALF + m * 16, b = row >> 12, t = row & (TOK - 1); const float f = fs[ai][m];
#pragma unroll
                for (int bj = 0; bj < 2; ++bj) *(u32x4*)(KN + (size_t)(b * KSEQ + KOFF + t) * 1024 + pn * 256 + bj * HALF + wc * 32 + 8 * fq) = pack8(acc[ai][bj][m][0] * f, acc[ai][bj][m][1] * f); }
    }
};
struct EpiVT {
    static constexpr bool PERM = true, AFTER_DRAIN = false, HAS_MID = false;
    bf16_t* VT; const float* ssq_kv;
    __device__ __forceinline__ void operator()(const f32x4 (&acc)[2][2][4][2], const Unit& u, int wr, int wc, int fr, int fq) const {
        const int pn = u.pn, row0 = u.pm * BM + wr * 64 + fr;
#pragma unroll
        for (int bj = 0; bj < 2; ++bj) { const int col = pn * 256 + bj * HALF + wc * 32 + 8 * fq, b = col >> 12, t = col & (TOK - 1);
            f32x4 f0, f1;
#pragma unroll
            for (int i = 0; i < 4; ++i) { const f32x4 a = *(const f32x4*)(ssq_kv + (size_t)(col + i) * 4);
                f0[i] = 1.0f / sqrtf(((a[0] + a[1]) + (a[2] + a[3])) * (1.f / 256.f) + 1e-6f); }
#pragma unroll
            for (int i = 0; i < 4; ++i) { const f32x4 c = *(const f32x4*)(ssq_kv + (size_t)(col + 4 + i) * 4);
                f1[i] = 1.0f / sqrtf(((c[0] + c[1]) + (c[2] + c[3])) * (1.f / 256.f) + 1e-6f); }
#pragma unroll
            for (int ai = 0; ai < 2; ++ai)
#pragma unroll
                for (int m = 0; m < 4; ++m) { const int row = row0 + ai * HALF + m * 16;
                    bf16_t* o = VT + (size_t)row * (8 * KSEQ) + b * KSEQ + KOFF + (t & ~15) + ((t & 8) ? 4 : 0);
                    *(u32x2*)o = pack4(acc[ai][bj][m][0] * f0); *(u32x2*)(o + 8) = pack4(acc[ai][bj][m][1] * f1); } }
    }
};
struct EpiMerge2 {
    static constexpr bool PERM = true, AFTER_DRAIN = false, HAS_MID = true;
    bf16_t* MG; const bf16_t* GATES;
    __device__ __forceinline__ void mid(f32x4 (&acc)[2][2][4][2], const Unit& u, int wr, int wc, int fr, int fq) const {
        asm volatile("" : "+v"(fr), "+v"(fq));
        const int row0 = u.pm * BM + wr * 64 + fr, col0 = u.pn * 256 + wc * 32 + 8 * fq;
#pragma unroll
        for (int ai = 0; ai < 2; ++ai)
#pragma unroll
            for (int mh = 0; mh < 2; ++mh) {
                u32x4 ga[2][2], gb[2][2];
#pragma unroll
                for (int mm = 0; mm < 2; ++mm)
#pragma unroll
                    for (int bj = 0; bj < 2; ++bj) { const size_t row = (size_t)(row0 + ai * HALF + (2 * mh + mm) * 16);
                        ga[mm][bj] = *(const u32x4*)(GATES + row * 4096 + col0 + bj * HALF); gb[mm][bj] = *(const u32x4*)(GATES + row * 4096 + 2048 + col0 + bj * HALF); }
                asm volatile("" ::: "memory");
#pragma unroll
                for (int mm = 0; mm < 2; ++mm)
#pragma unroll
                    for (int bj = 0; bj < 2; ++bj) { const int m = 2 * mh + mm; f32x4 a0, a1, b0, b1; unpack8(ga[mm][bj], a0, a1); unpack8(gb[mm][bj], b0, b1);
#pragma unroll
                        for (int i = 0; i < 4; ++i) { acc[ai][bj][m][0][i] *= a0[i] * __builtin_amdgcn_rcpf(fmaxf(b0[i], 1e-30f)); acc[ai][bj][m][1][i] *= a1[i] * __builtin_amdgcn_rcpf(fmaxf(b1[i], 1e-30f)); } }
                asm volatile("" ::: "memory");
            }
    }
    __device__ __forceinline__ void operator()(const f32x4 (&acc)[2][2][4][2], const Unit& u, int wr, int wc, int fr, int fq) const {
        asm volatile("" : "+v"(fr), "+v"(fq));
        const int row0 = u.pm * BM + wr * 64 + fr, col0 = u.pn * 256 + wc * 32 + 8 * fq;
#pragma unroll
        for (int ai = 0; ai < 2; ++ai) {
            u32x4 gb[4][2];
#pragma unroll
            for (int m = 0; m < 4; ++m)
#pragma unroll
                for (int bj = 0; bj < 2; ++bj) gb[m][bj] = *(const u32x4*)(GATES + (size_t)(row0 + ai * HALF + m * 16) * 4096 + 2048 + col0 + bj * HALF);
            asm volatile("" ::: "memory");
#pragma unroll
            for (int m = 0; m < 4; ++m)
#pragma unroll
                for (int bj = 0; bj < 2; ++bj) { f32x4 b0, b1; unpack8(gb[m][bj], b0, b1);
                    *(u32x4*)(MG + (size_t)(row0 + ai * HALF + m * 16) * 2048 + col0 + bj * HALF) = pack8(acc[ai][bj][m][0] * b0, acc[ai][bj][m][1] * b1); }
            asm volatile("" ::: "memory");
        }
    }
};
struct EpiOut {
    static constexpr bool PERM = true, AFTER_DRAIN = false, HAS_MID = false;
    bf16_t* PRE;
    __device__ __forceinline__ void operator()(const f32x4 (&acc)[2][2][4][2], const Unit& u, int wr, int wc, int fr, int fq) const {
        const int pn = u.pn, row0 = u.pm * BM + wr * 64 + fr;
#pragma unroll
        for (int ai = 0; ai < 2; ++ai)
#pragma unroll
            for (int m = 0; m < 4; ++m) { const int row = row0 + ai * HALF + m * 16;
#pragma unroll
                for (int bj = 0; bj < 2; ++bj) *(u32x4*)(PRE + (size_t)row * 2048 + pn * 256 + bj * HALF + wc * 32 + 8 * fq) = pack8(acc[ai][bj][m][0], acc[ai][bj][m][1]); }
    }
};

struct EpiNull {
    static constexpr bool PERM = true, AFTER_DRAIN = false, HAS_MID = false;
    float* sink;
    __device__ __forceinline__ void operator()(const f32x4 (&acc)[2][2][4][2], const Unit& u, int wr, int wc, int fr, int fq) const {
        float s = 0.f;
#pragma unroll
        for (int ai = 0; ai < 2; ++ai)
#pragma unroll
            for (int bj = 0; bj < 2; ++bj)
#pragma unroll
                for (int m = 0; m < 4; ++m)
#pragma unroll
                    for (int n = 0; n < 2; ++n) s += acc[ai][bj][m][n][0] + acc[ai][bj][m][n][3];
        if (s == 1.2345e-30f) sink[0] = s;
    }
};
template <class Epi, class Sched, bool ALIGN_EPI = false, bool SP2 = false>
__device__ __forceinline__ void gemm_phase(PG8_LAS unsigned char* lds, const Gemm g, const Sched& S, const Epi& E) {
    int tid = threadIdx.x; asm volatile("" : "+v"(tid));
    const int wid = __builtin_amdgcn_readfirstlane(tid >> 6), lane = tid & 63, wr = wid >> 2, wc = wid & 3, fr = lane & 15, fq = lane >> 4;
    const int K = g.K, nt = K / BK;
    unsigned voffA[2], voffB[2];
#pragma unroll
    for (int i = 0; i < 2; ++i) { int R, C; stage_rc(tid * 16 + i * 8192, R, C); const int Rb = Epi::PERM ? ((R & ~31) + perm32(R & 31)) : R;
        voffA[i] = (unsigned)(R * K + C) * 2u; voffB[i] = (unsigned)(Rb * K + C) * 2u; }
    const size_t kstep = (size_t)(BK * 2);
    const size_t hstep = (size_t)HALF * K * 2;
    const size_t tstep = 2 * hstep;
    const unsigned ldsw = (unsigned)wid * 1024u;
    const int aoff = lds_byte(wr * 64 + fr, fq * 8), boff = lds_byte(wc * 32 + fr, fq * 8);
#define PG8_SA(b, h) (((b) * 2 + (h)) * HTB)
#define PG8_SB(b, h) ((4 + (b) * 2 + (h)) * HTB)
#define PG8_STAGE(bufoff, gbase, voff) do { _Pragma("unroll") for (int _i = 0; _i < 2; ++_i) \
        __builtin_amdgcn_global_load_lds((const unsigned*)((const char*)(gbase) + (voff)[_i]), (PG8_LAS unsigned*)(lds + (bufoff) + ldsw + _i * 8192), 16, 0, 0); } while (0)
#define PG8_LDA(dst, b, h) do { _Pragma("unroll") for (int m = 0; m < 4; ++m) _Pragma("unroll") for (int k = 0; k < 2; ++k) dst[m][k] = *(const PG8_LAS bf16x8*)(lds + PG8_SA(b, h) + aoff + m * 2048 + k * 1024); } while (0)
#define PG8_LDB(dst, b, h) do { _Pragma("unroll") for (int n = 0; n < 2; ++n) _Pragma("unroll") for (int k = 0; k < 2; ++k) dst[n][k] = *(const PG8_LAS bf16x8*)(lds + PG8_SB(b, h) + boff + n * 2048 + k * 1024); } while (0)
#define PG8_MMA(ai, bj, At, Bt) do { __builtin_amdgcn_s_setprio(1); _Pragma("unroll") for (int m = 0; m < 4; ++m) _Pragma("unroll") for (int n = 0; n < 2; ++n) _Pragma("unroll") for (int k = 0; k < 2; ++k) \
        acc[ai][bj][m][n] = __builtin_amdgcn_mfma_f32_16x16x32_bf16(Bt[n][k], At[m][k], acc[ai][bj][m][n], 0, 0, 0); __builtin_amdgcn_s_setprio(0); } while (0)
#define PG8_WAIT_V(n) asm volatile("s_waitcnt vmcnt(" #n ")" ::: "memory")
#define PG8_WAIT_L(n) asm volatile("s_waitcnt lgkmcnt(" #n ")" ::: "memory")
#define PG8_BAR __builtin_amdgcn_s_barrier()
#define PG8_SCHED __builtin_amdgcn_sched_barrier(0)
    Unit cur, nxt; int ui = 0;
    if (!S.next(0, cur)) return;
    f32x4 acc[2][2][4][2];
#pragma unroll
    for (int a = 0; a < 2; ++a)
#pragma unroll
        for (int b = 0; b < 2; ++b)
#pragma unroll
            for (int m = 0; m < 4; ++m)
#pragma unroll
                for (int n = 0; n < 2; ++n) acc[a][b][m][n] = (f32x4){0.f, 0.f, 0.f, 0.f};
    bf16x8 At[4][2], B0[2][2], B1[2][2];
    const char* cA = (const char*)g.A + (size_t)cur.pm * tstep; const char* cB = (const char*)g.Bt + (size_t)cur.pn * tstep;
    S.a_ready(cur);
    if constexpr (SP2) {
        PG8_STAGE(PG8_SB(0, 0), cB, voffB); PG8_STAGE(PG8_SB(0, 1), cB + hstep, voffB); PG8_STAGE(PG8_SA(0, 0), cA, voffA); PG8_STAGE(PG8_SA(0, 1), cA + hstep, voffA);
        if (wr == 1) PG8_BAR;
        PG8_WAIT_V(2); PG8_BAR;
        PG8_STAGE(PG8_SB(1, 0), cB + kstep, voffB); PG8_STAGE(PG8_SA(1, 0), cA + kstep, voffA); PG8_STAGE(PG8_SB(1, 1), cB + hstep + kstep, voffB);
        PG8_WAIT_V(6); PG8_BAR;
    } else {
        PG8_STAGE(PG8_SB(0, 0), cB, voffB); PG8_STAGE(PG8_SA(0, 0), cA, voffA); PG8_STAGE(PG8_SB(0, 1), cB + hstep, voffB); PG8_STAGE(PG8_SA(0, 1), cA + hstep, voffA);
        if (wr == 1) PG8_BAR;
        PG8_WAIT_V(4); PG8_BAR;
        PG8_STAGE(PG8_SB(1, 0), cB + kstep, voffB); PG8_STAGE(PG8_SA(1, 0), cA + kstep, voffA); PG8_STAGE(PG8_SB(1, 1), cB + hstep + kstep, voffB);
        PG8_WAIT_V(6); PG8_BAR;
    }
    for (;;) {
        const bool has_next = S.next(ui + 1, nxt);
        const char* nA = has_next ? (const char*)g.A + (size_t)nxt.pm * tstep : cA; const char* nB = has_next ? (const char*)g.Bt + (size_t)nxt.pn * tstep : cB;
#pragma nounroll
        for (int t = 0; t < nt; t += 2) {
            if constexpr (Epi::HAS_MID) { if (t == nt / 2) { PG8_SCHED; E.mid(acc, cur, wr, wc, fr, fq); PG8_SCHED; } }
            const bool last = (t == nt - 2);
            const char* a1 = cA + (size_t)(t + 1) * kstep;
            const char* a2 = last ? nA : cA + (size_t)(t + 2) * kstep; const char* b2 = last ? nB : cB + (size_t)(t + 2) * kstep;
            const char* a3 = a2 + kstep; const char* b3 = b2 + kstep;
            if (last && has_next) S.a_ready(nxt);
            if constexpr (SP2) {
            PG8_LDB(B0, 0, 0); PG8_LDB(B1, 0, 1); PG8_SCHED; PG8_LDA(At, 0, 0); PG8_STAGE(PG8_SA(1, 1), a1 + hstep, voffA);
            PG8_WAIT_V(8); PG8_WAIT_L(0); PG8_BAR; PG8_MMA(0, 0, At, B0); PG8_MMA(0, 1, At, B1); PG8_BAR; PG8_SCHED;
            PG8_LDA(At, 0, 1); PG8_STAGE(PG8_SB(0, 0), b2, voffB); PG8_STAGE(PG8_SB(0, 1), b2 + hstep, voffB); PG8_STAGE(PG8_SA(0, 0), a2, voffA);
            PG8_WAIT_V(8); PG8_WAIT_L(0); PG8_BAR; PG8_MMA(1, 0, At, B0); PG8_MMA(1, 1, At, B1); PG8_BAR; PG8_SCHED;
            PG8_LDB(B0, 1, 0); PG8_LDB(B1, 1, 1); PG8_SCHED; PG8_LDA(At, 1, 0); PG8_STAGE(PG8_SA(0, 1), a2 + hstep, voffA);
            PG8_WAIT_V(8); PG8_WAIT_L(0); PG8_BAR; PG8_MMA(0, 0, At, B0); PG8_MMA(0, 1, At, B1); PG8_BAR; PG8_SCHED;
            PG8_LDA(At, 1, 1); PG8_STAGE(PG8_SB(1, 0), b3, voffB); PG8_STAGE(PG8_SB(1, 1), b3 + hstep, voffB); PG8_STAGE(PG8_SA(1, 0), a3, voffA);
            PG8_WAIT_V(8); PG8_WAIT_L(0); PG8_BAR; PG8_MMA(1, 0, At, B0); PG8_MMA(1, 1, At, B1); PG8_BAR; PG8_SCHED;
            } else {
            PG8_LDB(B0, 0, 0); PG8_SCHED; PG8_LDA(At, 0, 0); PG8_STAGE(PG8_SA(1, 1), a1 + hstep, voffA);
            PG8_WAIT_L(8); PG8_BAR; PG8_WAIT_L(0); PG8_MMA(0, 0, At, B0); PG8_BAR; PG8_SCHED;
            PG8_LDB(B1, 0, 1); PG8_STAGE(PG8_SB(0, 0), b2, voffB);
            PG8_BAR; PG8_WAIT_L(0); PG8_MMA(0, 1, At, B1); PG8_BAR;
            PG8_LDA(At, 0, 1); PG8_STAGE(PG8_SA(0, 0), a2, voffA);
            PG8_BAR; PG8_WAIT_L(0); PG8_MMA(1, 0, At, B0); PG8_BAR; PG8_SCHED;
            PG8_STAGE(PG8_SB(0, 1), b2 + hstep, voffB);
            PG8_WAIT_V(6); PG8_BAR; PG8_MMA(1, 1, At, B1); PG8_BAR;
            PG8_LDB(B0, 1, 0); PG8_SCHED; PG8_LDA(At, 1, 0); PG8_STAGE(PG8_SA(0, 1), a2 + hstep, voffA);
            PG8_WAIT_L(8); PG8_BAR; PG8_WAIT_L(0); PG8_MMA(0, 0, At, B0); PG8_BAR; PG8_SCHED;
            PG8_LDB(B1, 1, 1); PG8_STAGE(PG8_SB(1, 0), b3, voffB);
            PG8_BAR; PG8_WAIT_L(0); PG8_MMA(0, 1, At, B1); PG8_BAR;
            PG8_LDA(At, 1, 1); PG8_STAGE(PG8_SA(1, 0), a3, voffA);
            PG8_BAR; PG8_WAIT_L(0); PG8_MMA(1, 0, At, B0); PG8_BAR; PG8_SCHED;
            PG8_STAGE(PG8_SB(1, 1), b3 + hstep, voffB);
            PG8_WAIT_V(6); PG8_BAR; PG8_MMA(1, 1, At, B1); PG8_BAR;
            }
        }
        if constexpr (ALIGN_EPI) { if (wr == 0) PG8_BAR; }
        if constexpr (!Epi::AFTER_DRAIN) { E(acc, cur, wr, wc, fr, fq); S.done(cur); }
        if (!has_next) break;
#pragma unroll
        for (int a = 0; a < 2; ++a)
#pragma unroll
            for (int b = 0; b < 2; ++b)
#pragma unroll
                for (int m = 0; m < 4; ++m)
#pragma unroll
                    for (int n = 0; n < 2; ++n) acc[a][b][m][n] = (f32x4){0.f, 0.f, 0.f, 0.f};
        cur = nxt; cA = nA; cB = nB; ++ui;
        if constexpr (ALIGN_EPI) { if (wr == 1) PG8_BAR; }
    }
    PG8_WAIT_V(0);
    if constexpr (!ALIGN_EPI) { if (wr == 0) PG8_BAR; }
    PG8_BAR;
    if constexpr (Epi::AFTER_DRAIN) { E.fused(acc, cur, wr, wc, fr, fq, lds, wid, lane); S.done(cur); }
#undef PG8_SA
#undef PG8_SB
#undef PG8_STAGE
#undef PG8_LDA
#undef PG8_LDB
#undef PG8_MMA
#undef PG8_WAIT_V
#undef PG8_WAIT_L
#undef PG8_BAR
#undef PG8_SCHED
}
}
namespace cg = cooperative_groups;
#define LAS __attribute__((address_space(3)))
typedef unsigned short bf16;
using pg8::f32x4; using pg8::bf16x8; using pg8::u32x4; using pg8::u32x2; using pg8::cvt_pk_bf16; using pg8::bf2f;
typedef float f32x16 __attribute__((ext_vector_type(16)));
typedef short s16x4 __attribute__((ext_vector_type(4)));
using pg8::TOK; using pg8::KSEQ; using pg8::KOFF;
constexpr int NB = 8, M = NB * TOK, D = 2048, NIN = 10048, NINP = 10240, NPOS = 4112;
constexpr int NWAVES = 8, NTHR = 512, LDS_BYTES = 147456, QWORD_OFF = 147200;
constexpr int NMP = 2368;
constexpr float NORM_EPS = 1e-6f, GN_EPS = 1e-5f;

struct Args { const float* in[14]; float* out; unsigned char* ws; };

__device__ __forceinline__ unsigned f2bf(float f) { unsigned u = __float_as_uint(f); return (u + 0x7fffu + ((u >> 16) & 1u)) >> 16; }
__device__ __forceinline__ unsigned pk2(float lo, float hi) { return f2bf(lo) | (f2bf(hi) << 16); }
__device__ __forceinline__ float wave_sum(float v) {
#pragma unroll
    for (int o = 1; o < 64; o <<= 1) v += __shfl_xor(v, o);
    return v;
}
__device__ __forceinline__ float head_lg2(int h) { return pg8::head_lg2(h); }

__device__ __forceinline__ int src_in(int n) {
    if (n < 768) return n;
    if (n < 1024) { const int p = n - 768; if (p >= 64) return -1; const int wc = p >> 5, fq = (p >> 3) & 3, nn = (p >> 2) & 1, i = p & 3; return 768 + 32 * nn + 16 * wc + 4 * fq + i; }
    if (n < 2048) return 832 + (n - 1024);
    if (n < 4096) { const int q = n - 2048, hb = q >> 7, p = q & 127, wc = p >> 5, fq = (p >> 3) & 3, nn = (p >> 2) & 1, i = p & 3; return 1856 + hb * 128 + 64 * nn + 16 * wc + 4 * fq + i; }
    if (n < 6144) return 3904 + (n - 4096);
    return 5952 + (n - 6144);
}
__device__ __forceinline__ int src_uq(int n) {
    if (n < 1024) return (n >> 7) * 192 + (n & 127);
    const int q = n - 1024, blk = q >> 7, p = q & 127, wc = p >> 5, fq = (p >> 3) & 3, nn = (p >> 2) & 1, i = p & 3;
    return (2 * blk + (wc >> 1)) * 192 + 128 + 32 * nn + 16 * (wc & 1) + 4 * fq + i;
}
template <int KIND> __device__ __forceinline__ void p0_item(const float* W, int ldw, int K, bf16* WT, const float* ksc, int item, int nblk, LAS float* scr, int lane) {
    const int kb = item / nblk, nb = item % nblk, k0 = 64 * kb, n0 = 32 * nb, nl = lane & 31;
    int sc;
    if (KIND == 0) sc = n0 + nl; else if (KIND == 1) sc = src_in(n0 + nl); else if (KIND == 2) sc = src_uq(n0 + nl);
    else if (KIND == 3) sc = ((n0 + nl) >> 7) * 256 + ((n0 + nl) & 127); else sc = ((n0 + nl) >> 7) * 256 + 128 + ((n0 + nl) & 127);
#pragma unroll 16
    for (int i = 0; i < 32; ++i) { const int kk = 2 * i + (lane >> 5); float v = sc >= 0 ? W[(size_t)(k0 + kk) * ldw + sc] : 0.f; if (ksc) v *= ksc[k0 + kk]; scr[kk * 33 + nl] = v; }
    asm volatile("s_waitcnt lgkmcnt(0)" ::: "memory");
    const int c = lane & 7;
#pragma unroll
    for (int j = 0; j < 4; ++j) { const int n = (lane >> 3) + 8 * j; const LAS float* s = scr + (8 * c) * 33 + n;
        u32x4 o; o.x = pk2(s[0 * 33], s[1 * 33]); o.y = pk2(s[2 * 33], s[3 * 33]); o.z = pk2(s[4 * 33], s[5 * 33]); o.w = pk2(s[6 * 33], s[7 * 33]);
        *(u32x4*)(WT + (size_t)(n0 + n) * K + k0 + 8 * c) = o; }
    asm volatile("s_waitcnt lgkmcnt(0)" ::: "memory");
}

struct Ptrs {
    const Args* a; unsigned char* ws;
    __device__ __forceinline__ const float* x() const { return a->in[0]; }
    __device__ __forceinline__ const float* meta() const { return a->in[1]; }
    __device__ __forceinline__ const float* norm_w() const { return a->in[2]; }
    __device__ __forceinline__ const float* w_in() const { return a->in[3]; }
    __device__ __forceinline__ const float* qnw() const { return a->in[4]; }
    __device__ __forceinline__ const float* w_uq() const { return a->in[5]; }
    __device__ __forceinline__ const float* kvnw() const { return a->in[6]; }
    __device__ __forceinline__ const float* w_ukv() const { return a->in[7]; }
    __device__ __forceinline__ const float* gnw() const { return a->in[8]; }
    __device__ __forceinline__ const float* gnb() const { return a->in[9]; }
    __device__ __forceinline__ const float* w_bm() const { return a->in[10]; }
    __device__ __forceinline__ const float* w_br() const { return a->in[11]; }
    __device__ __forceinline__ const float* w_out() const { return a->in[12]; }
    __device__ __forceinline__ const float* fnw() const { return a->in[13]; }
    __device__ __forceinline__ float* out() const { return a->out; }
    __device__ __forceinline__ bf16* WIN() const { return (bf16*)(ws + WS_WIN); }
    __device__ __forceinline__ bf16* WUQ() const { return (bf16*)(ws + WS_WUQ); }
    __device__ __forceinline__ bf16* WUK() const { return (bf16*)(ws + WS_WUK); }
    __device__ __forceinline__ bf16* WUV() const { return (bf16*)(ws + WS_WUV); }
    __device__ __forceinline__ bf16* WB2() const { return (bf16*)(ws + WS_WB2); }
    __device__ __forceinline__ bf16* WOUT() const { return (bf16*)(ws + WS_WOUT); }
    __device__ __forceinline__ bf16* KR() const { return (bf16*)(ws + WS_KR); }
    __device__ __forceinline__ bf16* XN() const { return (bf16*)(ws + WS_XN); }
    __device__ __forceinline__ bf16* QN() const { return (bf16*)(ws + WS_QN); }
    __device__ __forceinline__ bf16* QR() const { return (bf16*)(ws + WS_QR); }
    __device__ __forceinline__ bf16* CQ() const { return (bf16*)(ws + WS_CQ); }
    __device__ __forceinline__ bf16* CKV() const { return (bf16*)(ws + WS_CKV); }
    __device__ __forceinline__ bf16* ZMLA() const { return (bf16*)(ws + WS_ZMLA); }
    __device__ __forceinline__ bf16* RQ() const { return (bf16*)(ws + WS_RQ); }
    __device__ __forceinline__ bf16* RK() const { return (bf16*)(ws + WS_RK); }
    __device__ __forceinline__ bf16* MG() const { return (bf16*)(ws + WS_MG); }
    __device__ __forceinline__ bf16* RV() const { return (bf16*)(ws + WS_RV); }
    __device__ __forceinline__ bf16* ZRET() const { return (bf16*)(ws + WS_ZRET); }
    __device__ __forceinline__ bf16* GATES() const { return (bf16*)(ws + WS_GATES); }
    __device__ __forceinline__ bf16* KN() const { return (bf16*)(ws + WS_KN); }
    __device__ __forceinline__ bf16* VT() const { return (bf16*)(ws + WS_VT); }
    __device__ __forceinline__ float* C128() const { return (float*)(ws + WS_C128); }
    __device__ __forceinline__ float* S128() const { return (float*)(ws + WS_S128); }
    __device__ __forceinline__ float* C64() const { return (float*)(ws + WS_C64); }
    __device__ __forceinline__ float* S64() const { return (float*)(ws + WS_S64); }
    __device__ __forceinline__ float* MP() const { return (float*)(ws + WS_MP); }
    __device__ __forceinline__ float* R0() const { return (float*)(ws + WS_R0); }
    __device__ __forceinline__ float* SSQQ() const { return (float*)(ws + WS_SSQQ); }
    __device__ __forceinline__ float* SSQKV() const { return (float*)(ws + WS_SSQKV); }
    __device__ __forceinline__ float* SSQO() const { return (float*)(ws + WS_SSQO); }
    __device__ __forceinline__ unsigned* ctl() const { return (unsigned*)(ws + WS_CTL); }
};

__device__ __forceinline__ void p0_prologue(const Ptrs& P, LAS unsigned char* lds, int tid, int lane, int wave) {
    const int G = gridDim.x, bx = blockIdx.x;
    const int gtid = bx * NTHR + tid, NT = G * NTHR;
    for (int i = gtid; i < 3456  ; i += NT) P.ctl()[4096 + i] = 0u;
    if (gtid < 32) P.ctl()[64 * gtid] = 0u;
    for (int i = gtid; i < NB * 48 * 512; i += NT) { const int b = i / (48 * 512), r = i % (48 * 512); ((unsigned*)(P.KN() + (size_t)b * KSEQ * 1024))[r] = 0u; }
    for (int i = gtid; i < NB * 48 * 32; i += NT) { const int b = i / (48 * 32), r = i % (48 * 32); ((unsigned*)(P.KR() + (size_t)b * KSEQ * 64))[r] = 0u; }
    for (int i = gtid; i < 1024 * NB * 24; i += NT) { const int row = i / (NB * 24), r = i % (NB * 24), b = r / 24, c = r % 24; ((unsigned*)(P.VT() + (size_t)row * (NB * KSEQ) + b * KSEQ))[c] = 0u; }
    for (int i = gtid; i < NPOS * 96; i += NT) { const int pos = i / 96, j = i % 96;
        const double e = j < 64 ? (double)j / 64.0 : (double)(j - 64) / 32.0;
        const float inv = (float)exp2(-e * 13.287712379549449); const float ang = (float)pos * inv;
        const double rev = (double)ang * 0.15915494309189535; const float a = (float)((rev - rint(rev)) * 6.283185307179586);
        const float c = cosf(a), s = sinf(a);
        if (j < 64) { P.C128()[pos * 64 + j] = c; P.S128()[pos * 64 + j] = s; } else { P.C64()[pos * 32 + j - 64] = c; P.S64()[pos * 32 + j - 64] = s; } }
    if (bx < NMP / 16) {
        LAS float* mx = (LAS float*)lds;
        for (int rr = 0; rr < 2; ++rr) { const int row = 2 * wave + rr; f32x4 v[8]; float ss = 0.f;
#pragma unroll
            for (int j = 0; j < 8; ++j) { v[j] = *(const f32x4*)(P.meta() + (size_t)row * D + 4 * lane + 256 * j); ss += (v[j][0] * v[j][0] + v[j][1] * v[j][1]) + (v[j][2] * v[j][2] + v[j][3] * v[j][3]); }
            const float rs = 1.0f / sqrtf(wave_sum(ss) * (1.f / D) + NORM_EPS);
#pragma unroll
            for (int j = 0; j < 8; ++j) { const f32x4 w = *(const f32x4*)(P.norm_w() + 4 * lane + 256 * j); *(LAS f32x4*)(mx + row * D + 4 * lane + 256 * j) = v[j] * rs * w; } }
        __syncthreads();
        const int c16 = lane & 15, ks = lane >> 4, q = 16 * bx + c16, orig = q < 320 ? 512 + q : 2880 + (q - 320);
        float acc[16];
#pragma unroll
        for (int i = 0; i < 16; ++i) acc[i] = 0.f;
        const float* wp = P.w_in() + (size_t)(256 * wave + ks) * NIN + orig;
#pragma unroll 8
        for (int j = 0; j < 64; ++j) { const float wv = wp[(size_t)(4 * j) * NIN]; const int k = 256 * wave + 4 * j + ks;
#pragma unroll
            for (int i = 0; i < 16; ++i) acc[i] += mx[i * D + k] * wv; }
#pragma unroll
        for (int i = 0; i < 16; ++i) { acc[i] += __shfl_xor(acc[i], 16); acc[i] += __shfl_xor(acc[i], 32); }
        __syncthreads();
        LAS float* red = (LAS float*)lds;
        if (ks == 0) {
#pragma unroll
            for (int i = 0; i < 16; ++i) red[(wave * 16 + i) * 16 + c16] = acc[i]; }
        __syncthreads();
        if (tid < 256) { float sum = 0.f;
#pragma unroll
            for (int w = 0; w < 8; ++w) sum += red[w * 256 + tid];
            P.MP()[(tid >> 4) * NMP + 16 * bx + (tid & 15)] = sum; }
        __syncthreads();
    }
    LAS float* scr = (LAS float*)(lds + wave * 16384);
    const int gw = bx * NWAVES + wave, NGW = G * NWAVES;
    constexpr int I_IN = 32 * 320, I_UQ = 8 * 48, I_UK = 4 * 32, I_B = 16 * 64, I_O = 32 * 64;
    constexpr int NITEMS = I_IN + I_UQ + 2 * I_UK + 2 * I_B + I_O;
    for (int it = gw; it < NITEMS; it += NGW) { int r = it;
        if (r < I_IN) { p0_item<1>(P.w_in(), NIN, D, P.WIN(), nullptr, r, 320, scr, lane); continue; } r -= I_IN;
        if (r < I_UQ) { p0_item<2>(P.w_uq(), 1536, 512, P.WUQ(), P.qnw(), r, 48, scr, lane); continue; } r -= I_UQ;
        if (r < I_UK) { p0_item<3>(P.w_ukv(), 2048, 256, P.WUK(), P.kvnw(), r, 32, scr, lane); continue; } r -= I_UK;
        if (r < I_UK) { p0_item<4>(P.w_ukv(), 2048, 256, P.WUV(), P.kvnw(), r, 32, scr, lane); continue; } r -= I_UK;
        if (r < I_B) { p0_item<0>(P.w_bm(), D, 2048, P.WB2(), nullptr, r, 64, scr, lane); continue; } r -= I_B;
        if (r < I_B) { p0_item<0>(P.w_br(), D, 2048, P.WB2() + 1024, nullptr, r, 64, scr, lane); continue; } r -= I_B;
        p0_item<0>(P.w_out(), D, D, P.WOUT(), nullptr, r, 64, scr, lane); }
    {
        f32x4 nw[8];
#pragma unroll
        for (int j = 0; j < 8; ++j) nw[j] = *(const f32x4*)(P.norm_w() + 4 * lane + 256 * j);
        f32x4 v[8], u[8];
#pragma unroll
        for (int j = 0; j < 8; ++j) { v[j] = *(const f32x4*)(P.x() + (size_t)gw * D + 4 * lane + 256 * j); u[j] = *(const f32x4*)(P.x() + (size_t)(gw + NGW) * D + 4 * lane + 256 * j); }
        for (int m = gw; m < M; m += 2 * NGW) { const int m2 = m + NGW, mn = m + 2 * NGW;
            f32x4 vn[8], un[8];
            if (mn < M) {
#pragma unroll
                for (int j = 0; j < 8; ++j) { vn[j] = *(const f32x4*)(P.x() + (size_t)mn * D + 4 * lane + 256 * j); un[j] = *(const f32x4*)(P.x() + (size_t)(mn + NGW) * D + 4 * lane + 256 * j); } }
            float ss = 0.f, ss2 = 0.f;
#pragma unroll
            for (int j = 0; j < 8; ++j) { ss += (v[j][0] * v[j][0] + v[j][1] * v[j][1]) + (v[j][2] * v[j][2] + v[j][3] * v[j][3]); ss2 += (u[j][0] * u[j][0] + u[j][1] * u[j][1]) + (u[j][2] * u[j][2] + u[j][3] * u[j][3]); }
            const float rs = 1.0f / sqrtf(wave_sum(ss) * (1.f / D) + NORM_EPS), rs2 = 1.0f / sqrtf(wave_sum(ss2) * (1.f / D) + NORM_EPS);
#pragma unroll
            for (int j = 0; j < 8; ++j) { const f32x4 o = v[j] * rs * nw[j], o2 = u[j] * rs2 * nw[j];
                u32x2 pk; pk.x = pk2(o[0], o[1]); pk.y = pk2(o[2], o[3]); *(u32x2*)(P.XN() + (size_t)m * D + 4 * lane + 256 * j) = pk;
                pk.x = pk2(o2[0], o2[1]); pk.y = pk2(o2[2], o2[3]); *(u32x2*)(P.XN() + (size_t)m2 * D + 4 * lane + 256 * j) = pk; }
            if (mn < M) {
#pragma unroll
                for (int j = 0; j < 8; ++j) { v[j] = vn[j]; u[j] = un[j]; } }
        }
    }
}

__device__ __forceinline__ void meta_stage2(const Ptrs& P, int tid) {
    const int gtid = blockIdx.x * NTHR + tid, NT = gridDim.x * NTHR;
    for (int idx = gtid; idx < 8 * 128 * 128; idx += NT) { const int h = idx >> 14, d = (idx >> 7) & 127, e = idx & 127, j = d & 63; const float lg2 = head_lg2(h); float s = 0.f;
        for (int i = 0; i < 16; ++i) { const float k1 = P.MP()[i * NMP + 320 + h * 128 + j], k2 = P.MP()[i * NMP + 320 + h * 128 + j + 64], c = P.C128()[i * 64 + j], sn = P.S128()[i * 64 + j];
            const float kd = d < 64 ? k1 * c - k2 * sn : k1 * sn + k2 * c;
            s += kd * 0.08838834764831845f * exp2f(lg2 * (float)(15 - i)) * P.MP()[i * NMP + 1344 + h * 128 + e]; }
        P.R0()[idx] = s; }
    if (gtid < 32768) { const int n = gtid >> 4, ks = gtid & 15, head = n >> 8, wi = n & 255; float dot[16], ss[16];
#pragma unroll
        for (int i = 0; i < 16; ++i) { dot[i] = 0.f; ss[i] = 0.f; }
#pragma unroll 4
        for (int kk = 0; kk < 16; ++kk) { const int k = 16 * ks + kk; const float wv = P.w_ukv()[(size_t)k * 2048 + n] * P.kvnw()[k];
#pragma unroll
            for (int i = 0; i < 16; ++i) { const float c = P.MP()[i * NMP + k]; dot[i] += c * wv; ss[i] += c * c; } }
#pragma unroll
        for (int i = 0; i < 16; ++i) {
#pragma unroll
            for (int o = 1; o < 16; o <<= 1) { dot[i] += __shfl_xor(dot[i], o); ss[i] += __shfl_xor(ss[i], o); } }
        if (ks == 0) {
#pragma unroll
            for (int i = 0; i < 16; ++i) { const float v = dot[i] / sqrtf(ss[i] * (1.f / 256.f) + NORM_EPS); const bf16 bv = (bf16)f2bf(v);
                for (int b = 0; b < NB; ++b) { if (wi < 128) P.KN()[(size_t)(b * KSEQ + 48 + i) * 1024 + head * 128 + wi] = bv; else P.VT()[(size_t)(head * 128 + wi - 128) * (NB * KSEQ) + b * KSEQ + 48 + ((i & 3) | ((i & 4) << 1) | ((i & 8) >> 1))] = bv; } } }
    } else if (gtid < 32768 + 512) { const int idx = gtid - 32768, i = idx >> 5, j = idx & 31;
        const float t1 = P.MP()[i * NMP + 256 + j], t2 = P.MP()[i * NMP + 256 + 32 + j], c = P.C64()[i * 32 + j], s = P.S64()[i * 32 + j];
        const bf16 o1 = (bf16)f2bf(t1 * c - t2 * s), o2 = (bf16)f2bf(t1 * s + t2 * c);
        for (int b = 0; b < NB; ++b) { P.KR()[(size_t)(b * KSEQ + 48 + i) * 64 + j] = o1; P.KR()[(size_t)(b * KSEQ + 48 + i) * 64 + 32 + j] = o2; } }
}

constexpr int AT_KB = 64 * 24 * 16, AT_VB = 128 * 8 * 16, AT_BUF = AT_KB + AT_VB;
template <int VAR> __device__ __forceinline__ void attn_unit(const Ptrs& P, LAS unsigned char* lds, int b, int h, int qb, int tid, int lane, int wave, bool do_store = true) {
    asm volatile("" : "+v"(tid), "+v"(lane));
    const int r = lane & 31, hh = lane >> 5;
    const int trow = 256 * qb + 32 * wave + r;
    const size_t row = (size_t)b * TOK + trow;
    bf16x8 qf[12];
#pragma unroll
    for (int s = 0; s < 8; ++s) qf[s] = *(const bf16x8*)(P.QN() + row * 1024 + h * 128 + 16 * s + 8 * hh);
#pragma unroll
    for (int s = 0; s < 4; ++s) qf[8 + s] = *(const bf16x8*)(P.QR() + row * 512 + h * 64 + 16 * s + 8 * hh);
    const int ntiles = 4 * qb + 5, kt_last = 4 * qb + 1 + (wave >> 1);
    f32x16 o[4];
#pragma unroll
    for (int e = 0; e < 4; ++e)
#pragma unroll
        for (int i = 0; i < 16; ++i) o[e][i] = 0.f;
    float mrun = -1e30f, lsum = 0.f;
    const char* kbase = (const char*)(P.KN() + (size_t)b * KSEQ * 1024 + h * 128); const char* rbase = (const char*)(P.KR() + (size_t)b * KSEQ * 64);
    const char* vbase = (const char*)(P.VT() + (size_t)(h * 128) * (NB * KSEQ) + (size_t)b * KSEQ);
    const char* ksrc[3]; unsigned kstr[3]; const char* vsrc[2];
#pragma unroll
    for (int i = 0; i < 3; ++i) { const int q = (3 * wave + i) * 64 + lane, key = q / 24, cc = (q % 24) ^ ((key >> 1) & 7);
        ksrc[i] = cc < 16 ? kbase + (size_t)key * 2048 + cc * 16 : rbase + (size_t)key * 128 + (cc - 16) * 16; kstr[i] = cc < 16 ? 64u * 2048u : 64u * 128u; }
#pragma unroll
    for (int i = 0; i < 2; ++i) { const int q = (2 * wave + i) * 64 + lane, e = q >> 3, cc = (q & 7) ^ ((e >> 1) & 7); vsrc[i] = vbase + (size_t)e * (NB * KSEQ * 2) + cc * 16; }
#define AT_ISSUE(kt, slot) do { LAS unsigned char* kb_ = lds + (slot) * AT_BUF; \
        _Pragma("unroll") for (int i = 0; i < 3; ++i) __builtin_amdgcn_global_load_lds((const unsigned*)(ksrc[i] + (size_t)(kt) * kstr[i]), (LAS unsigned*)(kb_ + (3 * wave + i) * 1024), 16, 0, 0); \
        _Pragma("unroll") for (int i = 0; i < 2; ++i) __builtin_amdgcn_global_load_lds((const unsigned*)(vsrc[i] + (size_t)(kt) * 128), (LAS unsigned*)(kb_ + AT_KB + (2 * wave + i) * 1024), 16, 0, 0); } while (0)
    const int swz = (r >> 1) & 7;
    const unsigned lbase = (unsigned)(unsigned long long)lds;
    asm volatile("s_waitcnt vmcnt(0)" ::: "memory");
    __builtin_amdgcn_s_barrier();
    if (!(VAR & 16)) { AT_ISSUE(0, 0); AT_ISSUE(1, 1); }
#define DSR128(dst, addr, off) asm volatile("ds_read_b128 %0, %1 offset:%2" : "=v"(dst) : "v"(addr), "n"(off))
#define LGKM2(n, a, b) asm volatile("s_waitcnt lgkmcnt(" #n ")" : "+v"(a), "+v"(b))
#define LGKM4(n, a, b, c, d) asm volatile("s_waitcnt lgkmcnt(" #n ")" : "+v"(a), "+v"(b), "+v"(c), "+v"(d))
#define KREAD(s_) do { DSR128(kr[(s_) % 3][0], kad[(s_) & 3], ((s_) >> 2) * 128); DSR128(kr[(s_) % 3][1], kad[(s_) & 3], ((s_) >> 2) * 128 + 12288); } while (0)
#define VREAD(s2_) do { DSR128(vr[(s2_) & 1][0], vad[s2_], 0); DSR128(vr[(s2_) & 1][1], vad[s2_], 4096); DSR128(vr[(s2_) & 1][2], vad[s2_], 8192); DSR128(vr[(s2_) & 1][3], vad[s2_], 12288); } while (0)
#define QKSTEP(s_, n_) do { if ((s_) + 2 < 12) KREAD((s_) + 2); LGKM2(n_, kr[(s_) % 3][0], kr[(s_) % 3][1]); \
        p0 = __builtin_amdgcn_mfma_f32_32x32x16_bf16(kr[(s_) % 3][0], qf[s_], p0, 0, 0, 0); p1 = __builtin_amdgcn_mfma_f32_32x32x16_bf16(kr[(s_) % 3][1], qf[s_], p1, 0, 0, 0); } while (0)
#define PVSTEP(s2_, n_, pw_) do { LGKM4(n_, vr[(s2_) & 1][0], vr[(s2_) & 1][1], vr[(s2_) & 1][2], vr[(s2_) & 1][3]); const bf16x8 pb_ = __builtin_bit_cast(bf16x8, pw_); \
        _Pragma("unroll") for (int e = 0; e < 4; ++e) o[e] = __builtin_amdgcn_mfma_f32_32x32x16_bf16(vr[(s2_) & 1][e], pb_, o[e], 0, 0, 0); \
        if ((s2_) + 2 < 4) VREAD((s2_) + 2); } while (0)
#define AT_TILE(kt, SLOT) do { \
        if (kt + 1 < ntiles) asm volatile("s_waitcnt vmcnt(5)" ::: "memory"); else asm volatile("s_waitcnt vmcnt(0)" ::: "memory"); \
        __builtin_amdgcn_s_barrier(); \
        asm volatile("" ::: "memory"); \
        if (kt + 2 < ntiles && !(VAR & 16)) AT_ISSUE(kt + 2, (SLOT + 2) % 3); \
        if (kt <= kt_last && !(VAR & 8)) { \
            unsigned kad[4], vad[4]; \
            _Pragma("unroll") for (int t = 0; t < 4; ++t) { kad[t] = lbase + (SLOT) * AT_BUF + r * 384 + (((2 * t + hh) ^ swz) * 16); vad[t] = lbase + (SLOT) * AT_BUF + AT_KB + r * 128 + (((2 * t + hh) ^ swz) * 16); } \
            bf16x8 kr[3][2], vr[2][4]; \
            f32x16 p0, p1; \
            _Pragma("unroll") for (int i = 0; i < 16; ++i) { p0[i] = 0.f; p1[i] = 0.f; } \
            KREAD(0); KREAD(1); \
            if (!(VAR & 4)) { QKSTEP(0, 4); QKSTEP(1, 4); QKSTEP(2, 4); QKSTEP(3, 4); QKSTEP(4, 4); QKSTEP(5, 4); QKSTEP(6, 4); QKSTEP(7, 4); QKSTEP(8, 4); QKSTEP(9, 4); QKSTEP(10, 2); QKSTEP(11, 0); } else { LGKM2(0, kr[0][0], kr[0][1]); LGKM2(0, kr[1][0], kr[1][1]); p0[0] = __builtin_bit_cast(float, kr[0][0][0] + kr[1][0][0]); p1[0] = __builtin_bit_cast(float, (int)kr[0][1][0] + (int)kr[1][1][0]); } \
            VREAD(0); VREAD(1); \
            if (kt == 0 || kt >= 4 * qb + 1) { \
                const int kmax = KOFF + trow, k0 = 64 * kt + 4 * hh; \
                _Pragma("unroll") for (int i = 0; i < 16; ++i) { const int kk = k0 + (i & 3) + 8 * (i >> 2); if (kk < 48 || kk > kmax) p0[i] = -1e30f; if (kk + 32 < 48 || kk + 32 > kmax) p1[i] = -1e30f; } \
            } \
            float mx = fmaxf(p0[0], p1[0]); \
            _Pragma("unroll") for (int i = 1; i < 16; ++i) mx = fmaxf(mx, fmaxf(p0[i], p1[i])); \
            mx = fmaxf(mx, __shfl_xor(mx, 32)); \
            if (__builtin_amdgcn_ballot_w64(mx > mrun + 8.f) != 0ull) {     \
                const float mnew = mx > mrun + 8.f ? mx : mrun, alpha = __builtin_amdgcn_exp2f(mrun - mnew); mrun = mnew; lsum *= alpha; \
                _Pragma("unroll") for (int e = 0; e < 4; ++e) \
                    _Pragma("unroll") for (int i = 0; i < 16; ++i) o[e][i] *= alpha; \
            } \
            float ps = 0.f; \
            _Pragma("unroll") for (int i = 0; i < 16; ++i) { if (VAR & 1) { p0[i] = p0[i] - mrun; p1[i] = p1[i] - mrun; } else { p0[i] = __builtin_amdgcn_exp2f(p0[i] - mrun); p1[i] = __builtin_amdgcn_exp2f(p1[i] - mrun); } ps += p0[i] + p1[i]; } \
            lsum += ps; \
            u32x4 pw0, pw1, pw2, pw3; \
            pw0.x = cvt_pk_bf16(p0[0], p0[1]); pw0.y = cvt_pk_bf16(p0[2], p0[3]); pw0.z = cvt_pk_bf16(p0[4], p0[5]); pw0.w = cvt_pk_bf16(p0[6], p0[7]); \
            pw1.x = cvt_pk_bf16(p0[8], p0[9]); pw1.y = cvt_pk_bf16(p0[10], p0[11]); pw1.z = cvt_pk_bf16(p0[12], p0[13]); pw1.w = cvt_pk_bf16(p0[14], p0[15]); \
            pw2.x = cvt_pk_bf16(p1[0], p1[1]); pw2.y = cvt_pk_bf16(p1[2], p1[3]); pw2.z = cvt_pk_bf16(p1[4], p1[5]); pw2.w = cvt_pk_bf16(p1[6], p1[7]); \
            pw3.x = cvt_pk_bf16(p1[8], p1[9]); pw3.y = cvt_pk_bf16(p1[10], p1[11]); pw3.z = cvt_pk_bf16(p1[12], p1[13]); pw3.w = cvt_pk_bf16(p1[14], p1[15]); \
            if (!(VAR & 2)) { PVSTEP(0, 4, pw0); PVSTEP(1, 4, pw1); PVSTEP(2, 4, pw2); PVSTEP(3, 0, pw3); } else { LGKM4(0, vr[0][0], vr[0][1], vr[0][2], vr[0][3]); LGKM4(0, vr[1][0], vr[1][1], vr[1][2], vr[1][3]); o[0][0] += __builtin_bit_cast(float, pw0.x ^ pw1.y ^ pw2.z ^ pw3.w) + __builtin_bit_cast(float, (int)vr[0][0][0] + (int)vr[1][1][0]); } \
        } \
    } while (0)
    if (wave >= 4) __builtin_amdgcn_s_setprio(1);
    for (int kt0 = 0; kt0 < ntiles; kt0 += 3) {
        { const int kt = kt0; AT_TILE(kt, 0); }
        if (kt0 + 1 < ntiles) { const int kt = kt0 + 1; AT_TILE(kt, 1); }
        if (kt0 + 2 < ntiles) { const int kt = kt0 + 2; AT_TILE(kt, 2); }
    }
#undef AT_TILE
    __builtin_amdgcn_s_setprio(0);
#undef DSR128
#undef LGKM2
#undef LGKM4
#undef KREAD
#undef VREAD
#undef QKSTEP
#undef PVSTEP
#undef AT_ISSUE
    const float inv = 1.0f / (lsum + __shfl_xor(lsum, 32));
    bf16* yrow = P.ZMLA() + row * 2048 + h * 128;
    u32x2 zz[4][4];
#pragma unroll
    for (int e = 0; e < 4; ++e)
#pragma unroll
        for (int g = 0; g < 4; ++g) zz[e][g] = *(const u32x2*)(yrow + 32 * e + 8 * g + 4 * hh);
    asm volatile("" ::: "memory");
#pragma unroll
    for (int e = 0; e < 4; ++e)
#pragma unroll
        for (int g = 0; g < 4; ++g) { bf16* p = yrow + 32 * e + 8 * g + 4 * hh; const u32x2 z = zz[e][g];
            const float z0 = __uint_as_float(z.x << 16), z1 = __uint_as_float(z.x & 0xffff0000u), z2 = __uint_as_float(z.y << 16), z3 = __uint_as_float(z.y & 0xffff0000u);
            u32x2 w; w.x = cvt_pk_bf16(o[e][4 * g] * inv * z0, o[e][4 * g + 1] * inv * z1); w.y = cvt_pk_bf16(o[e][4 * g + 2] * inv * z2, o[e][4 * g + 3] * inv * z3); if (do_store) *(u32x2*)p = w; }
}

constexpr int RT_S = 272, RT_T = 128 * RT_S;
typedef short v4i16_t __attribute__((ext_vector_type(4)));
__device__ __forceinline__ s16x4 tr_read(const LAS unsigned char* p) { return __builtin_bit_cast(s16x4, __builtin_amdgcn_ds_read_tr16_b64_v4i16((LAS v4i16_t*)p)); }
__device__ __forceinline__ void ret_unit(const Ptrs& P, LAS unsigned char* lds, int b, int h, int tid, int lane, int wave, bool do_store = true) {
    asm volatile("" : "+v"(tid), "+v"(lane));
    const int c16 = lane & 15, q4 = lane >> 4, tq = c16 >> 2, tp = c16 & 3;
    LAS unsigned char* Ks = lds; LAS unsigned char* Vs = lds + RT_T; LAS unsigned char* Ps = lds + 2 * RT_T; LAS unsigned char* RTs = lds + 3 * RT_T;
    const float lg2 = head_lg2(h), G = exp2f(lg2 * 128.f);
    f32x4 R[8];
#pragma unroll
    for (int eb = 0; eb < 8; ++eb)
#pragma unroll
        for (int i = 0; i < 4; ++i) R[eb][i] = P.R0()[(h * 128 + 16 * wave + 4 * q4 + i) * 128 + 16 * eb + c16];
    __syncthreads();
#pragma unroll
    for (int eb = 0; eb < 8; ++eb) { u32x2 w; w.x = cvt_pk_bf16(R[eb][0], R[eb][1]); w.y = cvt_pk_bf16(R[eb][2], R[eb][3]); *(LAS u32x2*)(RTs + (16 * eb + c16) * RT_S + (16 * wave + 4 * q4) * 2) = w; }
    float rowfac[4], xi[4];
#pragma unroll
    for (int i = 0; i < 4; ++i) { const int n = 16 * wave + 4 * q4 + i; rowfac[i] = exp2f(lg2 * (float)(n - 127)); xi[i] = exp2f(lg2 * (float)(n + 1)); }
    float gw[8], gb[8];
#pragma unroll
    for (int eb = 0; eb < 8; ++eb) { gw[eb] = P.gnw()[h * 128 + 16 * eb + c16]; gb[eb] = P.gnb()[h * 128 + 16 * eb + c16]; }
    for (int ch = 0; ch < 32; ++ch) {
        const size_t row0 = (size_t)b * TOK + 128 * ch;
#pragma unroll
        for (int i = 0; i < 4; ++i) { const int id = tid + 512 * i, m = id >> 4, cc = id & 15;
            *(LAS u32x4*)(Ks + m * RT_S + cc * 16) = *(const u32x4*)(P.RK() + (row0 + m) * 1024 + h * 128 + cc * 8);
            *(LAS u32x4*)(Vs + m * RT_S + cc * 16) = *(const u32x4*)(P.RV() + (row0 + m) * 1024 + h * 128 + cc * 8); }
        bf16x8 qf[4];
#pragma unroll
        for (int s = 0; s < 4; ++s) qf[s] = *(const bf16x8*)(P.RQ() + (row0 + 16 * wave + c16) * 1024 + h * 128 + 32 * s + 8 * q4);
        unsigned short zr[4][8];
#pragma unroll
        for (int i = 0; i < 4; ++i)
#pragma unroll
            for (int eb = 0; eb < 8; ++eb) zr[i][eb] = P.ZRET()[(row0 + 16 * wave + 4 * q4 + i) * 2048 + h * 128 + c16 + 16 * eb];
        __syncthreads();
        f32x4 sacc[8], oacc[8];
#pragma unroll
        for (int mb = 0; mb < 8; ++mb) { f32x4 a = {0.f, 0.f, 0.f, 0.f}, c = {0.f, 0.f, 0.f, 0.f};
#pragma unroll
            for (int s = 0; s < 4; ++s) { const bf16x8 kf = *(const LAS bf16x8*)(Ks + (16 * mb + c16) * RT_S + (32 * s + 8 * q4) * 2), rf = *(const LAS bf16x8*)(RTs + (16 * mb + c16) * RT_S + (32 * s + 8 * q4) * 2);
                a = __builtin_amdgcn_mfma_f32_16x16x32_bf16(qf[s], kf, a, 0, 0, 0); c = __builtin_amdgcn_mfma_f32_16x16x32_bf16(qf[s], rf, c, 0, 0, 0); }
            sacc[mb] = a; oacc[mb] = c; }
#pragma unroll
        for (int mb = 0; mb < 8; ++mb)
#pragma unroll
            for (int i = 0; i < 4; ++i) { const int n = 16 * wave + 4 * q4 + i, m = 16 * mb + c16; const float pv = m <= n ? sacc[mb][i] * rowfac[i] : 0.f;
                *(LAS bf16*)(Ps + n * RT_S + m * 2) = (bf16)f2bf(pv); oacc[mb][i] *= xi[i]; }
        __syncthreads();
        bf16x8 pf[4], ktf[4];
#pragma unroll
        for (int s = 0; s < 4; ++s) { pf[s] = *(const LAS bf16x8*)(Ps + (16 * wave + c16) * RT_S + (32 * s + 8 * q4) * 2);
            const s16x4 lo = tr_read(Ks + (32 * s + 8 * q4 + tq) * RT_S + (16 * wave + 4 * tp) * 2), hi = tr_read(Ks + (32 * s + 8 * q4 + 4 + tq) * RT_S + (16 * wave + 4 * tp) * 2);
            ktf[s] = __builtin_shufflevector(lo, hi, 0, 1, 2, 3, 4, 5, 6, 7); }
#pragma unroll
        for (int eb = 0; eb < 8; ++eb) { f32x4 kv = {0.f, 0.f, 0.f, 0.f};
#pragma unroll
            for (int s = 0; s < 4; ++s) { const s16x4 lo = tr_read(Vs + (32 * s + 8 * q4 + tq) * RT_S + (16 * eb + 4 * tp) * 2), hi = tr_read(Vs + (32 * s + 8 * q4 + 4 + tq) * RT_S + (16 * eb + 4 * tp) * 2);
                const bf16x8 vf = __builtin_shufflevector(lo, hi, 0, 1, 2, 3, 4, 5, 6, 7);
                oacc[eb] = __builtin_amdgcn_mfma_f32_16x16x32_bf16(pf[s], vf, oacc[eb], 0, 0, 0); kv = __builtin_amdgcn_mfma_f32_16x16x32_bf16(ktf[s], vf, kv, 0, 0, 0); }
            R[eb] = R[eb] * G + kv;
            u32x2 w; w.x = cvt_pk_bf16(R[eb][0], R[eb][1]); w.y = cvt_pk_bf16(R[eb][2], R[eb][3]); *(LAS u32x2*)(RTs + (16 * eb + c16) * RT_S + (16 * wave + 4 * q4) * 2) = w; }
#pragma unroll
        for (int i = 0; i < 4; ++i) { float s = 0.f;
#pragma unroll
            for (int eb = 0; eb < 8; ++eb) s += oacc[eb][i];
            s += __shfl_xor(s, 1); s += __shfl_xor(s, 2); s += __shfl_xor(s, 4); s += __shfl_xor(s, 8);
            const float mu = s * (1.f / 128.f); float v = 0.f;
#pragma unroll
            for (int eb = 0; eb < 8; ++eb) { const float d = oacc[eb][i] - mu; v += d * d; }
            v += __shfl_xor(v, 1); v += __shfl_xor(v, 2); v += __shfl_xor(v, 4); v += __shfl_xor(v, 8);
            const float rstd = 1.0f / sqrtf(v * (1.f / 128.f) + GN_EPS);
            bf16* yr = P.ZRET() + (row0 + 16 * wave + 4 * q4 + i) * 2048 + h * 128 + c16;
#pragma unroll
            for (int eb = 0; eb < 8; ++eb) { const float z = bf2f(zr[i][eb]); const bf16 yv = (bf16)f2bf(((oacc[eb][i] - mu) * rstd * gw[eb] + gb[eb]) * z); if (do_store) yr[16 * eb] = yv; } }
        __syncthreads();
    }
}

#define RLX_AGENT __ATOMIC_RELAXED, __HIP_MEMORY_SCOPE_AGENT
#define XB_TMO      128
#define XB_XCNT(j)  (256  + 64 * (j))
#define XB_XSUB(j)  (1280 + 64 * (j))
#define XB_XGEN(j)  (2304 + 64 * (j))
#define XB_TOP      3328
#define XB_TOPGEN   3392
#define XCD_BAR_WORDS 3456
#define XB_SPIN_CAP (1u << 18)

__device__ __forceinline__ unsigned xb_ld(unsigned* p)              { return __hip_atomic_load(p, __ATOMIC_RELAXED, __HIP_MEMORY_SCOPE_AGENT); }
__device__ __forceinline__ unsigned xb_add(unsigned* p, unsigned v) { return __hip_atomic_fetch_add(p, v, __ATOMIC_RELAXED, __HIP_MEMORY_SCOPE_AGENT); }
__device__ __forceinline__ unsigned xb_xcc_id() { return (unsigned)__builtin_amdgcn_s_getreg((3 << 11) | 20) & 0xFu; }
#define XB_SPIN(cond, bar) do { unsigned _sp = 0; while (cond) { __builtin_amdgcn_s_sleep(1); \
    if ((++_sp & 255u) == 0u) { if (xb_ld(&(bar)[XB_TMO])) break; if (_sp > XB_SPIN_CAP) { atomicAdd(&(bar)[XB_TMO], 1u); break; } } } } while (0)

struct XcdBarrier {
    unsigned* bar; unsigned x;
    volatile LAS unsigned* st;
};

__device__ __forceinline__ XcdBarrier xcd_barrier_post(unsigned* bar, volatile LAS unsigned* st) {
    XcdBarrier b; b.bar = bar; b.x = xb_xcc_id(); b.st = st;
    if (threadIdx.x == 0) (void)xb_add(&bar[XB_XCNT(b.x)], 1u);
    return b;
}
__device__ __forceinline__ void xcd_barrier_complete(unsigned* bar, unsigned x, unsigned& nloc, unsigned& nx) {
    const unsigned G = gridDim.x * gridDim.y * gridDim.z;
    unsigned sum, cnt, mine, sp = 0u;
    for (;;) {
        sum = 0u; cnt = 0u; mine = 0u;
#pragma unroll
        for (unsigned j = 0; j < 16; ++j) { const unsigned c = xb_ld(&bar[XB_XCNT(j)]); sum += c; cnt += (c > 0u) ? 1u : 0u; mine = (j == x) ? c : mine; }
        if (sum == G) break;
        __builtin_amdgcn_s_sleep(1);
        if ((++sp & 255u) == 0u) { if (xb_ld(&bar[XB_TMO])) break; if (sp > XB_SPIN_CAP) { atomicAdd(&bar[XB_TMO], 1u); break; } }
    }
    nloc = mine > 0u ? mine : 1u; nx = cnt > 0u ? cnt : 1u;
}

__device__ __forceinline__ void xcd_barrier(const XcdBarrier& b) {
    asm volatile("s_waitcnt vmcnt(0)" ::: "memory");
    __syncthreads();
    if (threadIdx.x == 0) {
        unsigned* bar = b.bar;
        __builtin_amdgcn_s_waitcnt(0);
        unsigned nloc = b.st[0], nx = b.st[1];
        if (nloc == 0u) { xcd_barrier_complete(bar, b.x, nloc, nx); b.st[0] = nloc; b.st[1] = nx; }
        const unsigned old = xb_add(&bar[XB_XSUB(b.x)], 1u);
        const unsigned gen = old / nloc;
        if (old + 1u == (gen + 1u) * nloc) {
            __builtin_amdgcn_fence(__ATOMIC_RELEASE, "agent");
            asm volatile("s_waitcnt vmcnt(0)" ::: "memory");
            const unsigned og = xb_add(&bar[XB_TOP], 1u);
            const unsigned tg = og / nx;
            if (og + 1u == (tg + 1u) * nx) xb_add(&bar[XB_TOPGEN], 1u);
            else XB_SPIN(xb_ld(&bar[XB_TOPGEN]) == tg, bar);
            __builtin_amdgcn_fence(__ATOMIC_ACQUIRE, "agent");
            xb_add(&bar[XB_XGEN(b.x)], 1u);
            asm volatile("s_waitcnt vmcnt(0)" ::: "memory");
        } else {
            XB_SPIN(xb_ld(&bar[XB_XGEN(b.x)]) == gen, bar);
            __builtin_amdgcn_fence(__ATOMIC_ACQUIRE, "agent");
            asm volatile("s_waitcnt vmcnt(0)" ::: "memory");
        }
    }
    __syncthreads();
}

__device__ __forceinline__ void stagger_start(int bx, int step_ticks  , int groups) {
    const unsigned long long t0 = __builtin_amdgcn_s_memrealtime(); const unsigned long long d = (unsigned long long)((bx % groups) * step_ticks);
    while (__builtin_amdgcn_s_memrealtime() - t0 < d) __builtin_amdgcn_s_sleep(16);
}
template <int PH> __device__ __forceinline__ void run_phase(const Ptrs& P, LAS unsigned char* lds, int tid, int lane, int wave);

template <int ph_lo, int ph_hi> __global__ void __launch_bounds__(NTHR, 2) hybrid_fwd(Args args) {
    extern __shared__ __attribute__((aligned(16))) unsigned char lds_raw[];
    LAS unsigned char* lds = (LAS unsigned char*)lds_raw;
    const int tid = threadIdx.x, lane = tid & 63, wave = __builtin_amdgcn_readfirstlane(tid >> 6);
    volatile LAS unsigned* xst = (volatile LAS unsigned*)(lds + QWORD_OFF + 16);
    if (tid == 0) { xst[0] = 0u; xst[1] = 0u; }
    __syncthreads();
    XcdBarrier xbar; xbar.bar = nullptr; xbar.x = 0; xbar.st = nullptr;
    const int G = gridDim.x, bx = blockIdx.x;
    constexpr bool multi = (ph_hi - ph_lo) > 1;
#ifndef PHMASK
#define PHMASK 0x7f
#endif
#ifndef STAG1_TICKS
#define STAG1_TICKS 400
#define STAG1_GROUPS 16
#endif
#ifndef DUPMASK
#define DUPMASK 0
#endif
#define NREP(k) (((DUPMASK >> (k)) & 1) ? 2 : 1)
#define IN(k) (((PHMASK >> (k)) & 1) && ph_lo <= (k) && (k) < ph_hi)
#define PHASE_PTRS() Ptrs P; P.a = &args; P.ws = args.ws; unsigned char* ws = P.ws; (void)ws
#define SEAM(k) do { if (multi && IN((k) + 1)) { if ((k) == 0) { cg::this_grid().sync(); xbar = xcd_barrier_post((unsigned*)(args.ws + WS_CTL) + 4096, xst); } else xcd_barrier(xbar); } } while (0)

    if (IN(0)) { PHASE_PTRS(); for (int rep_ = 0; rep_ < NREP(0); ++rep_) { p0_prologue(P, lds, tid, lane, wave); __syncthreads(); } SEAM(0); }
    if (IN(1)) { PHASE_PTRS();
#if defined(PROBE_KLOOP1)
        { pg8::Gemm g{P.XN(), P.WIN(), M, NINP, D}; pg8::StaticOrder S; S.init(M, NINP, G, bx); pg8::EpiNull E{P.SSQO()};
          pg8::gemm_phase<pg8::EpiNull, pg8::StaticOrder, true, true>(lds, g, S, E); }
#endif
      for (int rep_ = 0; rep_ < NREP(1); ++rep_) {
        pg8::Gemm g{P.XN(), P.WIN(), M, NINP, D}; pg8::StaticOrder S; S.init(M, NINP, G, bx);
        pg8::EpiIn E{ws, P.SSQQ(), P.SSQKV(), P.C128(), P.S128(), P.C64(), P.S64()};
        pg8::gemm_phase<pg8::EpiIn, pg8::StaticOrder, true, true>(lds, g, S, E);
      }
        SEAM(1);
    }
    if (IN(2)) { PHASE_PTRS();
        meta_stage2(P, tid);
      for (int rep_ = 0; rep_ < NREP(2); ++rep_) {
        { pg8::Gemm g{P.CQ(), P.WUQ(), M, 1536, 512}; pg8::StaticOrder S; S.init(M, 1536, G, bx);
          pg8::EpiQ E{P.QN(), P.QR(), P.SSQQ(), P.C64(), P.S64(), 0.07216878364870322f * 1.4426950408889634f};
          pg8::gemm_phase<pg8::EpiQ, pg8::StaticOrder, true, true>(lds, g, S, E); }
        { pg8::Gemm g{P.CKV(), P.WUK(), M, 1024, 256}; pg8::StaticOrder S; S.init(M, 1024, G, bx);
          pg8::EpiK E{P.KN(), P.SSQKV()};
          pg8::gemm_phase<pg8::EpiK, pg8::StaticOrder, true, true>(lds, g, S, E); }
        { pg8::Gemm g{P.WUV(), P.CKV(), 1024, M, 256}; pg8::StaticOrder S; S.init(1024, M, G, bx);
          pg8::EpiVT E{P.VT(), P.SSQKV()};
          pg8::gemm_phase<pg8::EpiVT, pg8::StaticOrder, true, true>(lds, g, S, E); }
      }
        SEAM(2);
    }
    if (IN(3)) { PHASE_PTRS();
        volatile LAS unsigned* qw = (volatile LAS unsigned*)(lds + QWORD_OFF);
#if defined(PROBE_RET2)
        for (;;) { __syncthreads(); if (tid == 0) *qw = __hip_atomic_fetch_add(P.ctl() + 64 * 26, 1u, __ATOMIC_RELAXED, __HIP_MEMORY_SCOPE_AGENT); __syncthreads();
            const int idx = (int)__builtin_amdgcn_readfirstlane(*qw); if (idx >= 64) break; ret_unit(P, lds, idx >> 3, idx & 7, tid, lane, wave, P.ws == nullptr); }
#endif
#ifndef AT_PROBE_VAR
#define AT_PROBE_VAR 0
#endif
#if defined(PROBE_ATT2)
        for (;;) { __syncthreads(); if (tid == 0) *qw = __hip_atomic_fetch_add(P.ctl() + 64 * 27, 1u, __ATOMIC_RELAXED, __HIP_MEMORY_SCOPE_AGENT); __syncthreads();
            const int a = (int)__builtin_amdgcn_readfirstlane(*qw); if (a >= 1024) break; attn_unit<AT_PROBE_VAR>(P, lds, (a & 63) >> 3, a & 7, 15 - (a >> 6), tid, lane, wave, P.ws == nullptr); }
#endif
#ifndef NO_RET
        for (;;) {
            __syncthreads();
            if (tid == 0) *qw = __hip_atomic_fetch_add(P.ctl() + 64, 1u, __ATOMIC_RELAXED, __HIP_MEMORY_SCOPE_AGENT);
            __syncthreads();
            const int idx = (int)__builtin_amdgcn_readfirstlane(*qw);
            if (idx >= 64) break;
            ret_unit(P, lds, idx >> 3, idx & 7, tid, lane, wave);
        }
#endif
#ifndef NO_ATT
        for (;;) {
            __syncthreads();
            if (tid == 0) *qw = __hip_atomic_fetch_add(P.ctl() + 128, 1u, __ATOMIC_RELAXED, __HIP_MEMORY_SCOPE_AGENT);
            __syncthreads();
            const int a = (int)__builtin_amdgcn_readfirstlane(*qw);
            if (a >= 1024) break;
            attn_unit<0>(P, lds, (a & 63) >> 3, a & 7, 15 - (a >> 6), tid, lane, wave);
        }
#endif
        SEAM(3);
    }
    if (IN(4)) { PHASE_PTRS();
        { pg8::Gemm g{P.ZMLA(), P.WB2(), M, D, 2048}; pg8::StaticOrder S; S.init(M, D, G, bx);
          pg8::EpiMerge2 E{P.MG(), P.GATES()};
          pg8::gemm_phase<pg8::EpiMerge2, pg8::StaticOrder, true, true>(lds, g, S, E); }
        SEAM(4);
    }
    if (IN(5)) { PHASE_PTRS();
      for (int rep_ = 0; rep_ < NREP(5); ++rep_) {
        pg8::Gemm g{P.MG(), P.WOUT(), M, D, D}; pg8::StaticOrder S; S.init(M, D, G, bx);
        pg8::EpiOut E{P.XN()};
        pg8::gemm_phase<pg8::EpiOut, pg8::StaticOrder, true, true>(lds, g, S, E);
#if defined(PROBE_DUP5)
        { pg8::Gemm g{P.MG(), P.WOUT(), M, D, D}; pg8::StaticOrder S; S.init(M, D, G, bx);
        pg8::EpiOut E{P.XN()};
        pg8::gemm_phase<pg8::EpiOut, pg8::StaticOrder, true, true>(lds, g, S, E); }
#endif
      }
        SEAM(5);
    }
    if (IN(6)) { PHASE_PTRS();
        const int gw = bx * NWAVES + wave, NGW = G * NWAVES;
        f32x4 fw[8];
#pragma unroll
        for (int j = 0; j < 4; ++j) { const int c0 = 8 * (lane + 64 * j); fw[2 * j] = *(const f32x4*)(P.fnw() + c0); fw[2 * j + 1] = *(const f32x4*)(P.fnw() + c0 + 4); }
        u32x4 dv[4]; f32x4 xv[8];
        if (gw < M) {
#pragma unroll
            for (int j = 0; j < 4; ++j) { const int c0 = 8 * (lane + 64 * j); dv[j] = *(const u32x4*)(P.XN() + (size_t)gw * D + c0); xv[2 * j] = *(const f32x4*)(P.x() + (size_t)gw * D + c0); xv[2 * j + 1] = *(const f32x4*)(P.x() + (size_t)gw * D + c0 + 4); } }
        for (int m = gw; m < M; m += NGW) { float* orow = P.out() + (size_t)m * D; const int mn = m + NGW;
            u32x4 dn[4]; f32x4 xq[8];
            if (mn < M) {
#pragma unroll
                for (int j = 0; j < 4; ++j) { const int c0 = 8 * (lane + 64 * j); dn[j] = *(const u32x4*)(P.XN() + (size_t)mn * D + c0); xq[2 * j] = *(const f32x4*)(P.x() + (size_t)mn * D + c0); xq[2 * j + 1] = *(const f32x4*)(P.x() + (size_t)mn * D + c0 + 4); } }
            f32x4 hv[8]; float ss = 0.f;
#pragma unroll
            for (int j = 0; j < 4; ++j) { f32x4 d0, d1; pg8::unpack8(dv[j], d0, d1); hv[2 * j] = d0 + xv[2 * j]; hv[2 * j + 1] = d1 + xv[2 * j + 1]; }
#pragma unroll
            for (int j = 0; j < 8; ++j) ss += (hv[j][0] * hv[j][0] + hv[j][1] * hv[j][1]) + (hv[j][2] * hv[j][2] + hv[j][3] * hv[j][3]);
            const float rs = 1.0f / sqrtf(wave_sum(ss) * (1.f / D) + NORM_EPS);
#pragma unroll
            for (int j = 0; j < 4; ++j) { const int c0 = 8 * (lane + 64 * j);
                *(f32x4*)(orow + c0) = hv[2 * j] * rs * fw[2 * j]; *(f32x4*)(orow + c0 + 4) = hv[2 * j + 1] * rs * fw[2 * j + 1]; }
            if (mn < M) {
#pragma unroll
                for (int j = 0; j < 4; ++j) dv[j] = dn[j];
#pragma unroll
                for (int j = 0; j < 8; ++j) xv[j] = xq[j]; }
        }
    }
#undef IN
#undef SEAM
}

#ifndef N_LAUNCHES
#define N_LAUNCHES 1
#endif
template <int LO, int HI> static bool setup_one(int& per_cu) {
    if (hipFuncSetAttribute((const void*)hybrid_fwd<LO, HI>, hipFuncAttributeMaxDynamicSharedMemorySize, LDS_BYTES) != hipSuccess) { fprintf(stderr, "kernel_launch: hipFuncSetAttribute failed\n"); return false; }
    if (hipOccupancyMaxActiveBlocksPerMultiprocessor(&per_cu, (const void*)hybrid_fwd<LO, HI>, NTHR, LDS_BYTES) != hipSuccess || per_cu < 1) { fprintf(stderr, "kernel_launch: occupancy query says %d blocks per CU\n", per_cu); per_cu = 1; }
    (void)hipGetLastError();
    return true;
}
extern "C" void kernel_launch(void* const* d_in, const int* in_sizes, int n_in, void* d_out, int out_size, void* d_ws, size_t ws_size, hipStream_t stream) {
    static int grid = 0;
    if (grid == 0) {
        if (n_in != 14 || out_size != M * D || ws_size < WS_END) { fprintf(stderr, "kernel_launch: unexpected shapes (n_in %d, out %d, ws %zu)\n", n_in, out_size, ws_size); grid = -1; return; }
        int dev = 0, cus = 0, per_cu = 1; bool ok = true;
        (void)hipGetDevice(&dev); (void)hipDeviceGetAttribute(&cus, hipDeviceAttributeMultiprocessorCount, dev);
#if N_LAUNCHES == 1
        ok = setup_one<0, 7>(per_cu);
#else
        ok = setup_one<0, 1>(per_cu) && setup_one<1, 2>(per_cu) && setup_one<2, 3>(per_cu) && setup_one<3, 4>(per_cu) && setup_one<4, 5>(per_cu) && setup_one<5, 6>(per_cu) && setup_one<6, 7>(per_cu);
#endif
        if (!ok) { grid = -1; return; }
        grid = cus * per_cu;
        if (grid != 256) fprintf(stderr, "kernel_launch: note: grid = %d workgroups\n", grid);
    }
    if (grid < 0) return;
    Args a{};
    for (int i = 0; i < 14; ++i) a.in[i] = (const float*)d_in[i];
    a.out = (float*)d_out; a.ws = (unsigned char*)d_ws;
#if N_LAUNCHES == 1
    void* kargs[] = {&a};
    hipError_t e = hipLaunchCooperativeKernel((const void*)hybrid_fwd<0, 7>, dim3(grid), dim3(NTHR), kargs, LDS_BYTES, stream);
    if (e != hipSuccess) fprintf(stderr, "kernel_launch: cooperative launch failed: %s (grid %d)\n", hipGetErrorString(e), grid);
#else
    hipLaunchKernelGGL((hybrid_fwd<0, 1>), dim3(grid), dim3(NTHR), LDS_BYTES, stream, a);
    hipLaunchKernelGGL((hybrid_fwd<1, 2>), dim3(grid), dim3(NTHR), LDS_BYTES, stream, a);
    hipLaunchKernelGGL((hybrid_fwd<2, 3>), dim3(grid), dim3(NTHR), LDS_BYTES, stream, a);
    hipLaunchKernelGGL((hybrid_fwd<3, 4>), dim3(grid), dim3(NTHR), LDS_BYTES, stream, a);
    hipLaunchKernelGGL((hybrid_fwd<4, 5>), dim3(grid), dim3(NTHR), LDS_BYTES, stream, a);
    hipLaunchKernelGGL((hybrid_fwd<5, 6>), dim3(grid), dim3(NTHR), LDS_BYTES, stream, a);
    hipLaunchKernelGGL((hybrid_fwd<6, 7>), dim3(grid), dim3(NTHR), LDS_BYTES, stream, a);
#endif
}
```

```cpp
#include <hip/hip_runtime.h>
#include <hip/hip_cooperative_groups.h>
#include <cstdio>
#include <cstdint>
constexpr size_t MiB = 1u << 20;
constexpr size_t WS_CTL = 0, WS_WIN = 1 * MiB, WS_WUQ = 41 * MiB, WS_WUK = 43 * MiB, WS_WUV = 43 * MiB + 512 * 1024, WS_WB2 = 44 * MiB, WS_WOUT = 52 * MiB;
constexpr size_t WS_C128 = 60 * MiB, WS_S128 = 61 * MiB + 256 * 1024, WS_C64 = 62 * MiB + 512 * 1024, WS_S64 = 63 * MiB + 256 * 1024;
constexpr size_t WS_MP = 64 * MiB, WS_R0 = 64 * MiB + 256 * 1024, WS_SSQQ = 65 * MiB, WS_SSQKV = 66 * MiB, WS_SSQO = 67 * MiB, WS_KR = 71 * MiB;
constexpr size_t WS_XN = 76 * MiB, WS_QN = 76 * MiB, WS_QR = 140 * MiB, WS_CQ = 204 * MiB, WS_CKV = 236 * MiB, WS_ZMLA = 252 * MiB  , WS_ZRET = 252 * MiB + 2048, WS_RQ = 380 * MiB, WS_RK = 444 * MiB, WS_MG = 380 * MiB;
constexpr size_t WS_RV = 508 * MiB, WS_GATES = 572 * MiB, WS_KN = 828 * MiB, WS_VT = 894 * MiB, WS_END = 960 * MiB;
namespace pg8 {
#define PG8_LAS __attribute__((address_space(3)))
typedef unsigned short bf16_t;
typedef short bf16x8 __attribute__((ext_vector_type(8)));
typedef float f32x4 __attribute__((ext_vector_type(4)));
typedef unsigned u32x4 __attribute__((ext_vector_type(4)));
constexpr int BM = 256, BK = 64, HALF = 128, HTB = HALF * BK * 2  , STAGE_BYTES = 8 * HTB, NXCD = 8, WGM = 4;

__host__ __device__ __forceinline__ int lds_byte(int r, int c) { const int st = (r >> 4) * 2 + (c >> 5), rr = r & 15, cc = c & 31, ob = rr * 64 + cc * 2; return st * 1024 + (ob ^ (((ob >> 9) & 1) << 5)); }
__host__ __device__ __forceinline__ void stage_rc(int b, int& R, int& C) { const int st = b / 1024, sb = b % 1024, swz = sb ^ (((sb >> 9) & 1) << 5); R = (st >> 1) * 16 + swz / 64; C = (st & 1) * 32 + (swz % 64) / 2; }
__host__ __device__ __forceinline__ int perm32(int rho) { const int n = rho >> 4, i = rho & 15; return 8 * (i >> 2) + 4 * n + (i & 3); }

struct Unit { int pm, pn; };
struct Gemm { const bf16_t* A; const bf16_t* Bt; int M, N, K; };

struct StaticOrder {
    int nM, nN, nwg, G, c;
    __host__ __device__ void init(int M, int N, int G_, int c_) { nM = M / BM; nN = N / BM; nwg = nM * nN; G = G_; c = c_; }
    __host__ __device__ bool next(int i, Unit& u) const {
        const long L = (long)i * G + c; if (L >= nwg) return false;
        int wgid = (int)L; { const int q = nwg / NXCD, r = nwg % NXCD, xcd = wgid % NXCD, off = wgid / NXCD; wgid = (xcd < r ? xcd * (q + 1) : r * (q + 1) + (xcd - r) * q) + off; }
        const int nig = WGM * nN, gid = wgid / nig, fm = gid * WGM, gsz = (nM - fm) < WGM ? (nM - fm) : WGM;
        u.pm = fm + ((wgid % nig) % gsz); u.pn = (wgid % nig) / gsz; return true;
    }
    __device__ __forceinline__ void a_ready(const Unit&) const {}
    __device__ __forceinline__ void done(const Unit&) const {}
};

__device__ __forceinline__ unsigned cvt_pk_bf16(float lo, float hi) { unsigned r; asm volatile("v_cvt_pk_bf16_f32 %0, %1, %2" : "=v"(r) : "v"(lo), "v"(hi)); return r; }
typedef float f32x2 __attribute__((ext_vector_type(2)));
typedef unsigned u32x2 __attribute__((ext_vector_type(2)));
constexpr int TOK = 4096, KSEQ = 4160, KOFF = 64;
__device__ __forceinline__ float head_lg2(int h) { const float x = __uint_as_float((unsigned)(127 - 5 - h) << 23); const float p = x * (1.f + x * (0.5f + x * (0.33333333f + x * (0.25f + x * (0.2f + x * (0.16666667f + x * 0.14285714f)))))); return -p * 1.4426950408889634f; }
__device__ __forceinline__ void rope_cs4(int pos, int j0, float inv_half  , f32x4& c, f32x4& s) {
#pragma unroll
    for (int i = 0; i < 4; ++i) { const float rev = (float)pos * __builtin_amdgcn_exp2f(-(float)(j0 + i) * inv_half * 13.287712379549449f - 2.651496129472319f);
        const float f = __builtin_amdgcn_fractf(rev); c[i] = __builtin_amdgcn_cosf(f); s[i] = __builtin_amdgcn_sinf(f); }
}
__device__ __forceinline__ float sigmoid_f(float x) { return __builtin_amdgcn_rcpf(1.f + __expf(-x)); }
__device__ __forceinline__ float bf2f(unsigned short b) { return __uint_as_float((unsigned)b << 16); }
__device__ __forceinline__ u32x4 pack8(f32x4 v0, f32x4 v1) { u32x4 w; w.x = cvt_pk_bf16(v0[0], v0[1]); w.y = cvt_pk_bf16(v0[2], v0[3]); w.z = cvt_pk_bf16(v1[0], v1[1]); w.w = cvt_pk_bf16(v1[2], v1[3]); return w; }
__device__ __forceinline__ u32x2 pack4(f32x4 v) { u32x2 w; w.x = cvt_pk_bf16(v[0], v[1]); w.y = cvt_pk_bf16(v[2], v[3]); return w; }
__device__ __forceinline__ void unpack8(u32x4 w, f32x4& a, f32x4& b) {
    a[0] = __uint_as_float(w.x << 16); a[1] = __uint_as_float(w.x & 0xffff0000u); a[2] = __uint_as_float(w.y << 16); a[3] = __uint_as_float(w.y & 0xffff0000u);
    b[0] = __uint_as_float(w.z << 16); b[1] = __uint_as_float(w.z & 0xffff0000u); b[2] = __uint_as_float(w.w << 16); b[3] = __uint_as_float(w.w & 0xffff0000u); }

struct EpiIn {
    static constexpr bool PERM = true, AFTER_DRAIN = false, HAS_MID = false;
    unsigned char* ws; float *ssq_q, *ssq_kv; const float *C128, *S128, *C64, *S64;
    __device__ __forceinline__ void operator()(const f32x4 (&acc)[2][2][4][2], const Unit& u, int wr, int wc, int fr, int fq) const {
        const int pn = u.pn, row0 = u.pm * BM + wr * 64 + fr;
        if (pn < 3) {
            bf16_t* base = (bf16_t*)(ws + (pn < 2 ? WS_CQ : WS_CKV)); const int ldc = pn < 2 ? 512 : 256, colt = pn < 2 ? pn * 256 : 0;
            float* sq = pn < 2 ? ssq_q : ssq_kv; const int sld = pn < 2 ? 8 : 4, soff = (pn < 2 ? pn * 4 : 0) + wc;
#pragma unroll
            for (int ai = 0; ai < 2; ++ai)
#pragma unroll
                for (int m = 0; m < 4; ++m) { const int row = row0 + ai * HALF + m * 16; float s = 0.f;
#pragma unroll
                    for (int bj = 0; bj < 2; ++bj) { const f32x4 v0 = acc[ai][bj][m][0], v1 = acc[ai][bj][m][1];
                        s += (v0[0] * v0[0] + v0[1] * v0[1]) + (v0[2] * v0[2] + v0[3] * v0[3]) + (v1[0] * v1[0] + v1[1] * v1[1]) + (v1[2] * v1[2] + v1[3] * v1[3]);
                        *(u32x4*)(base + (size_t)row * ldc + colt + bj * HALF + wc * 32 + 8 * fq) = pack8(v0, v1); }
                    s += __shfl_xor(s, 16); s += __shfl_xor(s, 32);
                    if (fq == 0) sq[(size_t)row * sld + soff] = s; }
        } else if (pn == 3) {
            if (wc < 2) {
                const int j0 = 16 * wc + 4 * fq;
#pragma unroll
                for (int ai = 0; ai < 2; ++ai)
#pragma unroll
                    for (int m = 0; m < 4; ++m) { const int row = row0 + ai * HALF + m * 16, b = row >> 12, t = row & (TOK - 1);
                        f32x4 c, s; rope_cs4(16 + t, j0, 1.f / 32.f, c, s);
                        const f32x4 t1 = acc[ai][0][m][0], t2 = acc[ai][0][m][1];
                        bf16_t* o = (bf16_t*)(ws + WS_KR) + (size_t)(b * KSEQ + KOFF + t) * 64 + j0;
                        *(u32x2*)o = pack4(t1 * c - t2 * s); *(u32x2*)(o + 32) = pack4(t1 * s + t2 * c); }
            }
        } else if ((pn >= 8) && (pn < 16)) {
            const bool isk = pn >= 12; bf16_t* base = (bf16_t*)(ws + (isk ? WS_RK : WS_RQ)); const int colt = (pn - (isk ? 12 : 8)) * 256; const int j0 = 16 * wc + 4 * fq;
#pragma unroll
            for (int ai = 0; ai < 2; ++ai) {
#pragma unroll
                for (int m = 0; m < 4; ++m) { const int row = row0 + ai * HALF + m * 16, t = row & (TOK - 1);
                    f32x4 c, s; rope_cs4(16 + t, j0, 1.f / 64.f, c, s);
#pragma unroll
                    for (int bj = 0; bj < 2; ++bj) { float f = 1.f;
                        if (isk) { const int h = (colt >> 7) + bj; f = 0.08838834764831845f * __builtin_amdgcn_exp2f(head_lg2(h) * (float)(127 - (t & 127))); }
                        const f32x4 t1 = acc[ai][bj][m][0] * f, t2 = acc[ai][bj][m][1] * f;
                        bf16_t* o = base + (size_t)row * 1024 + colt + bj * HALF + j0;
                        *(u32x2*)o = pack4(t1 * c - t2 * s); *(u32x2*)(o + 64) = pack4(t1 * s + t2 * c); } }
            }
        } else {
            size_t boff; int ldc, colt, act;
            if (pn < 8) { boff = WS_ZMLA; ldc = 2048; colt = (pn - 4) * 256; act = 1; }
            else if (pn < 20) { boff = WS_RV; ldc = 1024; colt = (pn - 16) * 256; act = 0; }
            else if (pn < 24) { boff = WS_ZRET; ldc = 2048; colt = (pn - 20) * 256; act = 1; }
            else { boff = WS_GATES; ldc = 4096; colt = (pn - 24) * 256; act = 2; }
            bf16_t* base = (bf16_t*)(ws + boff);
#pragma unroll
            for (int ai = 0; ai < 2; ++ai)
#pragma unroll
                for (int m = 0; m < 4; ++m) { const int row = row0 + ai * HALF + m * 16;
#pragma unroll
                    for (int bj = 0; bj < 2; ++bj) { f32x4 v0 = acc[ai][bj][m][0], v1 = acc[ai][bj][m][1];
                        if (act != 0) {
#pragma unroll
                            for (int i = 0; i < 4; ++i) { const float s0 = sigmoid_f(v0[i]), s1 = sigmoid_f(v1[i]); v0[i] = act == 1 ? v0[i] * s0 : s0; v1[i] = act == 1 ? v1[i] * s1 : s1; } }
                        *(u32x4*)(base + (size_t)row * ldc + colt + bj * HALF + wc * 32 + 8 * fq) = pack8(v0, v1); } }
        }
    }
};

__device__ __forceinline__ float rs_from(const float* p, int n, float inv_d, float eps) { float s = 0.f; for (int i = 0; i < n; ++i) s += p[i]; return 1.0f / sqrtf(s * inv_d + eps); }

struct EpiQ {
    static constexpr bool PERM = true, AFTER_DRAIN = false, HAS_MID = false;
    bf16_t *QN, *QR; const float *ssq_q, *C64, *S64; float qscale;
    __device__ __forceinline__ void operator()(const f32x4 (&acc)[2][2][4][2], const Unit& u, int wr, int wc, int fr, int fq) const {
        const int pn = u.pn, row0 = u.pm * BM + wr * 64 + fr;
        float fs[2][4];
#pragma unroll
        for (int ai = 0; ai < 2; ++ai)
#pragma unroll
            for (int m = 0; m < 4; ++m) { const int row = row0 + ai * HALF + m * 16;
                const f32x4 q0 = *(const f32x4*)(ssq_q + (size_t)row * 8), q1 = *(const f32x4*)(ssq_q + (size_t)row * 8 + 4);
                const float ss = ((q0[0] + q0[1]) + (q0[2] + q0[3])) + ((q1[0] + q1[1]) + (q1[2] + q1[3]));
                fs[ai][m] = qscale / sqrtf(ss * (1.f / 512.f) + 1e-6f); }
        if (pn < 4) {
            asm volatile("" ::: "memory");
#pragma unroll
            for (int ai = 0; ai < 2; ++ai)
#pragma unroll
                for (int m = 0; m < 4; ++m) { const int row = row0 + ai * HALF + m * 16; const float f = fs[ai][m];
#pragma unroll
                    for (int bj = 0; bj < 2; ++bj) *(u32x4*)(QN + (size_t)row * 1024 + pn * 256 + bj * HALF + wc * 32 + 8 * fq) = pack8(acc[ai][bj][m][0] * f, acc[ai][bj][m][1] * f); }
        } else {
            const int j0 = 16 * (wc & 1) + 4 * fq;
#pragma unroll
            for (int ai = 0; ai < 2; ++ai) {
#pragma unroll
                for (int m = 0; m < 4; ++m) { const int row = row0 + ai * HALF + m * 16; const float f = fs[ai][m]; f32x4 c, s; rope_cs4(16 + (row & (TOK - 1)), j0, 1.f / 32.f, c, s);
#pragma unroll
                    for (int bj = 0; bj < 2; ++bj) { const int head = (pn - 4) * 4 + bj * 2 + (wc >> 1);
                        const f32x4 t1 = acc[ai][bj][m][0] * f, t2 = acc[ai][bj][m][1] * f;
                        bf16_t* o = QR + (size_t)row * 512 + head * 64 + j0;
                        *(u32x2*)o = pack4(t1 * c - t2 * s); *(u32x2*)(o + 32) = pack4(t1 * s + t2 * c); } }
            }
        }
    }
};
struct EpiK {
    static constexpr bool PERM = true, AFTER_DRAIN = false, HAS_MID = false;
    bf16_t* KN; const float* ssq_kv;
    __device__ __forceinline__ void operator()(const f32x4 (&acc)[2][2][4][2], const Unit& u, int wr, int wc, int fr, int fq) const {
        const int pn = u.pn, row0 = u.pm * BM + wr * 64 + fr;
        float fs[2][4];
#pragma unroll
        for (int ai = 0; ai < 2; ++ai)
#pragma unroll
            for (int m = 0; m < 4; ++m) { const int row = row0 + ai * HALF + m * 16; const f32x4 q0 = *(const f32x4*)(ssq_kv + (size_t)row * 4);
                fs[ai][m] = 1.0f / sqrtf(((q0[0] + q0[1]) + (q0[2] + q0[3])) * (1.f / 256.f) + 1e-6f); }
        asm volatile("" ::: "memory");
#pragma unroll
        for (int ai = 0; ai < 2; ++ai)
#pragma unroll
            for (int m = 0; m < 4; ++m) { const int row = row0 + ai * HALF + m * 16, b = row >> 12, t = row & (TOK - 1); const float f = fs[ai][m];
#pragma unroll
                for (int bj = 0; bj < 2; ++bj) *(u32x4*)(KN + (size_t)(b * KSEQ + KOFF + t) * 1024 + pn * 256 + bj * HALF + wc * 32 + 8 * fq) = pack8(acc[ai][bj][m][0] * f, acc[ai][bj][m][1] * f); }
    }
};
struct EpiVT {
    static constexpr bool PERM = true, AFTER_DRAIN = false, HAS_MID = false;
    bf16_t* VT; const float* ssq_kv;
    __device__ __forceinline__ void operator()(const f32x4 (&acc)[2][2][4][2], const Unit& u, int wr, int wc, int fr, int fq) const {
        const int pn = u.pn, row0 = u.pm * BM + wr * 64 + fr;
#pragma unroll
        for (int bj = 0; bj < 2; ++bj) { const int col = pn * 256 + bj * HALF + wc * 32 + 8 * fq, b = col >> 12, t = col & (TOK - 1);
            f32x4 f0, f1;
#pragma unroll
            for (int i = 0; i < 4; ++i) { const f32x4 a = *(const f32x4*)(ssq_kv + (size_t)(col + i) * 4);
                f0[i] = 1.0f / sqrtf(((a[0] + a[1]) + (a[2] + a[3])) * (1.f / 256.f) + 1e-6f); }
#pragma unroll
            for (int i = 0; i < 4; ++i) { const f32x4 c = *(const f32x4*)(ssq_kv + (size_t)(col + 4 + i) * 4);
                f1[i] = 1.0f / sqrtf(((c[0] + c[1]) + (c[2] + c[3])) * (1.f / 256.f) + 1e-6f); }
#pragma unroll
            for (int ai = 0; ai < 2; ++ai)
#pragma unroll
                for (int m = 0; m < 4; ++m) { const int row = row0 + ai * HALF + m * 16;
                    bf16_t* o = VT + (size_t)row * (8 * KSEQ) + b * KSEQ + KOFF + (t & ~15) + ((t & 8) ? 4 : 0);
                    *(u32x2*)o = pack4(acc[ai][bj][m][0] * f0); *(u32x2*)(o + 8) = pack4(acc[ai][bj][m][1] * f1); } }
    }
};
struct EpiMerge2 {
    static constexpr bool PERM = true, AFTER_DRAIN = false, HAS_MID = true;
    bf16_t* MG; const bf16_t* GATES;
    __device__ __forceinline__ void mid(f32x4 (&acc)[2][2][4][2], const Unit& u, int wr, int wc, int fr, int fq) const {
        asm volatile("" : "+v"(fr), "+v"(fq));
        const int row0 = u.pm * BM + wr * 64 + fr, col0 = u.pn * 256 + wc * 32 + 8 * fq;
#pragma unroll
        for (int ai = 0; ai < 2; ++ai)
#pragma unroll
            for (int mh = 0; mh < 2; ++mh) {
                u32x4 ga[2][2], gb[2][2];
#pragma unroll
                for (int mm = 0; mm < 2; ++mm)
#pragma unroll
                    for (int bj = 0; bj < 2; ++bj) { const size_t row = (size_t)(row0 + ai * HALF + (2 * mh + mm) * 16);
                        ga[mm][bj] = *(const u32x4*)(GATES + row * 4096 + col0 + bj * HALF); gb[mm][bj] = *(const u32x4*)(GATES + row * 4096 + 2048 + col0 + bj * HALF); }
                asm volatile("" ::: "memory");
#pragma unroll
                for (int mm = 0; mm < 2; ++mm)
#pragma unroll
                    for (int bj = 0; bj < 2; ++bj) { const int m = 2 * mh + mm; f32x4 a0, a1, b0, b1; unpack8(ga[mm][bj], a0, a1); unpack8(gb[mm][bj], b0, b1);
#pragma unroll
                        for (int i = 0; i < 4; ++i) { acc[ai][bj][m][0][i] *= a0[i] * __builtin_amdgcn_rcpf(fmaxf(b0[i], 1e-30f)); acc[ai][bj][m][1][i] *= a1[i] * __builtin_amdgcn_rcpf(fmaxf(b1[i], 1e-30f)); } }
                asm volatile("" ::: "memory");
            }
    }
    __device__ __forceinline__ void operator()(const f32x4 (&acc)[2][2][4][2], const Unit& u, int wr, int wc, int fr, int fq) const {
        asm volatile("" : "+v"(fr), "+v"(fq));
        const int row0 = u.pm * BM + wr * 64 + fr, col0 = u.pn * 256 + wc * 32 + 8 * fq;
#pragma unroll
        for (int ai = 0; ai < 2; ++ai) {
            u32x4 gb[4][2];
#pragma unroll
            for (int m = 0; m < 4; ++m)
#pragma unroll
                for (int bj = 0; bj < 2; ++bj) gb[m][bj] = *(const u32x4*)(GATES + (size_t)(row0 + ai * HALF + m * 16) * 4096 + 2048 + col0 + bj * HALF);
            asm volatile("" ::: "memory");
#pragma unroll
            for (int m = 0; m < 4; ++m)
#pragma unroll
                for (int bj = 0; bj < 2; ++bj) { f32x4 b0, b1; unpack8(gb[m][bj], b0, b1);
                    *(u32x4*)(MG + (size_t)(row0 + ai * HALF + m * 16) * 2048 + col0 + bj * HALF) = pack8(acc[ai][bj][m][0] * b0, acc[ai][bj][m][1] * b1); }
            asm volatile("" ::: "memory");
        }
    }
};
struct EpiOut {
    static constexpr bool PERM = true, AFTER_DRAIN = false, HAS_MID = false;
    bf16_t* PRE;
    __device__ __forceinline__ void operator()(const f32x4 (&acc)[2][2][4][2], const Unit& u, int wr, int wc, int fr, int fq) const {
        const int pn = u.pn, row0 = u.pm * BM + wr * 64 + fr;
#pragma unroll
        for (int ai = 0; ai < 2; ++ai)
#pragma unroll
            for (int m = 0; m < 4; ++m) { const int row = row0 + ai * HALF + m * 16;
#pragma unroll
                for (int bj = 0; bj < 2; ++bj) *(u32x4*)(PRE + (size_t)row * 2048 + pn * 256 + bj * HALF + wc * 32 + 8 * fq) = pack8(acc[ai][bj][m][0], acc[ai][bj][m][1]); }
    }
};

struct EpiNull {
    static constexpr bool PERM = true, AFTER_DRAIN = false, HAS_MID = false;
    float* sink;
    __device__ __forceinline__ void operator()(const f32x4 (&acc)[2][2][4][2], const Unit& u, int wr, int wc, int fr, int fq) const {
        float s = 0.f;
#pragma unroll
        for (int ai = 0; ai < 2; ++ai)
#pragma unroll
            for (int bj = 0; bj < 2; ++bj)
#pragma unroll
                for (int m = 0; m < 4; ++m)
#pragma unroll
                    for (int n = 0; n < 2; ++n) s += acc[ai][bj][m][n][0] + acc[ai][bj][m][n][3];
        if (s == 1.2345e-30f) sink[0] = s;
    }
};
template <class Epi, class Sched, bool ALIGN_EPI = false, bool SP2 = false>
__device__ __forceinline__ void gemm_phase(PG8_LAS unsigned char* lds, const Gemm g, const Sched& S, const Epi& E) {
    int tid = threadIdx.x; asm volatile("" : "+v"(tid));
    const int wid = __builtin_amdgcn_readfirstlane(tid >> 6), lane = tid & 63, wr = wid >> 2, wc = wid & 3, fr = lane & 15, fq = lane >> 4;
    const int K = g.K, nt = K / BK;
    unsigned voffA[2], voffB[2];
#pragma unroll
    for (int i = 0; i < 2; ++i) { int R, C; stage_rc(tid * 16 + i * 8192, R, C); const int Rb = Epi::PERM ? ((R & ~31) + perm32(R & 31)) : R;
        voffA[i] = (unsigned)(R * K + C) * 2u; voffB[i] = (unsigned)(Rb * K + C) * 2u; }
    const size_t kstep = (size_t)(BK * 2);
    const size_t hstep = (size_t)HALF * K * 2;
    const size_t tstep = 2 * hstep;
    const unsigned ldsw = (unsigned)wid * 1024u;
    const int aoff = lds_byte(wr * 64 + fr, fq * 8), boff = lds_byte(wc * 32 + fr, fq * 8);
#define PG8_SA(b, h) (((b) * 2 + (h)) * HTB)
#define PG8_SB(b, h) ((4 + (b) * 2 + (h)) * HTB)
#define PG8_STAGE(bufoff, gbase, voff) do { _Pragma("unroll") for (int _i = 0; _i < 2; ++_i) \
        __builtin_amdgcn_global_load_lds((const unsigned*)((const char*)(gbase) + (voff)[_i]), (PG8_LAS unsigned*)(lds + (bufoff) + ldsw + _i * 8192), 16, 0, 0); } while (0)
#define PG8_LDA(dst, b, h) do { _Pragma("unroll") for (int m = 0; m < 4; ++m) _Pragma("unroll") for (int k = 0; k < 2; ++k) dst[m][k] = *(const PG8_LAS bf16x8*)(lds + PG8_SA(b, h) + aoff + m * 2048 + k * 1024); } while (0)
#define PG8_LDB(dst, b, h) do { _Pragma("unroll") for (int n = 0; n < 2; ++n) _Pragma("unroll") for (int k = 0; k < 2; ++k) dst[n][k] = *(const PG8_LAS bf16x8*)(lds + PG8_SB(b, h) + boff + n * 2048 + k * 1024); } while (0)
#define PG8_MMA(ai, bj, At, Bt) do { __builtin_amdgcn_s_setprio(1); _Pragma("unroll") for (int m = 0; m < 4; ++m) _Pragma("unroll") for (int n = 0; n < 2; ++n) _Pragma("unroll") for (int k = 0; k < 2; ++k) \
        acc[ai][bj][m][n] = __builtin_amdgcn_mfma_f32_16x16x32_bf16(Bt[n][k], At[m][k], acc[ai][bj][m][n], 0, 0, 0); __builtin_amdgcn_s_setprio(0); } while (0)
#define PG8_WAIT_V(n) asm volatile("s_waitcnt vmcnt(" #n ")" ::: "memory")
#define PG8_WAIT_L(n) asm volatile("s_waitcnt lgkmcnt(" #n ")" ::: "memory")
#define PG8_BAR __builtin_amdgcn_s_barrier()
#define PG8_SCHED __builtin_amdgcn_sched_barrier(0)
    Unit cur, nxt; int ui = 0;
    if (!S.next(0, cur)) return;
    f32x4 acc[2][2][4][2];
#pragma unroll
    for (int a = 0; a < 2; ++a)
#pragma unroll
        for (int b = 0; b < 2; ++b)
#pragma unroll
            for (int m = 0; m < 4; ++m)
#pragma unroll
                for (int n = 0; n < 2; ++n) acc[a][b][m][n] = (f32x4){0.f, 0.f, 0.f, 0.f};
    bf16x8 At[4][2], B0[2][2], B1[2][2];
    const char* cA = (const char*)g.A + (size_t)cur.pm * tstep; const char* cB = (const char*)g.Bt + (size_t)cur.pn * tstep;
    S.a_ready(cur);
    if constexpr (SP2) {
        PG8_STAGE(PG8_SB(0, 0), cB, voffB); PG8_STAGE(PG8_SB(0, 1), cB + hstep, voffB); PG8_STAGE(PG8_SA(0, 0), cA, voffA); PG8_STAGE(PG8_SA(0, 1), cA + hstep, voffA);
        if (wr == 1) PG8_BAR;
        PG8_WAIT_V(2); PG8_BAR;
        PG8_STAGE(PG8_SB(1, 0), cB + kstep, voffB); PG8_STAGE(PG8_SA(1, 0), cA + kstep, voffA); PG8_STAGE(PG8_SB(1, 1), cB + hstep + kstep, voffB);
        PG8_WAIT_V(6); PG8_BAR;
    } else {
        PG8_STAGE(PG8_SB(0, 0), cB, voffB); PG8_STAGE(PG8_SA(0, 0), cA, voffA); PG8_STAGE(PG8_SB(0, 1), cB + hstep, voffB); PG8_STAGE(PG8_SA(0, 1), cA + hstep, voffA);
        if (wr == 1) PG8_BAR;
        PG8_WAIT_V(4); PG8_BAR;
        PG8_STAGE(PG8_SB(1, 0), cB + kstep, voffB); PG8_STAGE(PG8_SA(1, 0), cA + kstep, voffA); PG8_STAGE(PG8_SB(1, 1), cB + hstep + kstep, voffB);
        PG8_WAIT_V(6); PG8_BAR;
    }
    for (;;) {
        const bool has_next = S.next(ui + 1, nxt);
        const char* nA = has_next ? (const char*)g.A + (size_t)nxt.pm * tstep : cA; const char* nB = has_next ? (const char*)g.Bt + (size_t)nxt.pn * tstep : cB;
#pragma nounroll
        for (int t = 0; t < nt; t += 2) {
            if constexpr (Epi::HAS_MID) { if (t == nt / 2) { PG8_SCHED; E.mid(acc, cur, wr, wc, fr, fq); PG8_SCHED; } }
            const bool last = (t == nt - 2);
            const char* a1 = cA + (size_t)(t + 1) * kstep;
            const char* a2 = last ? nA : cA + (size_t)(t + 2) * kstep; const char* b2 = last ? nB : cB + (size_t)(t + 2) * kstep;
            const char* a3 = a2 + kstep; const char* b3 = b2 + kstep;
            if (last && has_next) S.a_ready(nxt);
            if constexpr (SP2) {
            PG8_LDB(B0, 0, 0); PG8_LDB(B1, 0, 1); PG8_SCHED; PG8_LDA(At, 0, 0); PG8_STAGE(PG8_SA(1, 1), a1 + hstep, voffA);
            PG8_WAIT_V(8); PG8_WAIT_L(0); PG8_BAR; PG8_MMA(0, 0, At, B0); PG8_MMA(0, 1, At, B1); PG8_BAR; PG8_SCHED;
            PG8_LDA(At, 0, 1); PG8_STAGE(PG8_SB(0, 0), b2, voffB); PG8_STAGE(PG8_SB(0, 1), b2 + hstep, voffB); PG8_STAGE(PG8_SA(0, 0), a2, voffA);
            PG8_WAIT_V(8); PG8_WAIT_L(0); PG8_BAR; PG8_MMA(1, 0, At, B0); PG8_MMA(1, 1, At, B1); PG8_BAR; PG8_SCHED;
            PG8_LDB(B0, 1, 0); PG8_LDB(B1, 1, 1); PG8_SCHED; PG8_LDA(At, 1, 0); PG8_STAGE(PG8_SA(0, 1), a2 + hstep, voffA);
            PG8_WAIT_V(8); PG8_WAIT_L(0); PG8_BAR; PG8_MMA(0, 0, At, B0); PG8_MMA(0, 1, At, B1); PG8_BAR; PG8_SCHED;
            PG8_LDA(At, 1, 1); PG8_STAGE(PG8_SB(1, 0), b3, voffB); PG8_STAGE(PG8_SB(1, 1), b3 + hstep, voffB); PG8_STAGE(PG8_SA(1, 0), a3, voffA);
            PG8_WAIT_V(8); PG8_WAIT_L(0); PG8_BAR; PG8_MMA(1, 0, At, B0); PG8_MMA(1, 1, At, B1); PG8_BAR; PG8_SCHED;
            } else {
            PG8_LDB(B0, 0, 0); PG8_SCHED; PG8_LDA(At, 0, 0); PG8_STAGE(PG8_SA(1, 1), a1 + hstep, voffA);
            PG8_WAIT_L(8); PG8_BAR; PG8_WAIT_L(0); PG8_MMA(0, 0, At, B0); PG8_BAR; PG8_SCHED;
            PG8_LDB(B1, 0, 1); PG8_STAGE(PG8_SB(0, 0), b2, voffB);
            PG8_BAR; PG8_WAIT_L(0); PG8_MMA(0, 1, At, B1); PG8_BAR;
            PG8_LDA(At, 0, 1); PG8_STAGE(PG8_SA(0, 0), a2, voffA);
            PG8_BAR; PG8_WAIT_L(0); PG8_MMA(1, 0, At, B0); PG8_BAR; PG8_SCHED;
            PG8_STAGE(PG8_SB(0, 1), b2 + hstep, voffB);
            PG8_WAIT_V(6); PG8_BAR; PG8_MMA(1, 1, At, B1); PG8_BAR;
            PG8_LDB(B0, 1, 0); PG8_SCHED; PG8_LDA(At, 1, 0); PG8_STAGE(PG8_SA(0, 1), a2 + hstep, voffA);
            PG8_WAIT_L(8); PG8_BAR; PG8_WAIT_L(0); PG8_MMA(0, 0, At, B0); PG8_BAR; PG8_SCHED;
            PG8_LDB(B1, 1, 1); PG8_STAGE(PG8_SB(1, 0), b3, voffB);
            PG8_BAR; PG8_WAIT_L(0); PG8_MMA(0, 1, At, B1); PG8_BAR;
            PG8_LDA(At, 1, 1); PG8_STAGE(PG8_SA(1, 0), a3, voffA);
            PG8_BAR; PG8_WAIT_L(0); PG8_MMA(1, 0, At, B0); PG8_BAR; PG8_SCHED;
            PG8_STAGE(PG8_SB(1, 1), b3 + hstep, voffB);
            PG8_WAIT_V(6); PG8_BAR; PG8_MMA(1, 1, At, B1); PG8_BAR;
            }
        }
        if constexpr (ALIGN_EPI) { if (wr == 0) PG8_BAR; }
        if constexpr (!Epi::AFTER_DRAIN) { E(acc, cur, wr, wc, fr, fq); S.done(cur); }
        if (!has_next) break;
#pragma unroll
        for (int a = 0; a < 2; ++a)
#pragma unroll
            for (int b = 0; b < 2; ++b)
#pragma unroll
                for (int m = 0; m < 4; ++m)
#pragma unroll
                    for (int n = 0; n < 2; ++n) acc[a][b][m][n] = (f32x4){0.f, 0.f, 0.f, 0.f};
        cur = nxt; cA = nA; cB = nB; ++ui;
        if constexpr (ALIGN_EPI) { if (wr == 1) PG8_BAR; }
    }
    PG8_WAIT_V(0);
    if constexpr (!ALIGN_EPI) { if (wr == 0) PG8_BAR; }
    PG8_BAR;
    if constexpr (Epi::AFTER_DRAIN) { E.fused(acc, cur, wr, wc, fr, fq, lds, wid, lane); S.done(cur); }
#undef PG8_SA
#undef PG8_SB
#undef PG8_STAGE
#undef PG8_LDA
#undef PG8_LDB
#undef PG8_MMA
#undef PG8_WAIT_V
#undef PG8_WAIT_L
#undef PG8_BAR
#undef PG8_SCHED
}
}
namespace cg = cooperative_groups;
#define LAS __attribute__((address_space(3)))
typedef unsigned short bf16;
using pg8::f32x4; using pg8::bf16x8; using pg8::u32x4; using pg8::u32x2; using pg8::cvt_pk_bf16; using pg8::bf2f;
typedef float f32x16 __attribute__((ext_vector_type(16)));
typedef short s16x4 __attribute__((ext_vector_type(4)));
using pg8::TOK; using pg8::KSEQ; using pg8::KOFF;
constexpr int NB = 8, M = NB * TOK, D = 2048, NIN = 10048, NINP = 10240, NPOS = 4112;
constexpr int NWAVES = 8, NTHR = 512, LDS_BYTES = 147456, QWORD_OFF = 147200;
constexpr int NMP = 2368;
constexpr float NORM_EPS = 1e-6f, GN_EPS = 1e-5f;

struct Args { const float* in[14]; float* out; unsigned char* ws; };

__device__ __forceinline__ unsigned f2bf(float f) { unsigned u = __float_as_uint(f); return (u + 0x7fffu + ((u >> 16) & 1u)) >> 16; }
__device__ __forceinline__ unsigned pk2(float lo, float hi) { return f2bf(lo) | (f2bf(hi) << 16); }
__device__ __forceinline__ float wave_sum(float v) {
#pragma unroll
    for (int o = 1; o < 64; o <<= 1) v += __shfl_xor(v, o);
    return v;
}
__device__ __forceinline__ float head_lg2(int h) { return pg8::head_lg2(h); }

__device__ __forceinline__ int src_in(int n) {
    if (n < 768) return n;
    if (n < 1024) { const int p = n - 768; if (p >= 64) return -1; const int wc = p >> 5, fq = (p >> 3) & 3, nn = (p >> 2) & 1, i = p & 3; return 768 + 32 * nn + 16 * wc + 4 * fq + i; }
    if (n < 2048) return 832 + (n - 1024);
    if (n < 4096) { const int q = n - 2048, hb = q >> 7, p = q & 127, wc = p >> 5, fq = (p >> 3) & 3, nn = (p >> 2) & 1, i = p & 3; return 1856 + hb * 128 + 64 * nn + 16 * wc + 4 * fq + i; }
    if (n < 6144) return 3904 + (n - 4096);
    return 5952 + (n - 6144);
}
__device__ __forceinline__ int src_uq(int n) {
    if (n < 1024) return (n >> 7) * 192 + (n & 127);
    const int q = n - 1024, blk = q >> 7, p = q & 127, wc = p >> 5, fq = (p >> 3) & 3, nn = (p >> 2) & 1, i = p & 3;
    return (2 * blk + (wc >> 1)) * 192 + 128 + 32 * nn + 16 * (wc & 1) + 4 * fq + i;
}
template <int KIND> __device__ __forceinline__ void p0_item(const float* W, int ldw, int K, bf16* WT, const float* ksc, int item, int nblk, LAS float* scr, int lane) {
    const int kb = item / nblk, nb = item % nblk, k0 = 64 * kb, n0 = 32 * nb, nl = lane & 31;
    int sc;
    if (KIND == 0) sc = n0 + nl; else if (KIND == 1) sc = src_in(n0 + nl); else if (KIND == 2) sc = src_uq(n0 + nl);
    else if (KIND == 3) sc = ((n0 + nl) >> 7) * 256 + ((n0 + nl) & 127); else sc = ((n0 + nl) >> 7) * 256 + 128 + ((n0 + nl) & 127);
#pragma unroll 16
    for (int i = 0; i < 32; ++i) { const int kk = 2 * i + (lane >> 5); float v = sc >= 0 ? W[(size_t)(k0 + kk) * ldw + sc] : 0.f; if (ksc) v *= ksc[k0 + kk]; scr[kk * 33 + nl] = v; }
    asm volatile("s_waitcnt lgkmcnt(0)" ::: "memory");
    const int c = lane & 7;
#pragma unroll
    for (int j = 0; j < 4; ++j) { const int n = (lane >> 3) + 8 * j; const LAS float* s = scr + (8 * c) * 33 + n;
        u32x4 o; o.x = pk2(s[0 * 33], s[1 * 33]); o.y = pk2(s[2 * 33], s[3 * 33]); o.z = pk2(s[4 * 33], s[5 * 33]); o.w = pk2(s[6 * 33], s[7 * 33]);
        *(u32x4*)(WT + (size_t)(n0 + n) * K + k0 + 8 * c) = o; }
    asm volatile("s_waitcnt lgkmcnt(0)" ::: "memory");
}

struct Ptrs {
    const Args* a; unsigned char* ws;
    __device__ __forceinline__ const float* x() const { return a->in[0]; }
    __device__ __forceinline__ const float* meta() const { return a->in[1]; }
    __device__ __forceinline__ const float* norm_w() const { return a->in[2]; }
    __device__ __forceinline__ const float* w_in() const { return a->in[3]; }
    __device__ __forceinline__ const float* qnw() const { return a->in[4]; }
    __device__ __forceinline__ const float* w_uq() const { return a->in[5]; }
    __device__ __forceinline__ const float* kvnw() const { return a->in[6]; }
    __device__ __forceinline__ const float* w_ukv() const { return a->in[7]; }
    __device__ __forceinline__ const float* gnw() const { return a->in[8]; }
    __device__ __forceinline__ const float* gnb() const { return a->in[9]; }
    __device__ __forceinline__ const float* w_bm() const { return a->in[10]; }
    __device__ __forceinline__ const float* w_br() const { return a->in[11]; }
    __device__ __forceinline__ const float* w_out() const { return a->in[12]; }
    __device__ __forceinline__ const float* fnw() const { return a->in[13]; }
    __device__ __forceinline__ float* out() const { return a->out; }
    __device__ __forceinline__ bf16* WIN() const { return (bf16*)(ws + WS_WIN); }
    __device__ __forceinline__ bf16* WUQ() const { return (bf16*)(ws + WS_WUQ); }
    __device__ __forceinline__ bf16* WUK() const { return (bf16*)(ws + WS_WUK); }
    __device__ __forceinline__ bf16* WUV() const { return (bf16*)(ws + WS_WUV); }
    __device__ __forceinline__ bf16* WB2() const { return (bf16*)(ws + WS_WB2); }
    __device__ __forceinline__ bf16* WOUT() const { return (bf16*)(ws + WS_WOUT); }
    __device__ __forceinline__ bf16* KR() const { return (bf16*)(ws + WS_KR); }
    __device__ __forceinline__ bf16* XN() const { return (bf16*)(ws + WS_XN); }
    __device__ __forceinline__ bf16* QN() const { return (bf16*)(ws + WS_QN); }
    __device__ __forceinline__ bf16* QR() const { return (bf16*)(ws + WS_QR); }
    __device__ __forceinline__ bf16* CQ() const { return (bf16*)(ws + WS_CQ); }
    __device__ __forceinline__ bf16* CKV() const { return (bf16*)(ws + WS_CKV); }
    __device__ __forceinline__ bf16* ZMLA() const { return (bf16*)(ws + WS_ZMLA); }
    __device__ __forceinline__ bf16* RQ() const { return (bf16*)(ws + WS_RQ); }
    __device__ __forceinline__ bf16* RK() const { return (bf16*)(ws + WS_RK); }
    __device__ __forceinline__ bf16* MG() const { return (bf16*)(ws + WS_MG); }
    __device__ __forceinline__ bf16* RV() const { return (bf16*)(ws + WS_RV); }
    __device__ __forceinline__ bf16* ZRET() const { return (bf16*)(ws + WS_ZRET); }
    __device__ __forceinline__ bf16* GATES() const { return (bf16*)(ws + WS_GATES); }
    __device__ __forceinline__ bf16* KN() const { return (bf16*)(ws + WS_KN); }
    __device__ __forceinline__ bf16* VT() const { return (bf16*)(ws + WS_VT); }
    __device__ __forceinline__ float* C128() const { return (float*)(ws + WS_C128); }
    __device__ __forceinline__ float* S128() const { return (float*)(ws + WS_S128); }
    __device__ __forceinline__ float* C64() const { return (float*)(ws + WS_C64); }
    __device__ __forceinline__ float* S64() const { return (float*)(ws + WS_S64); }
    __device__ __forceinline__ float* MP() const { return (float*)(ws + WS_MP); }
    __device__ __forceinline__ float* R0() const { return (float*)(ws + WS_R0); }
    __device__ __forceinline__ float* SSQQ() const { return (float*)(ws + WS_SSQQ); }
    __device__ __forceinline__ float* SSQKV() const { return (float*)(ws + WS_SSQKV); }
    __device__ __forceinline__ float* SSQO() const { return (float*)(ws + WS_SSQO); }
    __device__ __forceinline__ unsigned* ctl() const { return (unsigned*)(ws + WS_CTL); }
};

__device__ __forceinline__ void p0_prologue(const Ptrs& P, LAS unsigned char* lds, int tid, int lane, int wave) {
    const int G = gridDim.x, bx = blockIdx.x;
    const int gtid = bx * NTHR + tid, NT = G * NTHR;
    for (int i = gtid; i < 3456  ; i += NT) P.ctl()[4096 + i] = 0u;
    if (gtid < 32) P.ctl()[64 * gtid] = 0u;
    for (int i = gtid; i < NB * 48 * 512; i += NT) { const int b = i / (48 * 512), r = i % (48 * 512); ((unsigned*)(P.KN() + (size_t)b * KSEQ * 1024))[r] = 0u; }
    for (int i = gtid; i < NB * 48 * 32; i += NT) { const int b = i / (48 * 32), r = i % (48 * 32); ((unsigned*)(P.KR() + (size_t)b * KSEQ * 64))[r] = 0u; }
    for (int i = gtid; i < 1024 * NB * 24; i += NT) { const int row = i / (NB * 24), r = i % (NB * 24), b = r / 24, c = r % 24; ((unsigned*)(P.VT() + (size_t)row * (NB * KSEQ) + b * KSEQ))[c] = 0u; }
    for (int i = gtid; i < NPOS * 96; i += NT) { const int pos = i / 96, j = i % 96;
        const double e = j < 64 ? (double)j / 64.0 : (double)(j - 64) / 32.0;
        const float inv = (float)exp2(-e * 13.287712379549449); const float ang = (float)pos * inv;
        const double rev = (double)ang * 0.15915494309189535; const float a = (float)((rev - rint(rev)) * 6.283185307179586);
        const float c = cosf(a), s = sinf(a);
        if (j < 64) { P.C128()[pos * 64 + j] = c; P.S128()[pos * 64 + j] = s; } else { P.C64()[pos * 32 + j - 64] = c; P.S64()[pos * 32 + j - 64] = s; } }
    if (bx < NMP / 16) {
        LAS float* mx = (LAS float*)lds;
        for (int rr = 0; rr < 2; ++rr) { const int row = 2 * wave + rr; f32x4 v[8]; float ss = 0.f;
#pragma unroll
            for (int j = 0; j < 8; ++j) { v[j] = *(const f32x4*)(P.meta() + (size_t)row * D + 4 * lane + 256 * j); ss += (v[j][0] * v[j][0] + v[j][1] * v[j][1]) + (v[j][2] * v[j][2] + v[j][3] * v[j][3]); }
            const float rs = 1.0f / sqrtf(wave_sum(ss) * (1.f / D) + NORM_EPS);
#pragma unroll
            for (int j = 0; j < 8; ++j) { const f32x4 w = *(const f32x4*)(P.norm_w() + 4 * lane + 256 * j); *(LAS f32x4*)(mx + row * D + 4 * lane + 256 * j) = v[j] * rs * w; } }
        __syncthreads();
        const int c16 = lane & 15, ks = lane >> 4, q = 16 * bx + c16, orig = q < 320 ? 512 + q : 2880 + (q - 320);
        float acc[16];
#pragma unroll
        for (int i = 0; i < 16; ++i) acc[i] = 0.f;
        const float* wp = P.w_in() + (size_t)(256 * wave + ks) * NIN + orig;
#pragma unroll 8
        for (int j = 0; j < 64; ++j) { const float wv = wp[(size_t)(4 * j) * NIN]; const int k = 256 * wave + 4 * j + ks;
#pragma unroll
            for (int i = 0; i < 16; ++i) acc[i] += mx[i * D + k] * wv; }
#pragma unroll
        for (int i = 0; i < 16; ++i) { acc[i] += __shfl_xor(acc[i], 16); acc[i] += __shfl_xor(acc[i], 32); }
        __syncthreads();
        LAS float* red = (LAS float*)lds;
        if (ks == 0) {
#pragma unroll
            for (int i = 0; i < 16; ++i) red[(wave * 16 + i) * 16 + c16] = acc[i]; }
        __syncthreads();
        if (tid < 256) { float sum = 0.f;
#pragma unroll
            for (int w = 0; w < 8; ++w) sum += red[w * 256 + tid];
            P.MP()[(tid >> 4) * NMP + 16 * bx + (tid & 15)] = sum; }
        __syncthreads();
    }
    LAS float* scr = (LAS float*)(lds + wave * 16384);
    const int gw = bx * NWAVES + wave, NGW = G * NWAVES;
    constexpr int I_IN = 32 * 320, I_UQ = 8 * 48, I_UK = 4 * 32, I_B = 16 * 64, I_O = 32 * 64;
    constexpr int NITEMS = I_IN + I_UQ + 2 * I_UK + 2 * I_B + I_O;
    for (int it = gw; it < NITEMS; it += NGW) { int r = it;
        if (r < I_IN) { p0_item<1>(P.w_in(), NIN, D, P.WIN(), nullptr, r, 320, scr, lane); continue; } r -= I_IN;
        if (r < I_UQ) { p0_item<2>(P.w_uq(), 1536, 512, P.WUQ(), P.qnw(), r, 48, scr, lane); continue; } r -= I_UQ;
        if (r < I_UK) { p0_item<3>(P.w_ukv(), 2048, 256, P.WUK(), P.kvnw(), r, 32, scr, lane); continue; } r -= I_UK;
        if (r < I_UK) { p0_item<4>(P.w_ukv(), 2048, 256, P.WUV(), P.kvnw(), r, 32, scr, lane); continue; } r -= I_UK;
        if (r < I_B) { p0_item<0>(P.w_bm(), D, 2048, P.WB2(), nullptr, r, 64, scr, lane); continue; } r -= I_B;
        if (r < I_B) { p0_item<0>(P.w_br(), D, 2048, P.WB2() + 1024, nullptr, r, 64, scr, lane); continue; } r -= I_B;
        p0_item<0>(P.w_out(), D, D, P.WOUT(), nullptr, r, 64, scr, lane); }
    {
        f32x4 nw[8];
#pragma unroll
        for (int j = 0; j < 8; ++j) nw[j] = *(const f32x4*)(P.norm_w() + 4 * lane + 256 * j);
        f32x4 v[8], u[8];
#pragma unroll
        for (int j = 0; j < 8; ++j) { v[j] = *(const f32x4*)(P.x() + (size_t)gw * D + 4 * lane + 256 * j); u[j] = *(const f32x4*)(P.x() + (size_t)(gw + NGW) * D + 4 * lane + 256 * j); }
        for (int m = gw; m < M; m += 2 * NGW) { const int m2 = m + NGW, mn = m + 2 * NGW;
            f32x4 vn[8], un[8];
            if (mn < M) {
#pragma unroll
                for (int j = 0; j < 8; ++j) { vn[j] = *(const f32x4*)(P.x() + (size_t)mn * D + 4 * lane + 256 * j); un[j] = *(const f32x4*)(P.x() + (size_t)(mn + NGW) * D + 4 * lane + 256 * j); } }
            float ss = 0.f, ss2 = 0.f;
#pragma unroll
            for (int j = 0; j < 8; ++j) { ss += (v[j][0] * v[j][0] + v[j][1] * v[j][1]) + (v[j][2] * v[j][2] + v[j][3] * v[j][3]); ss2 += (u[j][0] * u[j][0] + u[j][1] * u[j][1]) + (u[j][2] * u[j][2] + u[j][3] * u[j][3]); }
            const float rs = 1.0f / sqrtf(wave_sum(ss) * (1.f / D) + NORM_EPS), rs2 = 1.0f / sqrtf(wave_sum(ss2) * (1.f / D) + NORM_EPS);
#pragma unroll
            for (int j = 0; j < 8; ++j) { const f32x4 o = v[j] * rs * nw[j], o2 = u[j] * rs2 * nw[j];
                u32x2 pk; pk.x = pk2(o[0], o[1]); pk.y = pk2(o[2], o[3]); *(u32x2*)(P.XN() + (size_t)m * D + 4 * lane + 256 * j) = pk;
                pk.x = pk2(o2[0], o2[1]); pk.y = pk2(o2[2], o2[3]); *(u32x2*)(P.XN() + (size_t)m2 * D + 4 * lane + 256 * j) = pk; }
            if (mn < M) {
#pragma unroll
                for (int j = 0; j < 8; ++j) { v[j] = vn[j]; u[j] = un[j]; } }
        }
    }
}

__device__ __forceinline__ void meta_stage2(const Ptrs& P, int tid) {
    const int gtid = blockIdx.x * NTHR + tid, NT = gridDim.x * NTHR;
    for (int idx = gtid; idx < 8 * 128 * 128; idx += NT) { const int h = idx >> 14, d = (idx >> 7) & 127, e = idx & 127, j = d & 63; const float lg2 = head_lg2(h); float s = 0.f;
        for (int i = 0; i < 16; ++i) { const float k1 = P.MP()[i * NMP + 320 + h * 128 + j], k2 = P.MP()[i * NMP + 320 + h * 128 + j + 64], c = P.C128()[i * 64 + j], sn = P.S128()[i * 64 + j];
            const float kd = d < 64 ? k1 * c - k2 * sn : k1 * sn + k2 * c;
            s += kd * 0.08838834764831845f * exp2f(lg2 * (float)(15 - i)) * P.MP()[i * NMP + 1344 + h * 128 + e]; }
        P.R0()[idx] = s; }
    if (gtid < 32768) { const int n = gtid >> 4, ks = gtid & 15, head = n >> 8, wi = n & 255; float dot[16], ss[16];
#pragma unroll
        for (int i = 0; i < 16; ++i) { dot[i] = 0.f; ss[i] = 0.f; }
#pragma unroll 4
        for (int kk = 0; kk < 16; ++kk) { const int k = 16 * ks + kk; const float wv = P.w_ukv()[(size_t)k * 2048 + n] * P.kvnw()[k];
#pragma unroll
            for (int i = 0; i < 16; ++i) { const float c = P.MP()[i * NMP + k]; dot[i] += c * wv; ss[i] += c * c; } }
#pragma unroll
        for (int i = 0; i < 16; ++i) {
#pragma unroll
            for (int o = 1; o < 16; o <<= 1) { dot[i] += __shfl_xor(dot[i], o); ss[i] += __shfl_xor(ss[i], o); } }
        if (ks == 0) {
#pragma unroll
            for (int i = 0; i < 16; ++i) { const float v = dot[i] / sqrtf(ss[i] * (1.f / 256.f) + NORM_EPS); const bf16 bv = (bf16)f2bf(v);
                for (int b = 0; b < NB; ++b) { if (wi < 128) P.KN()[(size_t)(b * KSEQ + 48 + i) * 1024 + head * 128 + wi] = bv; else P.VT()[(size_t)(head * 128 + wi - 128) * (NB * KSEQ) + b * KSEQ + 48 + ((i & 3) | ((i & 4) << 1) | ((i & 8) >> 1))] = bv; } } }
    } else if (gtid < 32768 + 512) { const int idx = gtid - 32768, i = idx >> 5, j = idx & 31;
        const float t1 = P.MP()[i * NMP + 256 + j], t2 = P.MP()[i * NMP + 256 + 32 + j], c = P.C64()[i * 32 + j], s = P.S64()[i * 32 + j];
        const bf16 o1 = (bf16)f2bf(t1 * c - t2 * s), o2 = (bf16)f2bf(t1 * s + t2 * c);
        for (int b = 0; b < NB; ++b) { P.KR()[(size_t)(b * KSEQ + 48 + i) * 64 + j] = o1; P.KR()[(size_t)(b * KSEQ + 48 + i) * 64 + 32 + j] = o2; } }
}

constexpr int AT_KB = 64 * 24 * 16, AT_VB = 128 * 8 * 16, AT_BUF = AT_KB + AT_VB;
template <int VAR> __device__ __forceinline__ void attn_unit(const Ptrs& P, LAS unsigned char* lds, int b, int h, int qb, int tid, int lane, int wave, bool do_store = true) {
    asm volatile("" : "+v"(tid), "+v"(lane));
    const int r = lane & 31, hh = lane >> 5;
    const int trow = 256 * qb + 32 * wave + r;
    const size_t row = (size_t)b * TOK + trow;
    bf16x8 qf[12];
#pragma unroll
    for (int s = 0; s < 8; ++s) qf[s] = *(const bf16x8*)(P.QN() + row * 1024 + h * 128 + 16 * s + 8 * hh);
#pragma unroll
    for (int s = 0; s < 4; ++s) qf[8 + s] = *(const bf16x8*)(P.QR() + row * 512 + h * 64 + 16 * s + 8 * hh);
    const int ntiles = 4 * qb + 5, kt_last = 4 * qb + 1 + (wave >> 1);
    f32x16 o[4];
#pragma unroll
    for (int e = 0; e < 4; ++e)
#pragma unroll
        for (int i = 0; i < 16; ++i) o[e][i] = 0.f;
    float mrun = -1e30f, lsum = 0.f;
    const char* kbase = (const char*)(P.KN() + (size_t)b * KSEQ * 1024 + h * 128); const char* rbase = (const char*)(P.KR() + (size_t)b * KSEQ * 64);
    const char* vbase = (const char*)(P.VT() + (size_t)(h * 128) * (NB * KSEQ) + (size_t)b * KSEQ);
    const char* ksrc[3]; unsigned kstr[3]; const char* vsrc[2];
#pragma unroll
    for (int i = 0; i < 3; ++i) { const int q = (3 * wave + i) * 64 + lane, key = q / 24, cc = (q % 24) ^ ((key >> 1) & 7);
        ksrc[i] = cc < 16 ? kbase + (size_t)key * 2048 + cc * 16 : rbase + (size_t)key * 128 + (cc - 16) * 16; kstr[i] = cc < 16 ? 64u * 2048u : 64u * 128u; }
#pragma unroll
    for (int i = 0; i < 2; ++i) { const int q = (2 * wave + i) * 64 + lane, e = q >> 3, cc = (q & 7) ^ ((e >> 1) & 7); vsrc[i] = vbase + (size_t)e * (NB * KSEQ * 2) + cc * 16; }
#define AT_ISSUE(kt, slot) do { LAS unsigned char* kb_ = lds + (slot) * AT_BUF; \
        _Pragma("unroll") for (int i = 0; i < 3; ++i) __builtin_amdgcn_global_load_lds((const unsigned*)(ksrc[i] + (size_t)(kt) * kstr[i]), (LAS unsigned*)(kb_ + (3 * wave + i) * 1024), 16, 0, 0); \
        _Pragma("unroll") for (int i = 0; i < 2; ++i) __builtin_amdgcn_global_load_lds((const unsigned*)(vsrc[i] + (size_t)(kt) * 128), (LAS unsigned*)(kb_ + AT_KB + (2 * wave + i) * 1024), 16, 0, 0); } while (0)
    const int swz = (r >> 1) & 7;
    const unsigned lbase = (unsigned)(unsigned long long)lds;
    asm volatile("s_waitcnt vmcnt(0)" ::: "memory");
    __builtin_amdgcn_s_barrier();
    if (!(VAR & 16)) { AT_ISSUE(0, 0); AT_ISSUE(1, 1); }
#define DSR128(dst, addr, off) asm volatile("ds_read_b128 %0, %1 offset:%2" : "=v"(dst) : "v"(addr), "n"(off))
#define LGKM2(n, a, b) asm volatile("s_waitcnt lgkmcnt(" #n ")" : "+v"(a), "+v"(b))
#define LGKM4(n, a, b, c, d) asm volatile("s_waitcnt lgkmcnt(" #n ")" : "+v"(a), "+v"(b), "+v"(c), "+v"(d))
#define KREAD(s_) do { DSR128(kr[(s_) % 3][0], kad[(s_) & 3], ((s_) >> 2) * 128); DSR128(kr[(s_) % 3][1], kad[(s_) & 3], ((s_) >> 2) * 128 + 12288); } while (0)
#define VREAD(s2_) do { DSR128(vr[(s2_) & 1][0], vad[s2_], 0); DSR128(vr[(s2_) & 1][1], vad[s2_], 4096); DSR128(vr[(s2_) & 1][2], vad[s2_], 8192); DSR128(vr[(s2_) & 1][3], vad[s2_], 12288); } while (0)
#define QKSTEP(s_, n_) do { if ((s_) + 2 < 12) KREAD((s_) + 2); LGKM2(n_, kr[(s_) % 3][0], kr[(s_) % 3][1]); \
        p0 = __builtin_amdgcn_mfma_f32_32x32x16_bf16(kr[(s_) % 3][0], qf[s_], p0, 0, 0, 0); p1 = __builtin_amdgcn_mfma_f32_32x32x16_bf16(kr[(s_) % 3][1], qf[s_], p1, 0, 0, 0); } while (0)
#define PVSTEP(s2_, n_, pw_) do { LGKM4(n_, vr[(s2_) & 1][0], vr[(s2_) & 1][1], vr[(s2_) & 1][2], vr[(s2_) & 1][3]); const bf16x8 pb_ = __builtin_bit_cast(bf16x8, pw_); \
        _Pragma("unroll") for (int e = 0; e < 4; ++e) o[e] = __builtin_amdgcn_mfma_f32_32x32x16_bf16(vr[(s2_) & 1][e], pb_, o[e], 0, 0, 0); \
        if ((s2_) + 2 < 4) VREAD((s2_) + 2); } while (0)
#define AT_TILE(kt, SLOT) do { \
        if (kt + 1 < ntiles) asm volatile("s_waitcnt vmcnt(5)" ::: "memory"); else asm volatile("s_waitcnt vmcnt(0)" ::: "memory"); \
        __builtin_amdgcn_s_barrier(); \
        asm volatile("" ::: "memory"); \
        if (kt + 2 < ntiles && !(VAR & 16)) AT_ISSUE(kt + 2, (SLOT + 2) % 3); \
        if (kt <= kt_last && !(VAR & 8)) { \
            unsigned kad[4], vad[4]; \
            _Pragma("unroll") for (int t = 0; t < 4; ++t) { kad[t] = lbase + (SLOT) * AT_BUF + r * 384 + (((2 * t + hh) ^ swz) * 16); vad[t] = lbase + (SLOT) * AT_BUF + AT_KB + r * 128 + (((2 * t + hh) ^ swz) * 16); } \
            bf16x8 kr[3][2], vr[2][4]; \
            f32x16 p0, p1; \
            _Pragma("unroll") for (int i = 0; i < 16; ++i) { p0[i] = 0.f; p1[i] = 0.f; } \
            KREAD(0); KREAD(1); \
            if (!(VAR & 4)) { QKSTEP(0, 4); QKSTEP(1, 4); QKSTEP(2, 4); QKSTEP(3, 4); QKSTEP(4, 4); QKSTEP(5, 4); QKSTEP(6, 4); QKSTEP(7, 4); QKSTEP(8, 4); QKSTEP(9, 4); QKSTEP(10, 2); QKSTEP(11, 0); } else { LGKM2(0, kr[0][0], kr[0][1]); LGKM2(0, kr[1][0], kr[1][1]); p0[0] = __builtin_bit_cast(float, kr[0][0][0] + kr[1][0][0]); p1[0] = __builtin_bit_cast(float, (int)kr[0][1][0] + (int)kr[1][1][0]); } \
            VREAD(0); VREAD(1); \
            if (kt == 0 || kt >= 4 * qb + 1) { \
                const int kmax = KOFF + trow, k0 = 64 * kt + 4 * hh; \
                _Pragma("unroll") for (int i = 0; i < 16; ++i) { const int kk = k0 + (i & 3) + 8 * (i >> 2); if (kk < 48 || kk > kmax) p0[i] = -1e30f; if (kk + 32 < 48 || kk + 32 > kmax) p1[i] = -1e30f; } \
            } \
            float mx = fmaxf(p0[0], p1[0]); \
            _Pragma("unroll") for (int i = 1; i < 16; ++i) mx = fmaxf(mx, fmaxf(p0[i], p1[i])); \
            mx = fmaxf(mx, __shfl_xor(mx, 32)); \
            if (__builtin_amdgcn_ballot_w64(mx > mrun + 8.f) != 0ull) {     \
                const float mnew = mx > mrun + 8.f ? mx : mrun, alpha = __builtin_amdgcn_exp2f(mrun - mnew); mrun = mnew; lsum *= alpha; \
                _Pragma("unroll") for (int e = 0; e < 4; ++e) \
                    _Pragma("unroll") for (int i = 0; i < 16; ++i) o[e][i] *= alpha; \
            } \
            float ps = 0.f; \
            _Pragma("unroll") for (int i = 0; i < 16; ++i) { if (VAR & 1) { p0[i] = p0[i] - mrun; p1[i] = p1[i] - mrun; } else { p0[i] = __builtin_amdgcn_exp2f(p0[i] - mrun); p1[i] = __builtin_amdgcn_exp2f(p1[i] - mrun); } ps += p0[i] + p1[i]; } \
            lsum += ps; \
            u32x4 pw0, pw1, pw2, pw3; \
            pw0.x = cvt_pk_bf16(p0[0], p0[1]); pw0.y = cvt_pk_bf16(p0[2], p0[3]); pw0.z = cvt_pk_bf16(p0[4], p0[5]); pw0.w = cvt_pk_bf16(p0[6], p0[7]); \
            pw1.x = cvt_pk_bf16(p0[8], p0[9]); pw1.y = cvt_pk_bf16(p0[10], p0[11]); pw1.z = cvt_pk_bf16(p0[12], p0[13]); pw1.w = cvt_pk_bf16(p0[14], p0[15]); \
            pw2.x = cvt_pk_bf16(p1[0], p1[1]); pw2.y = cvt_pk_bf16(p1[2], p1[3]); pw2.z = cvt_pk_bf16(p1[4], p1[5]); pw2.w = cvt_pk_bf16(p1[6], p1[7]); \
            pw3.x = cvt_pk_bf16(p1[8], p1[9]); pw3.y = cvt_pk_bf16(p1[10], p1[11]); pw3.z = cvt_pk_bf16(p1[12], p1[13]); pw3.w = cvt_pk_bf16(p1[14], p1[15]); \
            if (!(VAR & 2)) { PVSTEP(0, 4, pw0); PVSTEP(1, 4, pw1); PVSTEP(2, 4, pw2); PVSTEP(3, 0, pw3); } else { LGKM4(0, vr[0][0], vr[0][1], vr[0][2], vr[0][3]); LGKM4(0, vr[1][0], vr[1][1], vr[1][2], vr[1][3]); o[0][0] += __builtin_bit_cast(float, pw0.x ^ pw1.y ^ pw2.z ^ pw3.w) + __builtin_bit_cast(float, (int)vr[0][0][0] + (int)vr[1][1][0]); } \
        } \
    } while (0)
    if (wave >= 4) __builtin_amdgcn_s_setprio(1);
    for (int kt0 = 0; kt0 < ntiles; kt0 += 3) {
        { const int kt = kt0; AT_TILE(kt, 0); }
        if (kt0 + 1 < ntiles) { const int kt = kt0 + 1; AT_TILE(kt, 1); }
        if (kt0 + 2 < ntiles) { const int kt = kt0 + 2; AT_TILE(kt, 2); }
    }
#undef AT_TILE
    __builtin_amdgcn_s_setprio(0);
#undef DSR128
#undef LGKM2
#undef LGKM4
#undef KREAD
#undef VREAD
#undef QKSTEP
#undef PVSTEP
#undef AT_ISSUE
    const float inv = 1.0f / (lsum + __shfl_xor(lsum, 32));
    bf16* yrow = P.ZMLA() + row * 2048 + h * 128;
    u32x2 zz[4][4];
#pragma unroll
    for (int e = 0; e < 4; ++e)
#pragma unroll
        for (int g = 0; g < 4; ++g) zz[e][g] = *(const u32x2*)(yrow + 32 * e + 8 * g + 4 * hh);
    asm volatile("" ::: "memory");
#pragma unroll
    for (int e = 0; e < 4; ++e)
#pragma unroll
        for (int g = 0; g < 4; ++g) { bf16* p = yrow + 32 * e + 8 * g + 4 * hh; const u32x2 z = zz[e][g];
            const float z0 = __uint_as_float(z.x << 16), z1 = __uint_as_float(z.x & 0xffff0000u), z2 = __uint_as_float(z.y << 16), z3 = __uint_as_float(z.y & 0xffff0000u);
            u32x2 w; w.x = cvt_pk_bf16(o[e][4 * g] * inv * z0, o[e][4 * g + 1] * inv * z1); w.y = cvt_pk_bf16(o[e][4 * g + 2] * inv * z2, o[e][4 * g + 3] * inv * z3); if (do_store) *(u32x2*)p = w; }
}

constexpr int RT_S = 272, RT_T = 128 * RT_S;
typedef short v4i16_t __attribute__((ext_vector_type(4)));
__device__ __forceinline__ s16x4 tr_read(const LAS unsigned char* p) { return __builtin_bit_cast(s16x4, __builtin_amdgcn_ds_read_tr16_b64_v4i16((LAS v4i16_t*)p)); }
__device__ __forceinline__ void ret_unit(const Ptrs& P, LAS unsigned char* lds, int b, int h, int tid, int lane, int wave, bool do_store = true) {
    asm volatile("" : "+v"(tid), "+v"(lane));
    const int c16 = lane & 15, q4 = lane >> 4, tq = c16 >> 2, tp = c16 & 3;
    LAS unsigned char* Ks = lds; LAS unsigned char* Vs = lds + RT_T; LAS unsigned char* Ps = lds + 2 * RT_T; LAS unsigned char* RTs = lds + 3 * RT_T;
    const float lg2 = head_lg2(h), G = exp2f(lg2 * 128.f);
    f32x4 R[8];
#pragma unroll
    for (int eb = 0; eb < 8; ++eb)
#pragma unroll
        for (int i = 0; i < 4; ++i) R[eb][i] = P.R0()[(h * 128 + 16 * wave + 4 * q4 + i) * 128 + 16 * eb + c16];
    __syncthreads();
#pragma unroll
    for (int eb = 0; eb < 8; ++eb) { u32x2 w; w.x = cvt_pk_bf16(R[eb][0], R[eb][1]); w.y = cvt_pk_bf16(R[eb][2], R[eb][3]); *(LAS u32x2*)(RTs + (16 * eb + c16) * RT_S + (16 * wave + 4 * q4) * 2) = w; }
    float rowfac[4], xi[4];
#pragma unroll
    for (int i = 0; i < 4; ++i) { const int n = 16 * wave + 4 * q4 + i; rowfac[i] = exp2f(lg2 * (float)(n - 127)); xi[i] = exp2f(lg2 * (float)(n + 1)); }
    float gw[8], gb[8];
#pragma unroll
    for (int eb = 0; eb < 8; ++eb) { gw[eb] = P.gnw()[h * 128 + 16 * eb + c16]; gb[eb] = P.gnb()[h * 128 + 16 * eb + c16]; }
    for (int ch = 0; ch < 32; ++ch) {
        const size_t row0 = (size_t)b * TOK + 128 * ch;
#pragma unroll
        for (int i = 0; i < 4; ++i) { const int id = tid + 512 * i, m = id >> 4, cc = id & 15;
            *(LAS u32x4*)(Ks + m * RT_S + cc * 16) = *(const u32x4*)(P.RK() + (row0 + m) * 1024 + h * 128 + cc * 8);
            *(LAS u32x4*)(Vs + m * RT_S + cc * 16) = *(const u32x4*)(P.RV() + (row0 + m) * 1024 + h * 128 + cc * 8); }
        bf16x8 qf[4];
#pragma unroll
        for (int s = 0; s < 4; ++s) qf[s] = *(const bf16x8*)(P.RQ() + (row0 + 16 * wave + c16) * 1024 + h * 128 + 32 * s + 8 * q4);
        unsigned short zr[4][8];
#pragma unroll
        for (int i = 0; i < 4; ++i)
#pragma unroll
            for (int eb = 0; eb < 8; ++eb) zr[i][eb] = P.ZRET()[(row0 + 16 * wave + 4 * q4 + i) * 2048 + h * 128 + c16 + 16 * eb];
        __syncthreads();
        f32x4 sacc[8], oacc[8];
#pragma unroll
        for (int mb = 0; mb < 8; ++mb) { f32x4 a = {0.f, 0.f, 0.f, 0.f}, c = {0.f, 0.f, 0.f, 0.f};
#pragma unroll
            for (int s = 0; s < 4; ++s) { const bf16x8 kf = *(const LAS bf16x8*)(Ks + (16 * mb + c16) * RT_S + (32 * s + 8 * q4) * 2), rf = *(const LAS bf16x8*)(RTs + (16 * mb + c16) * RT_S + (32 * s + 8 * q4) * 2);
                a = __builtin_amdgcn_mfma_f32_16x16x32_bf16(qf[s], kf, a, 0, 0, 0); c = __builtin_amdgcn_mfma_f32_16x16x32_bf16(qf[s], rf, c, 0, 0, 0); }
            sacc[mb] = a; oacc[mb] = c; }
#pragma unroll
        for (int mb = 0; mb < 8; ++mb)
#pragma unroll
            for (int i = 0; i < 4; ++i) { const int n = 16 * wave + 4 * q4 + i, m = 16 * mb + c16; const float pv = m <= n ? sacc[mb][i] * rowfac[i] : 0.f;
                *(LAS bf16*)(Ps + n * RT_S + m * 2) = (bf16)f2bf(pv); oacc[mb][i] *= xi[i]; }
        __syncthreads();
        bf16x8 pf[4], ktf[4];
#pragma unroll
        for (int s = 0; s < 4; ++s) { pf[s] = *(const LAS bf16x8*)(Ps + (16 * wave + c16) * RT_S + (32 * s + 8 * q4) * 2);
            const s16x4 lo = tr_read(Ks + (32 * s + 8 * q4 + tq) * RT_S + (16 * wave + 4 * tp) * 2), hi = tr_read(Ks + (32 * s + 8 * q4 + 4 + tq) * RT_S + (16 * wave + 4 * tp) * 2);
            ktf[s] = __builtin_shufflevector(lo, hi, 0, 1, 2, 3, 4, 5, 6, 7); }
#pragma unroll
        for (int eb = 0; eb < 8; ++eb) { f32x4 kv = {0.f, 0.f, 0.f, 0.f};
#pragma unroll
            for (int s = 0; s < 4; ++s) { const s16x4 lo = tr_read(Vs + (32 * s + 8 * q4 + tq) * RT_S + (16 * eb + 4 * tp) * 2), hi = tr_read(Vs + (32 * s + 8 * q4 + 4 + tq) * RT_S + (16 * eb + 4 * tp) * 2);
                const bf16x8 vf = __builtin_shufflevector(lo, hi, 0, 1, 2, 3, 4, 5, 6, 7);
                oacc[eb] = __builtin_amdgcn_mfma_f32_16x16x32_bf16(pf[s], vf, oacc[eb], 0, 0, 0); kv = __builtin_amdgcn_mfma_f32_16x16x32_bf16(ktf[s], vf, kv, 0, 0, 0); }
            R[eb] = R[eb] * G + kv;
            u32x2 w; w.x = cvt_pk_bf16(R[eb][0], R[eb][1]); w.y = cvt_pk_bf16(R[eb][2], R[eb][3]); *(LAS u32x2*)(RTs + (16 * eb + c16) * RT_S + (16 * wave + 4 * q4) * 2) = w; }
#pragma unroll
        for (int i = 0; i < 4; ++i) { float s = 0.f;
#pragma unroll
            for (int eb = 0; eb < 8; ++eb) s += oacc[eb][i];
            s += __shfl_xor(s, 1); s += __shfl_xor(s, 2); s += __shfl_xor(s, 4); s += __shfl_xor(s, 8);
            const float mu = s * (1.f / 128.f); float v = 0.f;
#pragma unroll
            for (int eb = 0; eb < 8; ++eb) { const float d = oacc[eb][i] - mu; v += d * d; }
            v += __shfl_xor(v, 1); v += __shfl_xor(v, 2); v += __shfl_xor(v, 4); v += __shfl_xor(v, 8);
            const float rstd = 1.0f / sqrtf(v * (1.f / 128.f) + GN_EPS);
            bf16* yr = P.ZRET() + (row0 + 16 * wave + 4 * q4 + i) * 2048 + h * 128 + c16;
#pragma unroll
            for (int eb = 0; eb < 8; ++eb) { const float z = bf2f(zr[i][eb]); const bf16 yv = (bf16)f2bf(((oacc[eb][i] - mu) * rstd * gw[eb] + gb[eb]) * z); if (do_store) yr[16 * eb] = yv; } }
        __syncthreads();
    }
}

#define RLX_AGENT __ATOMIC_RELAXED, __HIP_MEMORY_SCOPE_AGENT
#define XB_TMO      128
#define XB_XCNT(j)  (256  + 64 * (j))
#define XB_XSUB(j)  (1280 + 64 * (j))
#define XB_XGEN(j)  (2304 + 64 * (j))
#define XB_TOP      3328
#define XB_TOPGEN   3392
#define XCD_BAR_WORDS 3456
#define XB_SPIN_CAP (1u << 18)

__device__ __forceinline__ unsigned xb_ld(unsigned* p)              { return __hip_atomic_load(p, __ATOMIC_RELAXED, __HIP_MEMORY_SCOPE_AGENT); }
__device__ __forceinline__ unsigned xb_add(unsigned* p, unsigned v) { return __hip_atomic_fetch_add(p, v, __ATOMIC_RELAXED, __HIP_MEMORY_SCOPE_AGENT); }
__device__ __forceinline__ unsigned xb_xcc_id() { return (unsigned)__builtin_amdgcn_s_getreg((3 << 11) | 20) & 0xFu; }
#define XB_SPIN(cond, bar) do { unsigned _sp = 0; while (cond) { __builtin_amdgcn_s_sleep(1); \
    if ((++_sp & 255u) == 0u) { if (xb_ld(&(bar)[XB_TMO])) break; if (_sp > XB_SPIN_CAP) { atomicAdd(&(bar)[XB_TMO], 1u); break; } } } } while (0)

struct XcdBarrier {
    unsigned* bar; unsigned x;
    volatile LAS unsigned* st;
};

__device__ __forceinline__ XcdBarrier xcd_barrier_post(unsigned* bar, volatile LAS unsigned* st) {
    XcdBarrier b; b.bar = bar; b.x = xb_xcc_id(); b.st = st;
    if (threadIdx.x == 0) (void)xb_add(&bar[XB_XCNT(b.x)], 1u);
    return b;
}
__device__ __forceinline__ void xcd_barrier_complete(unsigned* bar, unsigned x, unsigned& nloc, unsigned& nx) {
    const unsigned G = gridDim.x * gridDim.y * gridDim.z;
    unsigned sum, cnt, mine, sp = 0u;
    for (;;) {
        sum = 0u; cnt = 0u; mine = 0u;
#pragma unroll
        for (unsigned j = 0; j < 16; ++j) { const unsigned c = xb_ld(&bar[XB_XCNT(j)]); sum += c; cnt += (c > 0u) ? 1u : 0u; mine = (j == x) ? c : mine; }
        if (sum == G) break;
        __builtin_amdgcn_s_sleep(1);
        if ((++sp & 255u) == 0u) { if (xb_ld(&bar[XB_TMO])) break; if (sp > XB_SPIN_CAP) { atomicAdd(&bar[XB_TMO], 1u); break; } }
    }
    nloc = mine > 0u ? mine : 1u; nx = cnt > 0u ? cnt : 1u;
}

__device__ __forceinline__ void xcd_barrier(const XcdBarrier& b) {
    asm volatile("s_waitcnt vmcnt(0)" ::: "memory");
    __syncthreads();
    if (threadIdx.x == 0) {
        unsigned* bar = b.bar;
        __builtin_amdgcn_s_waitcnt(0);
        unsigned nloc = b.st[0], nx = b.st[1];
        if (nloc == 0u) { xcd_barrier_complete(bar, b.x, nloc, nx); b.st[0] = nloc; b.st[1] = nx; }
        const unsigned old = xb_add(&bar[XB_XSUB(b.x)], 1u);
        const unsigned gen = old / nloc;
        if (old + 1u == (gen + 1u) * nloc) {
            __builtin_amdgcn_fence(__ATOMIC_RELEASE, "agent");
            asm volatile("s_waitcnt vmcnt(0)" ::: "memory");
            const unsigned og = xb_add(&bar[XB_TOP], 1u);
            const unsigned tg = og / nx;
            if (og + 1u == (tg + 1u) * nx) xb_add(&bar[XB_TOPGEN], 1u);
            else XB_SPIN(xb_ld(&bar[XB_TOPGEN]) == tg, bar);
            __builtin_amdgcn_fence(__ATOMIC_ACQUIRE, "agent");
            xb_add(&bar[XB_XGEN(b.x)], 1u);
            asm volatile("s_waitcnt vmcnt(0)" ::: "memory");
        } else {
            XB_SPIN(xb_ld(&bar[XB_XGEN(b.x)]) == gen, bar);
            __builtin_amdgcn_fence(__ATOMIC_ACQUIRE, "agent");
            asm volatile("s_waitcnt vmcnt(0)" ::: "memory");
        }
    }
    __syncthreads();
}

__device__ __forceinline__ void stagger_start(int bx, int step_ticks  , int groups) {
    const unsigned long long t0 = __builtin_amdgcn_s_memrealtime(); const unsigned long long d = (unsigned long long)((bx % groups) * step_ticks);
    while (__builtin_amdgcn_s_memrealtime() - t0 < d) __builtin_amdgcn_s_sleep(16);
}
template <int PH> __device__ __forceinline__ void run_phase(const Ptrs& P, LAS unsigned char* lds, int tid, int lane, int wave);

template <int ph_lo, int ph_hi> __global__ void __launch_bounds__(NTHR, 2) hybrid_fwd(Args args) {
    extern __shared__ __attribute__((aligned(16))) unsigned char lds_raw[];
    LAS unsigned char* lds = (LAS unsigned char*)lds_raw;
    const int tid = threadIdx.x, lane = tid & 63, wave = __builtin_amdgcn_readfirstlane(tid >> 6);
    volatile LAS unsigned* xst = (volatile LAS unsigned*)(lds + QWORD_OFF + 16);
    if (tid == 0) { xst[0] = 0u; xst[1] = 0u; }
    __syncthreads();
    XcdBarrier xbar; xbar.bar = nullptr; xbar.x = 0; xbar.st = nullptr;
    const int G = gridDim.x, bx = blockIdx.x;
    constexpr bool multi = (ph_hi - ph_lo) > 1;
#ifndef PHMASK
#define PHMASK 0x7f
#endif
#ifndef STAG1_TICKS
#define STAG1_TICKS 400
#define STAG1_GROUPS 16
#endif
#ifndef DUPMASK
#define DUPMASK 0
#endif
#define NREP(k) (((DUPMASK >> (k)) & 1) ? 2 : 1)
#define IN(k) (((PHMASK >> (k)) & 1) && ph_lo <= (k) && (k) < ph_hi)
#define PHASE_PTRS() Ptrs P; P.a = &args; P.ws = args.ws; unsigned char* ws = P.ws; (void)ws
#define SEAM(k) do { if (multi && IN((k) + 1)) { if ((k) == 0) { cg::this_grid().sync(); xbar = xcd_barrier_post((unsigned*)(args.ws + WS_CTL) + 4096, xst); } else xcd_barrier(xbar); } } while (0)

    if (IN(0)) { PHASE_PTRS(); for (int rep_ = 0; rep_ < NREP(0); ++rep_) { p0_prologue(P, lds, tid, lane, wave); __syncthreads(); } SEAM(0); }
    if (IN(1)) { PHASE_PTRS();
#if defined(PROBE_KLOOP1)
        { pg8::Gemm g{P.XN(), P.WIN(), M, NINP, D}; pg8::StaticOrder S; S.init(M, NINP, G, bx); pg8::EpiNull E{P.SSQO()};
          pg8::gemm_phase<pg8::EpiNull, pg8::StaticOrder, true, true>(lds, g, S, E); }
#endif
      for (int rep_ = 0; rep_ < NREP(1); ++rep_) {
        pg8::Gemm g{P.XN(), P.WIN(), M, NINP, D}; pg8::StaticOrder S; S.init(M, NINP, G, bx);
        pg8::EpiIn E{ws, P.SSQQ(), P.SSQKV(), P.C128(), P.S128(), P.C64(), P.S64()};
        pg8::gemm_phase<pg8::EpiIn, pg8::StaticOrder, true, true>(lds, g, S, E);
      }
        SEAM(1);
    }
    if (IN(2)) { PHASE_PTRS();
        meta_stage2(P, tid);
      for (int rep_ = 0; rep_ < NREP(2); ++rep_) {
        { pg8::Gemm g{P.CQ(), P.WUQ(), M, 1536, 512}; pg8::StaticOrder S; S.init(M, 1536, G, bx);
          pg8::EpiQ E{P.QN(), P.QR(), P.SSQQ(), P.C64(), P.S64(), 0.07216878364870322f * 1.4426950408889634f};
          pg8::gemm_phase<pg8::EpiQ, pg8::StaticOrder, true, true>(lds, g, S, E); }
        { pg8::Gemm g{P.CKV(), P.WUK(), M, 1024, 256}; pg8::StaticOrder S; S.init(M, 1024, G, bx);
          pg8::EpiK E{P.KN(), P.SSQKV()};
          pg8::gemm_phase<pg8::EpiK, pg8::StaticOrder, true, true>(lds, g, S, E); }
        { pg8::Gemm g{P.WUV(), P.CKV(), 1024, M, 256}; pg8::StaticOrder S; S.init(1024, M, G, bx);
          pg8::EpiVT E{P.VT(), P.SSQKV()};
          pg8::gemm_phase<pg8::EpiVT, pg8::StaticOrder, true, true>(lds, g, S, E); }
      }
        SEAM(2);
    }
    if (IN(3)) { PHASE_PTRS();
        volatile LAS unsigned* qw = (volatile LAS unsigned*)(lds + QWORD_OFF);
#if defined(PROBE_RET2)
        for (;;) { __syncthreads(); if (tid == 0) *qw = __hip_atomic_fetch_add(P.ctl() + 64 * 26, 1u, __ATOMIC_RELAXED, __HIP_MEMORY_SCOPE_AGENT); __syncthreads();
            const int idx = (int)__builtin_amdgcn_readfirstlane(*qw); if (idx >= 64) break; ret_unit(P, lds, idx >> 3, idx & 7, tid, lane, wave, P.ws == nullptr); }
#endif
#ifndef AT_PROBE_VAR
#define AT_PROBE_VAR 0
#endif
#if defined(PROBE_ATT2)
        for (;;) { __syncthreads(); if (tid == 0) *qw = __hip_atomic_fetch_add(P.ctl() + 64 * 27, 1u, __ATOMIC_RELAXED, __HIP_MEMORY_SCOPE_AGENT); __syncthreads();
            const int a = (int)__builtin_amdgcn_readfirstlane(*qw); if (a >= 1024) break; attn_unit<AT_PROBE_VAR>(P, lds, (a & 63) >> 3, a & 7, 15 - (a >> 6), tid, lane, wave, P.ws == nullptr); }
#endif
#ifndef NO_RET
        for (;;) {
            __syncthreads();
            if (tid == 0) *qw = __hip_atomic_fetch_add(P.ctl() + 64, 1u, __ATOMIC_RELAXED, __HIP_MEMORY_SCOPE_AGENT);
            __syncthreads();
            const int idx = (int)__builtin_amdgcn_readfirstlane(*qw);
            if (idx >= 64) break;
            ret_unit(P, lds, idx >> 3, idx & 7, tid, lane, wave);
        }
#endif
#ifndef NO_ATT
        for (;;) {
            __syncthreads();
            if (tid == 0) *qw = __hip_atomic_fetch_add(P.ctl() + 128, 1u, __ATOMIC_RELAXED, __HIP_MEMORY_SCOPE_AGENT);
            __syncthreads();
            const int a = (int)__builtin_amdgcn_readfirstlane(*qw);
            if (a >= 1024) break;
            attn_unit<0>(P, lds, (a & 63) >> 3, a & 7, 15 - (a >> 6), tid, lane, wave);
        }
#endif
        SEAM(3);
    }
    if (IN(4)) { PHASE_PTRS();
        { pg8::Gemm g{P.ZMLA(), P.WB2(), M, D, 2048}; pg8::StaticOrder S; S.init(M, D, G, bx);
          pg8::EpiMerge2 E{P.MG(), P.GATES()};
          pg8::gemm_phase<pg8::EpiMerge2, pg8::StaticOrder, true, true>(lds, g, S, E); }
        SEAM(4);
    }
    if (IN(5)) { PHASE_PTRS();
      for (int rep_ = 0; rep_ < NREP(5); ++rep_) {
        pg8::Gemm g{P.MG(), P.WOUT(), M, D, D}; pg8::StaticOrder S; S.init(M, D, G, bx);
        pg8::EpiOut E{P.XN()};
        pg8::gemm_phase<pg8::EpiOut, pg8::StaticOrder, true, true>(lds, g, S, E);
#if defined(PROBE_DUP5)
        { pg8::Gemm g{P.MG(), P.WOUT(), M, D, D}; pg8::StaticOrder S; S.init(M, D, G, bx);
        pg8::EpiOut E{P.XN()};
        pg8::gemm_phase<pg8::EpiOut, pg8::StaticOrder, true, true>(lds, g, S, E); }
#endif
      }
        SEAM(5);
    }
    if (IN(6)) { PHASE_PTRS();
        const int gw = bx * NWAVES + wave, NGW = G * NWAVES;
        f32x4 fw[8];
#pragma unroll
        for (int j = 0; j < 4; ++j) { const int c0 = 8 * (lane + 64 * j); fw[2 * j] = *(const f32x4*)(P.fnw() + c0); fw[2 * j + 1] = *(const f32x4*)(P.fnw() + c0 + 4); }
        u32x4 dv[4]; f32x4 xv[8];
        if (gw < M) {
#pragma unroll
            for (int j = 0; j < 4; ++j) { const int c0 = 8 * (lane + 64 * j); dv[j] = *(const u32x4*)(P.XN() + (size_t)gw * D + c0); xv[2 * j] = *(const f32x4*)(P.x() + (size_t)gw * D + c0); xv[2 * j + 1] = *(const f32x4*)(P.x() + (size_t)gw * D + c0 + 4); } }
        for (int m = gw; m < M; m += NGW) { float* orow = P.out() + (size_t)m * D; const int mn = m + NGW;
            u32x4 dn[4]; f32x4 xq[8];
            if (mn < M) {
#pragma unroll
                for (int j = 0; j < 4; ++j) { const int c0 = 8 * (lane + 64 * j); dn[j] = *(const u32x4*)(P.XN() + (size_t)mn * D + c0); xq[2 * j] = *(const f32x4*)(P.x() + (size_t)mn * D + c0); xq[2 * j + 1] = *(const f32x4*)(P.x() + (size_t)mn * D + c0 + 4); } }
            f32x4 hv[8]; float ss = 0.f;
#pragma unroll
            for (int j = 0; j < 4; ++j) { f32x4 d0, d1; pg8::unpack8(dv[j], d0, d1); hv[2 * j] = d0 + xv[2 * j]; hv[2 * j + 1] = d1 + xv[2 * j + 1]; }
#pragma unroll
            for (int j = 0; j < 8; ++j) ss += (hv[j][0] * hv[j][0] + hv[j][1] * hv[j][1]) + (hv[j][2] * hv[j][2] + hv[j][3] * hv[j][3]);
            const float rs = 1.0f / sqrtf(wave_sum(ss) * (1.f / D) + NORM_EPS);
#pragma unroll
            for (int j = 0; j < 4; ++j) { const int c0 = 8 * (lane + 64 * j);
                *(f32x4*)(orow + c0) = hv[2 * j] * rs * fw[2 * j]; *(f32x4*)(orow + c0 + 4) = hv[2 * j + 1] * rs * fw[2 * j + 1]; }
            if (mn < M) {
#pragma unroll
                for (int j = 0; j < 4; ++j) dv[j] = dn[j];
#pragma unroll
                for (int j = 0; j < 8; ++j) xv[j] = xq[j]; }
        }
    }
#undef IN
#undef SEAM
}

#ifndef N_LAUNCHES
#define N_LAUNCHES 1
#endif
template <int LO, int HI> static bool setup_one(int& per_cu) {
    if (hipFuncSetAttribute((const void*)hybrid_fwd<LO, HI>, hipFuncAttributeMaxDynamicSharedMemorySize, LDS_BYTES) != hipSuccess) { fprintf(stderr, "kernel_launch: hipFuncSetAttribute failed\n"); return false; }
    if (hipOccupancyMaxActiveBlocksPerMultiprocessor(&per_cu, (const void*)hybrid_fwd<LO, HI>, NTHR, LDS_BYTES) != hipSuccess || per_cu < 1) { fprintf(stderr, "kernel_launch: occupancy query says %d blocks per CU\n", per_cu); per_cu = 1; }
    (void)hipGetLastError();
    return true;
}
extern "C" void kernel_launch(void* const* d_in, const int* in_sizes, int n_in, void* d_out, int out_size, void* d_ws, size_t ws_size, hipStream_t stream) {
    static int grid = 0;
    if (grid == 0) {
        if (n_in != 14 || out_size != M * D || ws_size < WS_END) { fprintf(stderr, "kernel_launch: unexpected shapes (n_in %d, out %d, ws %zu)\n", n_in, out_size, ws_size); grid = -1; return; }
        int dev = 0, cus = 0, per_cu = 1; bool ok = true;
        (void)hipGetDevice(&dev); (void)hipDeviceGetAttribute(&cus, hipDeviceAttributeMultiprocessorCount, dev);
#if N_LAUNCHES == 1
        ok = setup_one<0, 7>(per_cu);
#else
        ok = setup_one<0, 1>(per_cu) && setup_one<1, 2>(per_cu) && setup_one<2, 3>(per_cu) && setup_one<3, 4>(per_cu) && setup_one<4, 5>(per_cu) && setup_one<5, 6>(per_cu) && setup_one<6, 7>(per_cu);
#endif
        if (!ok) { grid = -1; return; }
        grid = cus * per_cu;
        if (grid != 256) fprintf(stderr, "kernel_launch: note: grid = %d workgroups\n", grid);
    }
    if (grid < 0) return;
    Args a{};
    for (int i = 0; i < 14; ++i) a.in[i] = (const float*)d_in[i];
    a.out = (float*)d_out; a.ws = (unsigned char*)d_ws;
#if N_LAUNCHES == 1
    void* kargs[] = {&a};
    hipError_t e = hipLaunchCooperativeKernel((const void*)hybrid_fwd<0, 7>, dim3(grid), dim3(NTHR), kargs, LDS_BYTES, stream);
    if (e != hipSuccess) fprintf(stderr, "kernel_launch: cooperative launch failed: %s (grid %d)\n", hipGetErrorString(e), grid);
#else
    hipLaunchKernelGGL((hybrid_fwd<0, 1>), dim3(grid), dim3(NTHR), LDS_BYTES, stream, a);
    hipLaunchKernelGGL((hybrid_fwd<1, 2>), dim3(grid), dim3(NTHR), LDS_BYTES, stream, a);
    hipLaunchKernelGGL((hybrid_fwd<2, 3>), dim3(grid), dim3(NTHR), LDS_BYTES, stream, a);
    hipLaunchKernelGGL((hybrid_fwd<3, 4>), dim3(grid), dim3(NTHR), LDS_BYTES, stream, a);
    hipLaunchKernelGGL((hybrid_fwd<4, 5>), dim3(grid), dim3(NTHR), LDS_BYTES, stream, a);
    hipLaunchKernelGGL((hybrid_fwd<5, 6>), dim3(grid), dim3(NTHR), LDS_BYTES, stream, a);
    hipLaunchKernelGGL((hybrid_fwd<6, 7>), dim3(grid), dim3(NTHR), LDS_BYTES, stream, a);
#endif
}
```
